# Optimizing an MI355X kernel written in HIP

```python
import math
import jax, jax.numpy as jnp
from jax import lax
import numpy as np


D_MODEL = 1024
BATCH = 2
SEQ = 8192
DEPTH = 2

N_A_LAYERS = DEPTH // 2
N_B_LAYERS = DEPTH - N_A_LAYERS
ALPHA = (2.0 * DEPTH) ** 0.25
BETA = (8.0 * DEPTH) ** -0.25
LN_EPS = 1e-5
ROPE_THETA = 10000.0
NEG = -1e30

RET_HEADS = 4
RET_DK = D_MODEL // RET_HEADS
RET_DV = 2 * RET_DK
RET_CHUNK = 128

NSA_HEADS = 16
NSA_GROUPS = 4
NSA_REP = NSA_HEADS // NSA_GROUPS
NSA_DH = D_MODEL // NSA_HEADS
KV_W = NSA_GROUPS * NSA_DH
CMP_LEN = 32
CMP_STRIDE = 16
CMP_HIDDEN = 256
SLC_BLOCK = 64
SLC_TOPK = 16
WINDOW = 512
Q_BLOCK = 128
FORCE_BONUS = 1e3

N_EXPERTS = 16
N_EXPERT_GROUPS = 4
EXPERTS_PER_GROUP = N_EXPERTS // N_EXPERT_GROUPS
TOP_K = 2
D_EXPERT = 512

kernel_name = 'hybrid_retnet_nsa_moe'


def layer_norm(x, g, b):
    xf = x.astype(jnp.float32)
    mu = xf.mean(-1, keepdims=True)
    var = jnp.square(xf - mu).mean(-1, keepdims=True)
    y = (xf - mu) * lax.rsqrt(var + LN_EPS) * g.astype(jnp.float32) + b.astype(jnp.float32)
    return y.astype(x.dtype)


def rope(x, pos):
    d = x.shape[-1]
    inv = ROPE_THETA ** (-jnp.arange(0, d, 2, dtype=jnp.float32) / d)
    ang = pos.astype(jnp.float32)[:, None] * inv[None, :]
    cos = jnp.cos(ang)[None, :, None, :]
    sin = jnp.sin(ang)[None, :, None, :]
    xf = x.astype(jnp.float32)
    x1, x2 = xf[..., : d // 2], xf[..., d // 2:]
    return jnp.concatenate([x1 * cos - x2 * sin, x2 * cos + x1 * sin], -1).astype(x.dtype)


def masked_softmax(s, mask):
    p = jax.nn.softmax(jnp.where(mask, s, NEG), axis=-1)
    return jnp.where(mask, p, 0.0)


def retention(h, w_in, w_out):
    B, S, _ = h.shape
    dt = h.dtype
    H, dk, dv, C = RET_HEADS, RET_DK, RET_DV, RET_CHUNK
    proj = h @ w_in
    q, k, v, g = jnp.split(proj, [H * dk, 2 * H * dk, 2 * H * dk + H * dv], axis=-1)
    pos = jnp.arange(S)
    q = rope(q.reshape(B, S, H, dk), pos)
    k = rope(k.reshape(B, S, H, dk), pos) * (dk ** -0.5)
    v = v.reshape(B, S, H, dv)
    nC = S // C

    def chunks(t):
        return t.reshape(B, nC, C, H, -1).transpose(0, 3, 1, 2, 4)

    qc, kc, vc = chunks(q), chunks(k), chunks(v)
    log_gamma = jnp.log1p(-(2.0 ** (-5.0 - jnp.arange(H, dtype=jnp.float32))))
    idx = jnp.arange(C, dtype=jnp.float32)
    diff = idx[:, None] - idx[None, :]
    decay_mask = jnp.where(diff >= 0, jnp.exp(log_gamma[:, None, None] * jnp.maximum(diff, 0.0)), 0.0).astype(dt)
    inner = jnp.einsum('bhncd,bhnmd->bhncm', qc, kc) * decay_mask[None, :, None]
    o_inner = jnp.einsum('bhncm,bhnme->bhnce', inner, vc)
    q_decay = jnp.exp(log_gamma[:, None] * (idx[None, :] + 1.0)).astype(dt)
    k_decay = jnp.exp(log_gamma[:, None] * (C - 1.0 - idx[None, :])).astype(dt)
    chunk_decay = jnp.exp(log_gamma * C).astype(dt)

    def step(state, xs):
        q_i, k_i, v_i = xs
        o = jnp.einsum('bhcd,bhde->bhce', q_i * q_decay[None, :, :, None], state)
        state = state * chunk_decay[None, :, None, None] + jnp.einsum(
            'bhcd,bhce->bhde', k_i * k_decay[None, :, :, None], v_i)
        return state, o

    state0 = jnp.zeros((B, H, dk, dv), dt)
    _, o_cross = lax.scan(step, state0, (qc.transpose(2, 0, 1, 3, 4),
                                         kc.transpose(2, 0, 1, 3, 4),
                                         vc.transpose(2, 0, 1, 3, 4)))
    o = o_inner + o_cross.transpose(1, 2, 0, 3, 4)
    o = o.transpose(0, 2, 3, 1, 4).reshape(B, S, H, dv)
    of = o.astype(jnp.float32)
    mu = of.mean(-1, keepdims=True)
    var = jnp.square(of - mu).mean(-1, keepdims=True)
    o = ((of - mu) * lax.rsqrt(var + LN_EPS)).reshape(B, S, H * dv).astype(dt)
    return (jax.nn.silu(g) * o) @ w_out


def nsa_shared_kv(h, w_kv, cmp_pe_k, cmp_pe_v, cmp_k_w1, cmp_k_w2, cmp_v_w1, cmp_v_w2):
    B, S, _ = h.shape
    G, dh = NSA_GROUPS, NSA_DH
    pos = jnp.arange(S)
    parts = jnp.split(h @ w_kv, 6, axis=-1)
    kc, vc, ks, vs, kw, vw = [p.reshape(B, S, G, dh) for p in parts]
    kc, ks, kw = rope(kc, pos), rope(ks, pos), rope(kw, pos)
    n_cmp = (S - CMP_LEN) // CMP_STRIDE + 1
    cidx = jnp.arange(n_cmp)[:, None] * CMP_STRIDE + jnp.arange(CMP_LEN)[None, :]

    def compress(t, pe, w1, w2):
        blk = t[:, cidx] + pe[None, None, :, None, :]
        blk = blk.transpose(0, 3, 1, 2, 4).reshape(B, G, n_cmp, CMP_LEN * dh)
        return jax.nn.gelu(blk @ w1) @ w2

    k_cmp = compress(kc, cmp_pe_k, cmp_k_w1, cmp_k_w2)
    v_cmp = compress(vc, cmp_pe_v, cmp_v_w1, cmp_v_w2)
    nS = S // SLC_BLOCK

    def to_blocks(t):
        return t.transpose(0, 2, 1, 3).reshape(B, G, nS, SLC_BLOCK, dh)

    def pad_win(t):
        return jnp.pad(t.transpose(0, 2, 1, 3), ((0, 0), (0, 0), (WINDOW, 0), (0, 0)))

    return (k_cmp, v_cmp, to_blocks(ks), to_blocks(vs), pad_win(kw), pad_win(vw))


def nsa_attention(h, w_in, w_out, shared):
    k_cmp, v_cmp, k_slc, v_slc, k_win, v_win = shared
    B, S, _ = h.shape
    dt = h.dtype
    H, G, R, dh = NSA_HEADS, NSA_GROUPS, NSA_REP, NSA_DH
    proj = h @ w_in
    q = rope(proj[..., : H * dh].reshape(B, S, H, dh), jnp.arange(S)) * (dh ** -0.5)
    gates = jax.nn.sigmoid(proj[..., H * dh:].astype(jnp.float32)).reshape(B, S, H, 3)
    nQ = S // Q_BLOCK
    q_blocks = q.reshape(B, nQ, Q_BLOCK, G, R, dh).transpose(1, 0, 3, 4, 2, 5)
    g_blocks = gates.reshape(B, nQ, Q_BLOCK, G, R, 3).transpose(1, 0, 3, 4, 2, 5)
    n_cmp = k_cmp.shape[2]
    nS = k_slc.shape[2]
    top_k = min(SLC_TOPK, nS)
    ci = jnp.arange(n_cmp)
    sj = jnp.arange(nS)
    cmp_end = ci * CMP_STRIDE + CMP_LEN - 1
    overlap = ((ci[:, None] * CMP_STRIDE < (sj[None, :] + 1) * SLC_BLOCK)
               & (ci[:, None] * CMP_STRIDE + CMP_LEN > sj[None, :] * SLC_BLOCK)).astype(jnp.float32)
    gather_blocks = jax.vmap(jax.vmap(lambda kb, ix: kb[ix]))

    def block(xs):
        i, qb, gb = xs
        t = i * Q_BLOCK + jnp.arange(Q_BLOCK)
        s = jnp.einsum('bgrqd,bgnd->bgrqn', qb, k_cmp).astype(jnp.float32)
        p_cmp = masked_softmax(s, cmp_end[None, :] <= t[:, None])
        o_cmp = jnp.einsum('bgrqn,bgnd->bgrqd', p_cmp.astype(dt), v_cmp)
        imp = jnp.einsum('bgrqn,ns->bgqs', p_cmp, overlap)
        valid = sj[None, :] * SLC_BLOCK <= t[:, None]
        cur = t // SLC_BLOCK
        forced = (sj[None, :] == 0) | (sj[None, :] == cur[:, None]) | (sj[None, :] == cur[:, None] - 1)
        score = jnp.where(valid, imp + jnp.where(forced, FORCE_BONUS, 0.0), NEG)
        _, sel = lax.top_k(score, top_k)
        ks = gather_blocks(k_slc, sel).reshape(B, G, Q_BLOCK, top_k * SLC_BLOCK, dh)
        vs = gather_blocks(v_slc, sel).reshape(B, G, Q_BLOCK, top_k * SLC_BLOCK, dh)
        key_pos = (sel[..., None] * SLC_BLOCK + jnp.arange(SLC_BLOCK)).reshape(B, G, Q_BLOCK, top_k * SLC_BLOCK)
        s = jnp.einsum('bgrqd,bgqkd->bgrqk', qb, ks).astype(jnp.float32)
        p = masked_softmax(s, (key_pos <= t[:, None])[:, :, None])
        o_slc = jnp.einsum('bgrqk,bgqkd->bgrqd', p.astype(dt), vs)
        kw = lax.dynamic_slice_in_dim(k_win, i * Q_BLOCK, Q_BLOCK + WINDOW, axis=2)
        vw = lax.dynamic_slice_in_dim(v_win, i * Q_BLOCK, Q_BLOCK + WINDOW, axis=2)
        wpos = i * Q_BLOCK - WINDOW + jnp.arange(Q_BLOCK + WINDOW)
        dist = t[:, None] - wpos[None, :]
        wmask = (dist >= 0) & (dist < WINDOW) & (wpos[None, :] >= 0)
        s = jnp.einsum('bgrqd,bgkd->bgrqk', qb, kw).astype(jnp.float32)
        p = masked_softmax(s, wmask)
        o_win = jnp.einsum('bgrqk,bgkd->bgrqd', p.astype(dt), vw)
        o = gb[..., 0:1] * o_cmp + gb[..., 1:2] * o_slc + gb[..., 2:3] * o_win
        return o.astype(dt)

    o = lax.map(block, (jnp.arange(nQ), q_blocks, g_blocks))
    o = o.transpose(1, 0, 4, 2, 3, 5).reshape(B, S, H * dh)
    return o @ w_out


def moe(h, router_w, router_b, w_gate, w_up, w_down):
    B, S, D = h.shape
    x = h.reshape(-1, D)
    T = x.shape[0]
    aff = jax.nn.sigmoid((x @ router_w).astype(jnp.float32))
    sel_score = aff + router_b.astype(jnp.float32)
    grp_score = lax.top_k(sel_score.reshape(T, N_EXPERT_GROUPS, EXPERTS_PER_GROUP), TOP_K)[0].sum(-1)
    best = jnp.argmax(grp_score, axis=-1)
    in_group = (jnp.arange(N_EXPERTS) // EXPERTS_PER_GROUP)[None, :] == best[:, None]
    _, top_idx = lax.top_k(jnp.where(in_group, sel_score, NEG), TOP_K)
    chosen = jax.nn.one_hot(top_idx, N_EXPERTS, dtype=jnp.float32).sum(1)
    w = aff * chosen
    w = (w / w.sum(-1, keepdims=True)).astype(x.dtype)
    y = jnp.zeros_like(x)
    for e in range(N_EXPERTS):
        he = (jax.nn.silu(x @ w_gate[e]) * (x @ w_up[e])) @ w_down[e]
        y = y + w[:, e:e + 1] * he
    return y.reshape(B, S, D)


def setup_inputs(seed: int = 0) -> dict:
    key = jax.random.key(seed)
    ks = jax.random.split(key, 32)
    f32 = jnp.float32
    D = D_MODEL

    def nrm(k, shape, scale):
        return jax.random.normal(k, shape, f32) * scale

    x = nrm(ks[0], (BATCH, SEQ, D), 1.0)
    ret_w_in = jnp.concatenate([
        nrm(ks[1], (N_A_LAYERS, D, 2 * RET_HEADS * RET_DK), D ** -0.5),
        nrm(ks[2], (N_A_LAYERS, D, RET_HEADS * RET_DV), D ** -0.5 * BETA),
        nrm(ks[3], (N_A_LAYERS, D, RET_HEADS * RET_DV), D ** -0.5)], axis=-1)
    ret_w_out = nrm(ks[4], (N_A_LAYERS, RET_HEADS * RET_DV, D), (RET_HEADS * RET_DV) ** -0.5 * BETA)
    kv_k = nrm(ks[5], (3, D, KV_W), D ** -0.5)
    kv_v = nrm(ks[6], (3, D, KV_W), D ** -0.5 * BETA)
    nsa_w_kv = jnp.stack([kv_k, kv_v], 1).transpose(2, 0, 1, 3).reshape(D, 6 * KV_W)
    cmp_pe_k = nrm(ks[7], (CMP_LEN, NSA_DH), 0.1)
    cmp_pe_v = nrm(ks[8], (CMP_LEN, NSA_DH), 0.1)
    cmp_k_w1 = nrm(ks[9], (CMP_LEN * NSA_DH, CMP_HIDDEN), (CMP_LEN * NSA_DH) ** -0.5)
    cmp_k_w2 = nrm(ks[10], (CMP_HIDDEN, NSA_DH), CMP_HIDDEN ** -0.5)
    cmp_v_w1 = nrm(ks[11], (CMP_LEN * NSA_DH, CMP_HIDDEN), (CMP_LEN * NSA_DH) ** -0.5)
    cmp_v_w2 = nrm(ks[12], (CMP_HIDDEN, NSA_DH), CMP_HIDDEN ** -0.5)
    nsa_w_in = nrm(ks[13], (N_B_LAYERS, D, NSA_HEADS * NSA_DH + 3 * NSA_HEADS), D ** -0.5)
    nsa_w_out = nrm(ks[14], (N_B_LAYERS, NSA_HEADS * NSA_DH, D), (NSA_HEADS * NSA_DH) ** -0.5 * BETA)
    router_w = nrm(ks[15], (D, N_EXPERTS), D ** -0.5)
    router_b = nrm(ks[16], (N_EXPERTS,), 0.01)
    moe_w_gate = nrm(ks[17], (DEPTH, N_EXPERTS, D, D_EXPERT), D ** -0.5)
    moe_w_up = nrm(ks[18], (DEPTH, N_EXPERTS, D, D_EXPERT), D ** -0.5 * BETA)
    moe_w_down = nrm(ks[19], (DEPTH, N_EXPERTS, D_EXPERT, D), D_EXPERT ** -0.5 * BETA)
    ln_mix_g = 1.0 + nrm(ks[20], (DEPTH, D), 0.02)
    ln_mix_b = nrm(ks[21], (DEPTH, D), 0.02)
    ln_ffn_g = 1.0 + nrm(ks[22], (DEPTH, D), 0.02)
    ln_ffn_b = nrm(ks[23], (DEPTH, D), 0.02)
    return {'x': x, 'ret_w_in': ret_w_in, 'ret_w_out': ret_w_out, 'nsa_w_kv': nsa_w_kv,
            'cmp_pe_k': cmp_pe_k, 'cmp_pe_v': cmp_pe_v, 'cmp_k_w1': cmp_k_w1, 'cmp_k_w2': cmp_k_w2,
            'cmp_v_w1': cmp_v_w1, 'cmp_v_w2': cmp_v_w2, 'nsa_w_in': nsa_w_in, 'nsa_w_out': nsa_w_out,
            'router_w': router_w, 'router_b': router_b, 'moe_w_gate': moe_w_gate, 'moe_w_up': moe_w_up,
            'moe_w_down': moe_w_down, 'ln_mix_g': ln_mix_g, 'ln_mix_b': ln_mix_b,
            'ln_ffn_g': ln_ffn_g, 'ln_ffn_b': ln_ffn_b}


def reference(x, ret_w_in, ret_w_out, nsa_w_kv, cmp_pe_k, cmp_pe_v, cmp_k_w1, cmp_k_w2, cmp_v_w1, cmp_v_w2,
              nsa_w_in, nsa_w_out, router_w, router_b, moe_w_gate, moe_w_up, moe_w_down,
              ln_mix_g, ln_mix_b, ln_ffn_g, ln_ffn_b):
    h = x
    shared = None
    for l in range(DEPTH):
        if l < N_A_LAYERS:
            mix = retention(h, ret_w_in[l], ret_w_out[l])
        else:
            if l == N_A_LAYERS:
                shared = nsa_shared_kv(h, nsa_w_kv, cmp_pe_k, cmp_pe_v, cmp_k_w1, cmp_k_w2, cmp_v_w1, cmp_v_w2)
            j = l - N_A_LAYERS
            mix = nsa_attention(h, nsa_w_in[j], nsa_w_out[j], shared)
        h = layer_norm(ALPHA * h + mix, ln_mix_g[l], ln_mix_b[l])
        h = layer_norm(ALPHA * h + moe(h, router_w, router_b, moe_w_gate[l], moe_w_up[l], moe_w_down[l]),
                       ln_ffn_g[l], ln_ffn_b[l])
    return h
```

```cpp
#include <hip/hip_runtime.h>
#include <hip/hip_cooperative_groups.h>
#include <cstdio>
#include <cstdint>
namespace cg = cooperative_groups;

typedef unsigned short bf16_t;
typedef short bf16x8 __attribute__((ext_vector_type(8)));
typedef float f32x4 __attribute__((ext_vector_type(4)));
typedef unsigned u32x4 __attribute__((ext_vector_type(4)));
typedef unsigned u32x2 __attribute__((ext_vector_type(2)));

#define NT 512
constexpr int T_ = 16384, D_ = 1024, S_ = 8192;
constexpr size_t MiB = 1u << 20;
constexpr size_t XB = 0, WT_IN = 32 * MiB, QB = 44 * MiB, KB = 76 * MiB, VB = 108 * MiB, GB = 172 * MiB;
constexpr size_t WT_OUT = 246 * MiB, MOEW_GU = 250 * MiB, MOEW_D = 282 * MiB;
constexpr size_t H_F32 = 0, H_BF = 64 * MiB, YEXP = 96 * MiB, XS = 172 * MiB, MISC = 244 * MiB;
constexpr size_t WT_KVQ = 236 * MiB, WT_NSAOUT = 242 * MiB;
constexpr size_t KVQ = 96 * MiB, GATES = 180 * MiB, HC = 183 * MiB, KCMP = 191 * MiB, MLB = 193 * MiB, SEL = 195 * MiB, ATTN_OUT = 199 * MiB;
constexpr size_t MIX2 = 96 * MiB;
constexpr size_t WS_NEEDED = 298 * MiB;
constexpr int KVQ_LD = 2688;
constexpr int MI_CNT = 0, MI_TE = 1024, MI_TW = MI_TE + 32768, MI_TI = MI_TW + 32768, MI_TR = MI_TI + 32768;

struct Params {
    const float *x, *ret_w_in, *ret_w_out, *nsa_w_kv, *pe_k, *pe_v, *ck_w1, *ck_w2, *cv_w1, *cv_w2, *nsa_w_in, *nsa_w_out,
        *router_w, *router_b, *moe_wg, *moe_wu, *moe_wd, *ln_mix_g, *ln_mix_b, *ln_ffn_g, *ln_ffn_b;
    float* out; unsigned char* ws;
};

__device__ __forceinline__ bf16_t f2bf(float f) { unsigned u = __float_as_uint(f); u += 0x7fffu + ((u >> 16) & 1u); return (bf16_t)(u >> 16); }
__device__ __forceinline__ float bf2f(bf16_t h) { return __uint_as_float(((unsigned)h) << 16); }
__device__ __forceinline__ unsigned pack2(float a, float b) { return (unsigned)f2bf(a) | ((unsigned)f2bf(b) << 16); }
__device__ __forceinline__ float lo2f(unsigned u) { return __uint_as_float(u << 16); }
__device__ __forceinline__ float hi2f(unsigned u) { return __uint_as_float(u & 0xffff0000u); }
__device__ __forceinline__ float wave_sum(float v) {
#pragma unroll
    for (int o = 32; o > 0; o >>= 1) v += __shfl_xor(v, o);
    return v;
}
__device__ __forceinline__ float wave_max(float v) {
#pragma unroll
    for (int o = 32; o > 0; o >>= 1) v = fmaxf(v, __shfl_xor(v, o));
    return v;
}
__device__ __forceinline__ int gtid() { return blockIdx.x * NT + threadIdx.x; }
__device__ __forceinline__ int gthreads() { return gridDim.x * NT; }
__device__ __forceinline__ int gwave() { return (threadIdx.x >> 6) * gridDim.x + blockIdx.x; }
__device__ __forceinline__ int gwaves() { return gridDim.x * (NT / 64); }
__device__ __forceinline__ void unpack8(u32x4 u, float* f) {
    f[0] = lo2f(u.x); f[1] = hi2f(u.x); f[2] = lo2f(u.y); f[3] = hi2f(u.y); f[4] = lo2f(u.z); f[5] = hi2f(u.z); f[6] = lo2f(u.w); f[7] = hi2f(u.w);
}

template <class F> __device__ __forceinline__ void transpose_conv(F src, bf16_t* dst, int K, int N, float* tile) {
    const int tilesK = K >> 6, ntile = (N >> 6) * tilesK;
    for (int t = blockIdx.x; t < ntile; t += gridDim.x) {
        const int n0 = (t / tilesK) << 6, k0 = (t % tilesK) << 6;
#pragma unroll
        for (int i = 0; i < 8; ++i) { const int idx = threadIdx.x + i * NT, kk = idx >> 6, r = idx & 63; tile[kk * 65 + r] = src(k0 + kk, n0 + r); }
        __syncthreads();
#pragma unroll
        for (int i = 0; i < 8; ++i) { const int idx = threadIdx.x + i * NT, r = idx >> 6, kk = idx & 63; dst[(size_t)(n0 + r) * K + k0 + kk] = f2bf(tile[kk * 65 + r]); }
        __syncthreads();
    }
}

template <class Epi> __device__ __forceinline__ void gemm_tile(const bf16_t* __restrict__ A, int lda, const bf16_t* __restrict__ Bt, int ldb, int K, const Epi& epi, unsigned char* smem) {
    const int tid = threadIdx.x, lane = tid & 63, wid = tid >> 6, wm = wid >> 1, wn = wid & 1, fr = lane & 15, fq = lane >> 4;
    bf16_t* As = (bf16_t*)smem;
    bf16_t* Bs = As + 256 * 72;
    f32x4 acc[4][4];
#pragma unroll
    for (int i = 0; i < 4; ++i)
#pragma unroll
        for (int j = 0; j < 4; ++j) acc[i][j] = (f32x4){0.f, 0.f, 0.f, 0.f};
    u32x4 ra[4], rb[2];
    const int lrow = tid >> 3, lkc = tid & 7;
    const bf16_t* ag = A + (size_t)lrow * lda + lkc * 8;
    const bf16_t* bg = Bt + (size_t)lrow * ldb + lkc * 8;
#pragma unroll
    for (int i = 0; i < 4; ++i) ra[i] = *(const u32x4*)(ag + (size_t)i * 64 * lda);
#pragma unroll
    for (int i = 0; i < 2; ++i) rb[i] = *(const u32x4*)(bg + (size_t)i * 64 * ldb);
    const int nk = K >> 6;
    for (int kt = 0; kt < nk; ++kt) {
#pragma unroll
        for (int i = 0; i < 4; ++i) *(u32x4*)(As + (lrow + i * 64) * 72 + lkc * 8) = ra[i];
#pragma unroll
        for (int i = 0; i < 2; ++i) *(u32x4*)(Bs + (lrow + i * 64) * 72 + lkc * 8) = rb[i];
        __syncthreads();
        if (kt + 1 < nk) {
            const int k0 = (kt + 1) << 6;
#pragma unroll
            for (int i = 0; i < 4; ++i) ra[i] = *(const u32x4*)(ag + (size_t)i * 64 * lda + k0);
#pragma unroll
            for (int i = 0; i < 2; ++i) rb[i] = *(const u32x4*)(bg + (size_t)i * 64 * ldb + k0);
        }
#pragma unroll
        for (int s = 0; s < 2; ++s) {
            bf16x8 af[4], bfr[4];
#pragma unroll
            for (int i = 0; i < 4; ++i) af[i] = *(const bf16x8*)(As + (wm * 64 + i * 16 + fr) * 72 + s * 32 + fq * 8);
#pragma unroll
            for (int j = 0; j < 4; ++j) bfr[j] = *(const bf16x8*)(Bs + (wn * 64 + j * 16 + fr) * 72 + s * 32 + fq * 8);
#pragma unroll
            for (int i = 0; i < 4; ++i)
#pragma unroll
                for (int j = 0; j < 4; ++j) acc[i][j] = __builtin_amdgcn_mfma_f32_16x16x32_bf16(bfr[j], af[i], acc[i][j], 0, 0, 0);
        }
        __syncthreads();
    }
#pragma unroll
    for (int i = 0; i < 4; ++i)
#pragma unroll
        for (int j = 0; j < 4; ++j) epi(wm * 64 + i * 16 + fr, wn * 64 + j * 16 + fq * 4, acc[i][j]);
}

struct EpiBf16 { bf16_t* C; int ldc;
    __device__ __forceinline__ void operator()(int m, int n, f32x4 v) const { *(uint2*)(C + (size_t)m * ldc + n) = make_uint2(pack2(v[0], v[1]), pack2(v[2], v[3])); } };
struct EpiF32 { float* C; int ldc;
    __device__ __forceinline__ void operator()(int m, int n, f32x4 v) const { *(float4*)(C + (size_t)m * ldc + n) = make_float4(v[0], v[1], v[2], v[3]); } };
struct EpiSwiglu { bf16_t* C; int ldc;
    __device__ __forceinline__ void operator()(int m, int n, f32x4 v) const {
        const float a0 = v[0] / (1.f + __expf(-v[0])) * v[1], a1 = v[2] / (1.f + __expf(-v[2])) * v[3];
        *(unsigned*)(C + (size_t)m * ldc + (n >> 1)) = pack2(a0, a1); } };

__device__ void ph_prep0(const Params& p, unsigned char* smem) {
    if (blockIdx.x == 0 && threadIdx.x < 64) ((int*)(p.ws + MISC))[MI_CNT + threadIdx.x] = 0;
    {   const float4* x4 = (const float4*)p.x; uint2* xb = (uint2*)(p.ws + XB);
        for (int i = gtid(); i < T_ * D_ / 4; i += gthreads()) { const float4 v = x4[i]; xb[i] = make_uint2(pack2(v.x, v.y), pack2(v.z, v.w)); } }
    float* tile = (float*)smem;
    { const float* w = p.ret_w_in; transpose_conv([w](int k, int n) { return w[(size_t)k * 6144 + n]; }, (bf16_t*)(p.ws + WT_IN), 1024, 6144, tile); }
    { const float* w = p.ret_w_out; transpose_conv([w](int k, int n) { return w[(size_t)k * 1024 + n]; }, (bf16_t*)(p.ws + WT_OUT), 2048, 1024, tile); }
}
__device__ void ph_moe_weights(const Params& p, int l, unsigned char* smem) {
    float* tile = (float*)smem;
    { const float* wg = p.moe_wg + (size_t)l * 16 * 1024 * 512; const float* wu = p.moe_wu + (size_t)l * 16 * 1024 * 512;
      const ptrdiff_t du = wu - wg;
      transpose_conv([wg, du](int k, int n) { const int e = n >> 10, c = n & 1023; return wg[(ptrdiff_t)(c & 1) * du + ((size_t)e * 1024 + k) * 512 + (c >> 1)]; },
                     (bf16_t*)(p.ws + MOEW_GU), 1024, 16 * 1024, tile); }
    { const float* wd = p.moe_wd + (size_t)l * 16 * 512 * 1024;
      transpose_conv([wd](int k, int n) { const int e = n >> 10, c = n & 1023; return wd[((size_t)e * 512 + k) * 1024 + c]; }, (bf16_t*)(p.ws + MOEW_D), 512, 16 * 1024, tile); }
}
__device__ void ph_prep1(const Params& p, unsigned char* smem) {
    float* tile = (float*)smem;
    { const float* wkv = p.nsa_w_kv; const float* win = p.nsa_w_in;
      transpose_conv([wkv, win](int k, int n) { return n < 1536 ? wkv[(size_t)k * 1536 + n] : (n < 2608 ? win[(size_t)k * 1072 + (n - 1536)] : 0.f); },
                     (bf16_t*)(p.ws + WT_KVQ), 1024, KVQ_LD, tile); }
    { const float* w = p.nsa_w_out; transpose_conv([w](int k, int n) { return w[(size_t)k * 1024 + n]; }, (bf16_t*)(p.ws + WT_NSAOUT), 1024, 1024, tile); }
}

__device__ void ph_gemm_retin(const Params& p, unsigned char* smem) {
    const bf16_t* A = (const bf16_t*)(p.ws + XB); const bf16_t* Bt = (const bf16_t*)(p.ws + WT_IN);
    for (int t = blockIdx.x; t < 64 * 48; t += gridDim.x) {
        const int mt = t / 48, nt = t % 48, n0 = nt * 128;
        bf16_t* C; int ldc;
        if (n0 < 1024) { C = (bf16_t*)(p.ws + QB) + n0; ldc = 1024; }
        else if (n0 < 2048) { C = (bf16_t*)(p.ws + KB) + (n0 - 1024); ldc = 1024; }
        else if (n0 < 4096) { C = (bf16_t*)(p.ws + VB) + (n0 - 2048); ldc = 2048; }
        else { C = (bf16_t*)(p.ws + GB) + (n0 - 4096); ldc = 2048; }
        gemm_tile(A + (size_t)mt * 256 * 1024, 1024, Bt + (size_t)n0 * 1024, 1024, 1024, EpiBf16{C + (size_t)mt * 256 * ldc, ldc}, smem);
    }
}
__device__ void ph_gemm_f32(const bf16_t* A, const bf16_t* Bt, float* C, int Mt, int Nt, int K, int N, unsigned char* smem) {
    for (int t = blockIdx.x; t < Mt * Nt; t += gridDim.x) {
        const int mt = t / Nt, nt = t % Nt;
        gemm_tile(A + (size_t)mt * 256 * K, K, Bt + (size_t)nt * 128 * K, K, K, EpiF32{C + (size_t)mt * 256 * N + nt * 128, N}, smem);
    }
}
__device__ void ph_gemm_bf16(const bf16_t* A, const bf16_t* Bt, bf16_t* C, int Mt, int Nt, int K, int N, unsigned char* smem) {
    for (int t = blockIdx.x; t < Mt * Nt; t += gridDim.x) {
        const int mt = t / Nt, nt = t % Nt;
        gemm_tile(A + (size_t)mt * 256 * K, K, Bt + (size_t)nt * 128 * K, K, K, EpiBf16{C + (size_t)mt * 256 * N + nt * 128, N}, smem);
    }
}

__device__ void ph_rope_ret(const Params& p) {
    bf16_t* Q = (bf16_t*)(p.ws + QB); bf16_t* K = (bf16_t*)(p.ws + KB);
    for (int it = gtid(); it < T_ * 4 * 128; it += gthreads()) {
        const int i = it & 127, h = (it >> 7) & 3, tok = it >> 9, t = tok & (S_ - 1);
        const float inv = (float)pow(10000.0, (double)(-(float)(2 * i) / 256.0f));
        const float ang = (float)t * inv, c = cosf(ang), s = sinf(ang);
        const size_t o = (size_t)tok * 1024 + h * 256 + i;
        { const float x1 = bf2f(Q[o]), x2 = bf2f(Q[o + 128]); Q[o] = f2bf(x1 * c - x2 * s); Q[o + 128] = f2bf(x2 * c + x1 * s); }
        { const float x1 = bf2f(K[o]), x2 = bf2f(K[o + 128]); K[o] = f2bf((x1 * c - x2 * s) * 0.0625f); K[o + 128] = f2bf((x2 * c + x1 * s) * 0.0625f); }
    }
}
__device__ void ph_ret_naive(const Params& p) {
    const bf16_t* Q = (const bf16_t*)(p.ws + QB); const bf16_t* K = (const bf16_t*)(p.ws + KB); const bf16_t* V = (const bf16_t*)(p.ws + VB);
    bf16_t* O = (bf16_t*)p.out;
    const int lane = threadIdx.x & 63, W = gwave();
    if (W >= 512) return;
    const int b = W >> 8, h = (W >> 6) & 3, e = ((W & 63) << 3) + (lane >> 3), part = lane & 7;
    const float gamma = 1.f - exp2f(-5.f - (float)h);
    float S[32];
#pragma unroll
    for (int i = 0; i < 32; ++i) S[i] = 0.f;
    for (int t = 0; t < S_; ++t) {
        const size_t tok = (size_t)b * S_ + t;
        const u32x4* kp = (const u32x4*)(K + tok * 1024 + h * 256 + part * 32);
        const u32x4* qp = (const u32x4*)(Q + tok * 1024 + h * 256 + part * 32);
        const float v = bf2f(V[tok * 2048 + h * 512 + e]);
        float o = 0.f;
#pragma unroll
        for (int c = 0; c < 4; ++c) {
            float kf[8], qf[8]; unpack8(kp[c], kf); unpack8(qp[c], qf);
#pragma unroll
            for (int j = 0; j < 8; ++j) { S[c * 8 + j] = S[c * 8 + j] * gamma + kf[j] * v; o += qf[j] * S[c * 8 + j]; }
        }
        o += __shfl_xor(o, 1); o += __shfl_xor(o, 2); o += __shfl_xor(o, 4);
        if (part == 0) O[tok * 2048 + h * 512 + e] = f2bf(o);
    }
}
__device__ void ph_gnorm_gate(const Params& p) {
    bf16_t* O = (bf16_t*)p.out; const bf16_t* G = (const bf16_t*)(p.ws + GB);
    const int lane = threadIdx.x & 63;
    for (int it = gwave(); it < T_ * 4; it += gwaves()) {
        const size_t off = (size_t)it * 512 + lane * 8;
        float x[8], g[8]; unpack8(*(const u32x4*)(O + off), x); unpack8(*(const u32x4*)(G + off), g);
        float s = 0.f;
#pragma unroll
        for (int j = 0; j < 8; ++j) s += x[j];
        const float mean = wave_sum(s) * (1.f / 512.f);
        float q = 0.f;
#pragma unroll
        for (int j = 0; j < 8; ++j) { x[j] -= mean; q += x[j] * x[j]; }
        const float rstd = rsqrtf(wave_sum(q) * (1.f / 512.f) + 1e-5f);
        float r[8];
#pragma unroll
        for (int j = 0; j < 8; ++j) r[j] = x[j] * rstd * (g[j] / (1.f + __expf(-g[j])));
        *(uint4*)(O + off) = make_uint4(pack2(r[0], r[1]), pack2(r[2], r[3]), pack2(r[4], r[5]), pack2(r[6], r[7]));
    }
}

template <bool COMBINE, bool ROUTER, bool FINAL>
__device__ void ph_ln(const Params& p, const float* base, const float* mix, float* hout, bf16_t* hb, const float* lng, const float* lnb, int layer) {
    const int lane = threadIdx.x & 63;
    int* misc = (int*)(p.ws + MISC);
    const bf16_t* yexp = (const bf16_t*)(p.ws + YEXP);
    for (int tok = gwave(); tok < T_; tok += gwaves()) {
        float v[16];
        float w0 = 0.f, w1 = 0.f; int r0 = 0, r1 = 0;
        if (COMBINE) { w0 = __int_as_float(misc[MI_TW + tok * 2]); w1 = __int_as_float(misc[MI_TW + tok * 2 + 1]); r0 = misc[MI_TR + tok * 2]; r1 = misc[MI_TR + tok * 2 + 1]; }
#pragma unroll
        for (int i = 0; i < 4; ++i) {
            const float4 a = *(const float4*)(base + (size_t)tok * 1024 + i * 256 + lane * 4);
            float4 m;
            if (COMBINE) {
                const uint2 y0 = *(const uint2*)(yexp + (size_t)r0 * 1024 + i * 256 + lane * 4), y1 = *(const uint2*)(yexp + (size_t)r1 * 1024 + i * 256 + lane * 4);
                m.x = w0 * lo2f(y0.x) + w1 * lo2f(y1.x); m.y = w0 * hi2f(y0.x) + w1 * hi2f(y1.x); m.z = w0 * lo2f(y0.y) + w1 * lo2f(y1.y); m.w = w0 * hi2f(y0.y) + w1 * hi2f(y1.y);
            } else m = *(const float4*)(mix + (size_t)tok * 1024 + i * 256 + lane * 4);
            v[i * 4 + 0] = 1.41421356237f * a.x + m.x; v[i * 4 + 1] = 1.41421356237f * a.y + m.y; v[i * 4 + 2] = 1.41421356237f * a.z + m.z; v[i * 4 + 3] = 1.41421356237f * a.w + m.w;
        }
        float s = 0.f;
#pragma unroll
        for (int i = 0; i < 16; ++i) s += v[i];
        const float mean = wave_sum(s) * (1.f / 1024.f);
        float q = 0.f;
#pragma unroll
        for (int i = 0; i < 16; ++i) { v[i] -= mean; q += v[i] * v[i]; }
        const float rstd = rsqrtf(wave_sum(q) * (1.f / 1024.f) + 1e-5f);
#pragma unroll
        for (int i = 0; i < 4; ++i) {
            const float4 g = *(const float4*)(lng + i * 256 + lane * 4), bb = *(const float4*)(lnb + i * 256 + lane * 4);
            v[i * 4 + 0] = v[i * 4 + 0] * rstd * g.x + bb.x; v[i * 4 + 1] = v[i * 4 + 1] * rstd * g.y + bb.y; v[i * 4 + 2] = v[i * 4 + 2] * rstd * g.z + bb.z; v[i * 4 + 3] = v[i * 4 + 3] * rstd * g.w + bb.w;
            *(float4*)(hout + (size_t)tok * 1024 + i * 256 + lane * 4) = make_float4(v[i * 4 + 0], v[i * 4 + 1], v[i * 4 + 2], v[i * 4 + 3]);
            if (!FINAL) *(uint2*)(hb + (size_t)tok * 1024 + i * 256 + lane * 4) = make_uint2(pack2(v[i * 4 + 0], v[i * 4 + 1]), pack2(v[i * 4 + 2], v[i * 4 + 3]));
        }
        if (ROUTER) {
            float lg[16];
#pragma unroll
            for (int e = 0; e < 16; ++e) lg[e] = 0.f;
#pragma unroll
            for (int i = 0; i < 4; ++i)
#pragma unroll
                for (int j = 0; j < 4; ++j) {
                    const float4* rw = (const float4*)(p.router_w + (size_t)(i * 256 + lane * 4 + j) * 16);
                    const float hv = v[i * 4 + j];
#pragma unroll
                    for (int e4 = 0; e4 < 4; ++e4) { const float4 r = rw[e4]; lg[e4 * 4 + 0] += hv * r.x; lg[e4 * 4 + 1] += hv * r.y; lg[e4 * 4 + 2] += hv * r.z; lg[e4 * 4 + 3] += hv * r.w; }
                }
            float aff[16], sel[16];
#pragma unroll
            for (int e = 0; e < 16; ++e) { lg[e] = wave_sum(lg[e]); aff[e] = 1.f / (1.f + expf(-lg[e])); sel[e] = aff[e] + p.router_b[e]; }
            float best = -3.0e38f; int bg = 0; float b0 = 0, b1 = 0, b2 = 0, b3 = 0, a0 = 0, a1 = 0, a2 = 0, a3 = 0;
#pragma unroll
            for (int g = 0; g < 4; ++g) {
                const float x0 = sel[4 * g], x1 = sel[4 * g + 1], x2 = sel[4 * g + 2], x3 = sel[4 * g + 3];
                const float mx = fmaxf(fmaxf(x0, x1), fmaxf(x2, x3));
                const float m2 = fmaxf(fmaxf(fminf(x0, x1), fminf(x2, x3)), fminf(fmaxf(x0, x1), fmaxf(x2, x3)));
                const float gs = mx + m2;
                if (gs > best) { best = gs; bg = g; b0 = x0; b1 = x1; b2 = x2; b3 = x3; a0 = aff[4 * g]; a1 = aff[4 * g + 1]; a2 = aff[4 * g + 2]; a3 = aff[4 * g + 3]; }
            }
            int i1 = 0; float m = b0, wa = a0;
            if (b1 > m) { m = b1; i1 = 1; wa = a1; } if (b2 > m) { m = b2; i1 = 2; wa = a2; } if (b3 > m) { m = b3; i1 = 3; wa = a3; }
            int i2 = -1; float m2 = -3.0e38f, wb = 0.f;
            if (i1 != 0 && b0 > m2) { m2 = b0; i2 = 0; wb = a0; } if (i1 != 1 && b1 > m2) { m2 = b1; i2 = 1; wb = a1; }
            if (i1 != 2 && b2 > m2) { m2 = b2; i2 = 2; wb = a2; } if (i1 != 3 && b3 > m2) { m2 = b3; i2 = 3; wb = a3; }
            const float nrm = wa + wb;
            if (lane == 0) {
                const int e1 = bg * 4 + i1, e2 = bg * 4 + i2;
                misc[MI_TE + tok * 2] = e1; misc[MI_TE + tok * 2 + 1] = e2;
                misc[MI_TW + tok * 2] = __float_as_int(wa / nrm); misc[MI_TW + tok * 2 + 1] = __float_as_int(wb / nrm);
                misc[MI_TI + tok * 2] = atomicAdd(&misc[MI_CNT + layer * 16 + e1], 1);
                misc[MI_TI + tok * 2 + 1] = atomicAdd(&misc[MI_CNT + layer * 16 + e2], 1);
            }
        }
    }
}

__device__ __forceinline__ int moe_off(const int* cnt, int e) { int o = 0; for (int i = 0; i < e; ++i) o += (cnt[i] + 255) & ~255; return o; }
__device__ void ph_moe_scatter(const Params& p, int layer) {
    int* misc = (int*)(p.ws + MISC); const int* cnt = misc + MI_CNT + layer * 16;
    const uint4* hb = (const uint4*)(p.ws + H_BF); uint4* xs = (uint4*)(p.ws + XS);
    const int lane = threadIdx.x & 63;
    for (int it = gwave(); it < T_ * 2; it += gwaves()) {
        const int tok = it >> 1, e = misc[MI_TE + it], row = moe_off(cnt, e) + misc[MI_TI + it];
        if (lane == 0) misc[MI_TR + it] = row;
        xs[(size_t)row * 128 + lane * 2] = hb[(size_t)tok * 128 + lane * 2];
        xs[(size_t)row * 128 + lane * 2 + 1] = hb[(size_t)tok * 128 + lane * 2 + 1];
    }
}
template <int WHICH> __device__ void ph_moe_gemm(const Params& p, int layer, unsigned char* smem) {
    const int* cnt = (const int*)(p.ws + MISC) + MI_CNT + layer * 16;
    __shared__ int eoff[17];
    if (threadIdx.x == 0) { int o = 0; for (int e = 0; e < 16; ++e) { eoff[e] = o; o += (cnt[e] + 255) & ~255; } eoff[16] = o; }
    __syncthreads();
    const int Mt = eoff[16] >> 8;
    for (int t = blockIdx.x; t < Mt * 8; t += gridDim.x) {
        const int mt = t >> 3, nt = t & 7, row0 = mt << 8;
        int e = 0;
        while (e < 15 && row0 >= eoff[e + 1]) ++e;
        if (WHICH == 0) {
            const bf16_t* A = (const bf16_t*)(p.ws + XS) + (size_t)row0 * 1024;
            const bf16_t* Bt = (const bf16_t*)(p.ws + MOEW_GU) + ((size_t)e * 1024 + nt * 128) * 1024;
            gemm_tile(A, 1024, Bt, 1024, 1024, EpiSwiglu{(bf16_t*)p.out + (size_t)row0 * 512 + nt * 64, 512}, smem);
        } else {
            const bf16_t* A = (const bf16_t*)p.out + (size_t)row0 * 512;
            const bf16_t* Bt = (const bf16_t*)(p.ws + MOEW_D) + ((size_t)e * 1024 + nt * 128) * 512;
            gemm_tile(A, 512, Bt, 512, 512, EpiBf16{(bf16_t*)(p.ws + YEXP) + (size_t)row0 * 1024 + nt * 128, 1024}, smem);
        }
    }
}

__device__ void ph_rope_nsa(const Params& p) {
    bf16_t* kvq = (bf16_t*)(p.ws + KVQ); float* gates = (float*)(p.ws + GATES);
    for (int it = gtid(); it < T_ * 896; it += gthreads()) {
        const int tok = it / 896, pp = it % 896, t = tok & (S_ - 1);
        int col, i; float sc = 1.f;
        if (pp < 384) { const int part = pp >> 7, w = pp & 127; i = w & 31; col = part * 512 + (w >> 5) * 64; }
        else { const int q = pp - 384; i = q & 31; col = 1536 + (q >> 5) * 64; sc = 0.125f; }
        const float inv = (float)pow(10000.0, (double)(-(float)(2 * i) / 64.0f));
        const float ang = (float)t * inv, c = cosf(ang), s = sinf(ang);
        bf16_t* x = kvq + (size_t)tok * KVQ_LD + col + i;
        const float x1 = bf2f(x[0]), x2 = bf2f(x[32]);
        x[0] = f2bf((x1 * c - x2 * s) * sc); x[32] = f2bf((x2 * c + x1 * s) * sc);
    }
    for (int it = gtid(); it < T_ * 48; it += gthreads()) {
        const int tok = it / 48, c = it % 48;
        gates[it] = 1.f / (1.f + expf(-bf2f(kvq[(size_t)tok * KVQ_LD + 2560 + c])));
    }
}
__device__ __forceinline__ float gelu_tanh(float x) { return 0.5f * x * (1.f + tanhf(0.7978845608028654f * (x + 0.044715f * x * x * x))); }
__device__ void ph_cmp1(const Params& p) {
    const bf16_t* kvq = (const bf16_t*)(p.ws + KVQ); float* hc = (float*)(p.ws + HC);
    for (int it = gtid(); it < 2 * 4088 * 256; it += gthreads()) {
        const int j = it & 255, r = (it >> 8) % 4088, kv = it / (4088 * 256);
        const int n = r % 511, bg = r / 511, g = bg & 3, b = bg >> 2;
        const float* w1 = kv ? p.cv_w1 : p.ck_w1; const float* pe = kv ? p.pe_v : p.pe_k;
        const bf16_t* src = kvq + ((size_t)b * S_ + 16 * n) * KVQ_LD + kv * 256 + g * 64;
        float acc = 0.f;
        for (int l = 0; l < 32; ++l)
            for (int d = 0; d < 64; ++d) acc += (bf2f(src[(size_t)l * KVQ_LD + d]) + pe[l * 64 + d]) * w1[(size_t)(l * 64 + d) * 256 + j];
        hc[it] = gelu_tanh(acc);
    }
}
__device__ void ph_cmp2(const Params& p) {
    const float* hc = (const float*)(p.ws + HC); float* kc = (float*)(p.ws + KCMP);
    for (int it = gtid(); it < 2 * 4088 * 64; it += gthreads()) {
        const int d = it & 63, rr = it >> 6, kv = rr / 4088;
        const float* w2 = kv ? p.cv_w2 : p.ck_w2;
        float acc = 0.f;
        for (int j = 0; j < 256; ++j) acc += hc[(size_t)rr * 256 + j] * w2[j * 64 + d];
        kc[it] = acc;
    }
}
__device__ __forceinline__ float dot16(const float* q, const float* k) {
    float s = 0.f;
#pragma unroll
    for (int d4 = 0; d4 < 4; ++d4) { const f32x4 k4 = *(const f32x4*)(k + d4 * 4); s += q[d4 * 4] * k4[0] + q[d4 * 4 + 1] * k4[1] + q[d4 * 4 + 2] * k4[2] + q[d4 * 4 + 3] * k4[3]; }
    return s;
}
__device__ __forceinline__ void load_q16(const bf16_t* ptr, float* q) { unpack8(*(const u32x4*)ptr, q); unpack8(*(const u32x4*)(ptr + 8), q + 8); }
__device__ void ph_cmp_attn(const Params& p) {
    const bf16_t* kvq = (const bf16_t*)(p.ws + KVQ); const float* kc = (const float*)(p.ws + KCMP); const float* vc = kc + 4088 * 64;
    float* ml = (float*)(p.ws + MLB); float* ocmp = p.out;
    for (int it = gtid(); it < T_ * 64; it += gthreads()) {
        const int part = it & 3, h = (it >> 2) & 15, tok = it >> 6, t = tok & (S_ - 1), b = tok >> 13, g = h >> 2;
        const int nv = t >= 31 ? min((t - 31) / 16 + 1, 511) : 0;
        float q[16]; load_q16(kvq + (size_t)tok * KVQ_LD + 1536 + h * 64 + part * 16, q);
        const float* kr = kc + (size_t)(b * 4 + g) * 511 * 64 + part * 16; const float* vr = vc + (size_t)(b * 4 + g) * 511 * 64 + part * 16;
        float m = -1e30f;
        for (int n = 0; n < nv; ++n) { float s = dot16(q, kr + n * 64); s += __shfl_xor(s, 1); s += __shfl_xor(s, 2); m = fmaxf(m, s); }
        float l = 0.f, o[16];
#pragma unroll
        for (int d = 0; d < 16; ++d) o[d] = 0.f;
        for (int n = 0; n < nv; ++n) {
            float s = dot16(q, kr + n * 64); s += __shfl_xor(s, 1); s += __shfl_xor(s, 2);
            const float pr = expf(s - m); l += pr;
#pragma unroll
            for (int d4 = 0; d4 < 4; ++d4) { const f32x4 v4 = *(const f32x4*)(vr + n * 64 + d4 * 4); o[d4 * 4] += pr * v4[0]; o[d4 * 4 + 1] += pr * v4[1]; o[d4 * 4 + 2] += pr * v4[2]; o[d4 * 4 + 3] += pr * v4[3]; }
        }
        if (part == 0) { ml[(it >> 2) * 2] = m; ml[(it >> 2) * 2 + 1] = l; }
        const float il = l > 0.f ? 1.f / l : 0.f;
#pragma unroll
        for (int d4 = 0; d4 < 4; ++d4) *(f32x4*)(ocmp + (size_t)tok * 1024 + h * 64 + part * 16 + d4 * 4) = (f32x4){o[d4 * 4] * il, o[d4 * 4 + 1] * il, o[d4 * 4 + 2] * il, o[d4 * 4 + 3] * il};
    }
}
__device__ void ph_topk(const Params& p) {
    const bf16_t* kvq = (const bf16_t*)(p.ws + KVQ); const float* kc = (const float*)(p.ws + KCMP);
    const float* ml = (const float*)(p.ws + MLB); int* sel = (int*)(p.ws + SEL);
    const int lane = threadIdx.x & 63;
    for (int it = gwave(); it < T_ * 4; it += gwaves()) {
        const int g = it & 3, tok = it >> 2, t = tok & (S_ - 1), b = tok >> 13;
        const int nv = t >= 31 ? min((t - 31) / 16 + 1, 511) : 0, cur = t >> 6;
        const float* kr = kc + (size_t)(b * 4 + g) * 511 * 64;
        float imp0 = 0.f, imp1 = 0.f;
#pragma unroll 1
        for (int r = 0; r < 4; ++r) {
            const int h = g * 4 + r;
            const float m = ml[(tok * 16 + h) * 2], l = ml[(tok * 16 + h) * 2 + 1];
            if (l <= 0.f) continue;
            const float il = 1.f / l;
#pragma unroll 1
            for (int cnd = 0; cnd < 2; ++cnd) {
                float acc = 0.f;
#pragma unroll 1
                for (int k = 0; k < 5; ++k) {
                    const int n = 4 * (lane + cnd * 64) - 1 + k;
                    if (n < 0 || n >= nv) continue;
                    float sd = 0.f;
#pragma unroll 1
                    for (int part = 0; part < 4; ++part) { float q[16]; load_q16(kvq + (size_t)tok * KVQ_LD + 1536 + h * 64 + part * 16, q); sd += dot16(q, kr + n * 64 + part * 16); }
                    acc += expf(sd - m) * il;
                }
                if (cnd == 0) imp0 += acc; else imp1 += acc;
            }
        }
        float sc0, sc1;
        { const int s = lane; const bool valid = s * 64 <= t, forced = (s == 0) || (s == cur) || (s == cur - 1); sc0 = valid ? imp0 + (forced ? 1000.f : 0.f) : -1e30f; }
        { const int s = lane + 64; const bool valid = s * 64 <= t, forced = (s == 0) || (s == cur) || (s == cur - 1); sc1 = valid ? imp1 + (forced ? 1000.f : 0.f) : -1e30f; }
        for (int rd = 0; rd < 16; ++rd) {
            const float loc = fmaxf(sc0, sc1), mx = wave_max(loc);
            const unsigned long long b0 = __ballot(sc0 == mx);
            int ws;
            if (b0) { const int wl = __ffsll((long long)b0) - 1; ws = wl; if (lane == wl) sc0 = -3.0e38f; }
            else { const unsigned long long b1 = __ballot(sc1 == mx); const int wl = __ffsll((long long)b1) - 1; ws = wl + 64; if (lane == wl) sc1 = -3.0e38f; }
            if (lane == 0) sel[it * 16 + rd] = ws;
        }
    }
}
__device__ void ph_slc_win(const Params& p) {
    const bf16_t* kvq = (const bf16_t*)(p.ws + KVQ); const int* sel = (const int*)(p.ws + SEL); const float* gates = (const float*)(p.ws + GATES);
    float* ocmp = p.out; bf16_t* ao = (bf16_t*)(p.ws + ATTN_OUT);
    for (int it = gtid(); it < T_ * 64; it += gthreads()) {
        const int part = it & 3, h = (it >> 2) & 15, tok = it >> 6, t = tok & (S_ - 1), b = tok >> 13, g = h >> 2;
        float q[16], o[16]; load_q16(kvq + (size_t)tok * KVQ_LD + 1536 + h * 64 + part * 16, q);
        const float g0 = gates[tok * 48 + h * 3], g1 = gates[tok * 48 + h * 3 + 1], g2 = gates[tok * 48 + h * 3 + 2];
        float* oc = ocmp + (size_t)tok * 1024 + h * 64 + part * 16;
        for (int br = 0; br < 2; ++br) {
            float m = -1e30f, l = 0.f;
#pragma unroll
            for (int d = 0; d < 16; ++d) o[d] = 0.f;
            const int kcol = (br == 0 ? 512 : 1024) + g * 64 + part * 16, vcol = kcol + 256;
            const int nseg = br == 0 ? 16 : 1;
            for (int sg = 0; sg < nseg; ++sg) {
                int p0, p1;
                if (br == 0) { const int j = sel[(tok * 4 + g) * 16 + sg]; p0 = j * 64; p1 = min(p0 + 63, t); }
                else { p0 = max(0, t - 511); p1 = t; }
                for (int pos = p0; pos <= p1; ++pos) {
                    const bf16_t* row = kvq + ((size_t)b * S_ + pos) * KVQ_LD;
                    float kf[16]; load_q16(row + kcol, kf);
                    float s = 0.f;
#pragma unroll
                    for (int j = 0; j < 16; ++j) s += q[j] * kf[j];
                    s += __shfl_xor(s, 1); s += __shfl_xor(s, 2);
                    if (s > m) { const float a = expf(m - s); l *= a;
#pragma unroll
                        for (int d = 0; d < 16; ++d) o[d] *= a;
                        m = s; }
                    const float pr = expf(s - m); l += pr;
                    float vf[16]; load_q16(row + vcol, vf);
#pragma unroll
                    for (int j = 0; j < 16; ++j) o[j] += pr * vf[j];
                }
            }
            const float il = 1.f / l;
            if (br == 0) {
#pragma unroll
                for (int d4 = 0; d4 < 4; ++d4) { f32x4 c4 = *(f32x4*)(oc + d4 * 4);
                    c4[0] = g0 * c4[0] + g1 * o[d4 * 4] * il; c4[1] = g0 * c4[1] + g1 * o[d4 * 4 + 1] * il; c4[2] = g0 * c4[2] + g1 * o[d4 * 4 + 2] * il; c4[3] = g0 * c4[3] + g1 * o[d4 * 4 + 3] * il;
                    *(f32x4*)(oc + d4 * 4) = c4; }
            } else {
#pragma unroll
                for (int d4 = 0; d4 < 4; ++d4) { const f32x4 c4 = *(f32x4*)(oc + d4 * 4);
                    *(u32x2*)(ao + (size_t)tok * 1024 + h * 64 + part * 16 + d4 * 4) = (u32x2){pack2(c4[0] + g2 * o[d4 * 4] * il, c4[1] + g2 * o[d4 * 4 + 1] * il), pack2(c4[2] + g2 * o[d4 * 4 + 2] * il, c4[3] + g2 * o[d4 * 4 + 3] * il)}; }
            }
        }
    }
}

__global__ void __launch_bounds__(NT) fwd_kernel(Params p) {
    cg::grid_group grid = cg::this_grid();
    __shared__ __attribute__((aligned(16))) unsigned char smem[(256 + 128) * 72 * 2];
    float* hf = (float*)(p.ws + H_F32); bf16_t* hb = (bf16_t*)(p.ws + H_BF);
    ph_prep0(p, smem); ph_moe_weights(p, 0, smem);
    grid.sync();
    ph_gemm_retin(p, smem);
    grid.sync();
    ph_rope_ret(p);
    grid.sync();
    ph_ret_naive(p);
    grid.sync();
    ph_gnorm_gate(p);
    grid.sync();
    ph_gemm_f32((const bf16_t*)p.out, (const bf16_t*)(p.ws + WT_OUT), hf, 64, 8, 2048, 1024, smem);
    grid.sync();
    ph_ln<false, true, false>(p, p.x, hf, hf, hb, p.ln_mix_g, p.ln_mix_b, 0);
    grid.sync();
    ph_moe_scatter(p, 0);
    grid.sync();
    ph_moe_gemm<0>(p, 0, smem);
    grid.sync();
    ph_moe_gemm<1>(p, 0, smem);
    grid.sync();
    ph_ln<true, false, false>(p, hf, nullptr, hf, hb, p.ln_ffn_g, p.ln_ffn_b, 0);
    ph_moe_weights(p, 1, smem); ph_prep1(p, smem);
    grid.sync();
    ph_gemm_bf16(hb, (const bf16_t*)(p.ws + WT_KVQ), (bf16_t*)(p.ws + KVQ), 64, KVQ_LD / 128, 1024, KVQ_LD, smem);
    grid.sync();
    ph_rope_nsa(p);
    grid.sync();
    ph_cmp1(p);
    grid.sync();
    ph_cmp2(p);
    grid.sync();
    ph_cmp_attn(p);
    grid.sync();
    ph_topk(p);
    grid.sync();
    ph_slc_win(p);
    grid.sync();
    ph_gemm_f32((const bf16_t*)(p.ws + ATTN_OUT), (const bf16_t*)(p.ws + WT_NSAOUT), (float*)(p.ws + MIX2), 64, 8, 1024, 1024, smem);
    grid.sync();
    ph_ln<false, true, false>(p, hf, (const float*)(p.ws + MIX2), hf, hb, p.ln_mix_g + 1024, p.ln_mix_b + 1024, 1);
    grid.sync();
    ph_moe_scatter(p, 1);
    grid.sync();
    ph_moe_gemm<0>(p, 1, smem);
    grid.sync();
    ph_moe_gemm<1>(p, 1, smem);
    grid.sync();
    ph_ln<true, false, true>(p, hf, nullptr, p.out, nullptr, p.ln_ffn_g + 1024, p.ln_ffn_b + 1024, 1);
}

extern "C" void kernel_launch(void* const* d_in, const int* in_sizes, int n_in, void* d_out, int out_size, void* d_ws, size_t ws_size, hipStream_t stream) {
    (void)in_sizes; (void)n_in; (void)out_size;
    if (ws_size < WS_NEEDED) { fprintf(stderr, "workspace too small: %zu < %zu\n", ws_size, (size_t)WS_NEEDED); return; }
    static int grid_blocks = 0;
    if (!grid_blocks) {
        int dev = 0, cus = 0, per_cu = 0;
        hipGetDevice(&dev);
        hipDeviceGetAttribute(&cus, hipDeviceAttributeMultiprocessorCount, dev);
        hipOccupancyMaxActiveBlocksPerMultiprocessor(&per_cu, fwd_kernel, NT, 0);
        if (per_cu > 1) per_cu = 1;
        grid_blocks = cus * per_cu;
    }
    Params p{};
    const float** pp = (const float**)&p;
    for (int i = 0; i < 21; ++i) pp[i] = (const float*)d_in[i];
    p.out = (float*)d_out; p.ws = (unsigned char*)d_ws;
    void* args[] = {&p};
    hipError_t e = hipLaunchCooperativeKernel((void*)fwd_kernel, dim3(grid_blocks), dim3(NT), args, 0, stream);
    if (e != hipSuccess) fprintf(stderr, "cooperative launch failed: %s (grid %d)\n", hipGetErrorString(e), grid_blocks);
}
```

```cpp
#include <hip/hip_runtime.h>
#include <hip/hip_cooperative_groups.h>
#include <cstdio>
#include <cstdint>
namespace cg = cooperative_groups;

typedef unsigned short bf16_t;
typedef short bf16x8 __attribute__((ext_vector_type(8)));
typedef float f32x4 __attribute__((ext_vector_type(4)));
typedef unsigned u32x4 __attribute__((ext_vector_type(4)));
typedef unsigned u32x2 __attribute__((ext_vector_type(2)));

#define NT 512
constexpr int LDS_BYTES = 144 * 1024;
constexpr int T_ = 16384, D_ = 1024, S_ = 8192;
constexpr size_t MiB = 1u << 20;
constexpr size_t XB = 0, WT_IN = 32 * MiB, QB = 44 * MiB, KB = 76 * MiB, VB = 108 * MiB, GB = 172 * MiB;
constexpr size_t WT_OUT = 246 * MiB, MOEW_GU = 250 * MiB, MOEW_D = 282 * MiB;
constexpr size_t H_F32 = 0, H_BF = 64 * MiB, YEXP = 96 * MiB, XS = 172 * MiB, MISC = 244 * MiB;
constexpr size_t WT_KVQ = 236 * MiB, WT_NSAOUT = 242 * MiB;
constexpr size_t KVQ = 96 * MiB, GATES = 180 * MiB, HC = 183 * MiB, KCMP = 191 * MiB, MLB = 193 * MiB, SEL = 195 * MiB, ATTN_OUT = 199 * MiB;
constexpr size_t MIX2 = 96 * MiB;
constexpr size_t RET_L = 0;
constexpr size_t WS_NEEDED = 298 * MiB;
constexpr int KVQ_LD = 2688;
constexpr int MI_CNT = 0, MI_TE = 1024, MI_TW = MI_TE + 32768, MI_TI = MI_TW + 32768, MI_TR = MI_TI + 32768;

struct Params {
    const float *x, *ret_w_in, *ret_w_out, *nsa_w_kv, *pe_k, *pe_v, *ck_w1, *ck_w2, *cv_w1, *cv_w2, *nsa_w_in, *nsa_w_out,
        *router_w, *router_b, *moe_wg, *moe_wu, *moe_wd, *ln_mix_g, *ln_mix_b, *ln_ffn_g, *ln_ffn_b;
    float* out; unsigned char* ws;
};

__device__ __forceinline__ bf16_t f2bf(float f) { unsigned u = __float_as_uint(f); u += 0x7fffu + ((u >> 16) & 1u); return (bf16_t)(u >> 16); }
__device__ __forceinline__ float bf2f(bf16_t h) { return __uint_as_float(((unsigned)h) << 16); }
typedef float f32x2 __attribute__((ext_vector_type(2)));
typedef __bf16 bf16x2_t __attribute__((ext_vector_type(2)));
__device__ __forceinline__ unsigned pack2(float a, float b) { const f32x2 v = {a, b}; return __builtin_bit_cast(unsigned, __builtin_convertvector(v, bf16x2_t)); }
__device__ __forceinline__ float lo2f(unsigned u) { return __uint_as_float(u << 16); }
__device__ __forceinline__ float hi2f(unsigned u) { return __uint_as_float(u & 0xffff0000u); }
__device__ __forceinline__ float wave_sum(float v) {
#pragma unroll
    for (int o = 32; o > 0; o >>= 1) v += __shfl_xor(v, o);
    return v;
}
__device__ __forceinline__ float wave_max(float v) {
#pragma unroll
    for (int o = 32; o > 0; o >>= 1) v = fmaxf(v, __shfl_xor(v, o));
    return v;
}
__device__ __forceinline__ int gtid() { return blockIdx.x * NT + threadIdx.x; }
__device__ __forceinline__ int gthreads() { return gridDim.x * NT; }
__device__ __forceinline__ int gwave() { return (threadIdx.x >> 6) * gridDim.x + blockIdx.x; }
__device__ __forceinline__ int gwaves() { return gridDim.x * (NT / 64); }
__device__ __forceinline__ void unpack8(u32x4 u, float* f) {
    f[0] = lo2f(u.x); f[1] = hi2f(u.x); f[2] = lo2f(u.y); f[3] = hi2f(u.y); f[4] = lo2f(u.z); f[5] = hi2f(u.z); f[6] = lo2f(u.w); f[7] = hi2f(u.w);
}

template <class F> __device__ __forceinline__ void transpose_conv(F src, bf16_t* dst, int K, int N, float* tile) {
    const int tilesK = K >> 6, ntile = (N >> 6) * tilesK;
    for (int t = blockIdx.x; t < ntile; t += gridDim.x) {
        const int n0 = (t / tilesK) << 6, k0 = (t % tilesK) << 6;
#pragma unroll
        for (int i = 0; i < 8; ++i) { const int idx = threadIdx.x + i * NT, kk = idx >> 6, r = idx & 63; tile[kk * 65 + r] = src(k0 + kk, n0 + r); }
        __syncthreads();
#pragma unroll
        for (int i = 0; i < 8; ++i) { const int idx = threadIdx.x + i * NT, r = idx >> 6, kk = idx & 63; dst[(size_t)(n0 + r) * K + k0 + kk] = f2bf(tile[kk * 65 + r]); }
        __syncthreads();
    }
}

template <class Epi> __device__ __forceinline__ void gemm_tile(const bf16_t* __restrict__ A, int lda, const bf16_t* __restrict__ Bt, int ldb, int K, const Epi& epi, unsigned char* smem) {
    const int tid = threadIdx.x, lane = tid & 63, wid = tid >> 6, wm = wid >> 1, wn = wid & 1, fr = lane & 15, fq = lane >> 4;
    bf16_t* As = (bf16_t*)smem;
    bf16_t* Bs = As + 256 * 72;
    f32x4 acc[4][4];
#pragma unroll
    for (int i = 0; i < 4; ++i)
#pragma unroll
        for (int j = 0; j < 4; ++j) acc[i][j] = (f32x4){0.f, 0.f, 0.f, 0.f};
    u32x4 ra[4], rb[2];
    const int lrow = tid >> 3, lkc = tid & 7;
    const bf16_t* ag = A + (size_t)lrow * lda + lkc * 8;
    const bf16_t* bg = Bt + (size_t)lrow * ldb + lkc * 8;
#pragma unroll
    for (int i = 0; i < 4; ++i) ra[i] = *(const u32x4*)(ag + (size_t)i * 64 * lda);
#pragma unroll
    for (int i = 0; i < 2; ++i) rb[i] = *(const u32x4*)(bg + (size_t)i * 64 * ldb);
    const int nk = K >> 6;
    for (int kt = 0; kt < nk; ++kt) {
#pragma unroll
        for (int i = 0; i < 4; ++i) *(u32x4*)(As + (lrow + i * 64) * 72 + lkc * 8) = ra[i];
#pragma unroll
        for (int i = 0; i < 2; ++i) *(u32x4*)(Bs + (lrow + i * 64) * 72 + lkc * 8) = rb[i];
        __syncthreads();
        if (kt + 1 < nk) {
            const int k0 = (kt + 1) << 6;
#pragma unroll
            for (int i = 0; i < 4; ++i) ra[i] = *(const u32x4*)(ag + (size_t)i * 64 * lda + k0);
#pragma unroll
            for (int i = 0; i < 2; ++i) rb[i] = *(const u32x4*)(bg + (size_t)i * 64 * ldb + k0);
        }
#pragma unroll
        for (int s = 0; s < 2; ++s) {
            bf16x8 af[4], bfr[4];
#pragma unroll
            for (int i = 0; i < 4; ++i) af[i] = *(const bf16x8*)(As + (wm * 64 + i * 16 + fr) * 72 + s * 32 + fq * 8);
#pragma unroll
            for (int j = 0; j < 4; ++j) bfr[j] = *(const bf16x8*)(Bs + (wn * 64 + j * 16 + fr) * 72 + s * 32 + fq * 8);
#pragma unroll
            for (int i = 0; i < 4; ++i)
#pragma unroll
                for (int j = 0; j < 4; ++j) acc[i][j] = __builtin_amdgcn_mfma_f32_16x16x32_bf16(bfr[j], af[i], acc[i][j], 0, 0, 0);
        }
        __syncthreads();
    }
#pragma unroll
    for (int i = 0; i < 4; ++i)
#pragma unroll
        for (int j = 0; j < 4; ++j) epi(wm * 64 + i * 16 + fr, wn * 64 + j * 16 + fq * 4, acc[i][j]);
}

struct EpiBf16 { bf16_t* C; int ldc;
    __device__ __forceinline__ void operator()(int m, int n, f32x4 v) const { *(uint2*)(C + (size_t)m * ldc + n) = make_uint2(pack2(v[0], v[1]), pack2(v[2], v[3])); } };
struct EpiF32 { float* C; int ldc;
    __device__ __forceinline__ void operator()(int m, int n, f32x4 v) const { *(float4*)(C + (size_t)m * ldc + n) = make_float4(v[0], v[1], v[2], v[3]); } };
struct EpiSwiglu { bf16_t* C; int ldc;
    __device__ __forceinline__ void operator()(int m, int n, f32x4 v) const {
        const float a0 = v[0] / (1.f + __expf(-v[0])) * v[1], a1 = v[2] / (1.f + __expf(-v[2])) * v[3];
        *(unsigned*)(C + (size_t)m * ldc + (n >> 1)) = pack2(a0, a1); } };

__device__ __forceinline__ void ph_prep0(const Params& p, unsigned char* smem) {
    if (blockIdx.x == 0 && threadIdx.x < 64) ((int*)(p.ws + MISC))[MI_CNT + threadIdx.x] = 0;
    {   const float4* x4 = (const float4*)p.x; uint2* xb = (uint2*)(p.ws + XB);
        for (int i = gtid(); i < T_ * D_ / 4; i += gthreads()) { const float4 v = x4[i]; xb[i] = make_uint2(pack2(v.x, v.y), pack2(v.z, v.w)); } }
    float* tile = (float*)smem;
    { const float* w = p.ret_w_in; transpose_conv([w](int k, int n) { return w[(size_t)k * 6144 + n]; }, (bf16_t*)(p.ws + WT_IN), 1024, 6144, tile); }
    { const float* w = p.ret_w_out; transpose_conv([w](int k, int n) { return w[(size_t)k * 1024 + n]; }, (bf16_t*)(p.ws + WT_OUT), 2048, 1024, tile); }
}
__device__ __forceinline__ void ph_moe_weights(const Params& p, int l, unsigned char* smem) {
    float* tile = (float*)smem;
    { const float* wg = p.moe_wg + (size_t)l * 16 * 1024 * 512; const float* wu = p.moe_wu + (size_t)l * 16 * 1024 * 512;
      const ptrdiff_t du = wu - wg;
      transpose_conv([wg, du](int k, int n) { const int e = n >> 10, c = n & 1023; return wg[(ptrdiff_t)(c & 1) * du + ((size_t)e * 1024 + k) * 512 + (c >> 1)]; },
                     (bf16_t*)(p.ws + MOEW_GU), 1024, 16 * 1024, tile); }
    { const float* wd = p.moe_wd + (size_t)l * 16 * 512 * 1024;
      transpose_conv([wd](int k, int n) { const int e = n >> 10, c = n & 1023; return wd[((size_t)e * 512 + k) * 1024 + c]; }, (bf16_t*)(p.ws + MOEW_D), 512, 16 * 1024, tile); }
}
__device__ __forceinline__ void ph_prep1(const Params& p, unsigned char* smem) {
    float* tile = (float*)smem;
    { const float* wkv = p.nsa_w_kv; const float* win = p.nsa_w_in;
      transpose_conv([wkv, win](int k, int n) { return n < 1536 ? wkv[(size_t)k * 1536 + n] : (n < 2608 ? win[(size_t)k * 1072 + (n - 1536)] : 0.f); },
                     (bf16_t*)(p.ws + WT_KVQ), 1024, KVQ_LD, tile); }
    { const float* w = p.nsa_w_out; transpose_conv([w](int k, int n) { return w[(size_t)k * 1024 + n]; }, (bf16_t*)(p.ws + WT_NSAOUT), 1024, 1024, tile); }
}

__device__ __forceinline__ void ph_gemm_retin(const Params& p, unsigned char* smem) {
    const bf16_t* A = (const bf16_t*)(p.ws + XB); const bf16_t* Bt = (const bf16_t*)(p.ws + WT_IN);
    for (int t = blockIdx.x; t < 64 * 48; t += gridDim.x) {
        const int mt = t / 48, nt = t % 48, n0 = nt * 128;
        bf16_t* C; int ldc;
        if (n0 < 1024) { C = (bf16_t*)(p.ws + QB) + n0; ldc = 1024; }
        else if (n0 < 2048) { C = (bf16_t*)(p.ws + KB) + (n0 - 1024); ldc = 1024; }
        else if (n0 < 4096) { C = (bf16_t*)(p.ws + VB) + (n0 - 2048); ldc = 2048; }
        else { C = (bf16_t*)(p.ws + GB) + (n0 - 4096); ldc = 2048; }
        gemm_tile(A + (size_t)mt * 256 * 1024, 1024, Bt + (size_t)n0 * 1024, 1024, 1024, EpiBf16{C + (size_t)mt * 256 * ldc, ldc}, smem);
    }
}
__device__ __forceinline__ void ph_gemm_f32(const bf16_t* A, const bf16_t* Bt, float* C, int Mt, int Nt, int K, int N, unsigned char* smem) {
    for (int t = blockIdx.x; t < Mt * Nt; t += gridDim.x) {
        const int mt = t / Nt, nt = t % Nt;
        gemm_tile(A + (size_t)mt * 256 * K, K, Bt + (size_t)nt * 128 * K, K, K, EpiF32{C + (size_t)mt * 256 * N + nt * 128, N}, smem);
    }
}
__device__ __forceinline__ void ph_gemm_bf16(const bf16_t* A, const bf16_t* Bt, bf16_t* C, int Mt, int Nt, int K, int N, unsigned char* smem) {
    for (int t = blockIdx.x; t < Mt * Nt; t += gridDim.x) {
        const int mt = t / Nt, nt = t % Nt;
        gemm_tile(A + (size_t)mt * 256 * K, K, Bt + (size_t)nt * 128 * K, K, K, EpiBf16{C + (size_t)mt * 256 * N + nt * 128, N}, smem);
    }
}

__device__ __forceinline__ void ph_rope_ret(const Params& p) {
    bf16_t* Q = (bf16_t*)(p.ws + QB); bf16_t* K = (bf16_t*)(p.ws + KB);
    for (int it = gtid(); it < T_ * 4 * 128; it += gthreads()) {
        const int i = it & 127, h = (it >> 7) & 3, tok = it >> 9, t = tok & (S_ - 1);
        const float inv = (float)pow(10000.0, (double)(-(float)(2 * i) / 256.0f));
        const float ang = (float)t * inv, c = cosf(ang), s = sinf(ang);
        const size_t o = (size_t)tok * 1024 + h * 256 + i;
        { const float x1 = bf2f(Q[o]), x2 = bf2f(Q[o + 128]); Q[o] = f2bf(x1 * c - x2 * s); Q[o + 128] = f2bf(x2 * c + x1 * s); }
        { const float kd = 0.0625f * exp2f((float)(127 - (t & 127)) * log2f(1.f - exp2f(-5.f - (float)h)));
          const float x1 = bf2f(K[o]), x2 = bf2f(K[o + 128]); K[o] = f2bf((x1 * c - x2 * s) * kd); K[o + 128] = f2bf((x2 * c + x1 * s) * kd); }
    }
}
typedef short s16x4 __attribute__((ext_vector_type(4)));
#define LDSP(T, ptr) ((__attribute__((address_space(3))) T*)(ptr))
__device__ __forceinline__ bf16x8 tr_frag(const bf16_t* tile, int ld, int row0, int col0, int lane) {
    const int g = lane >> 4, q = (lane & 15) >> 2, pp = lane & 3;
    const bf16_t* a = tile + (row0 + 8 * g + q) * ld + col0 + 4 * pp;
    const s16x4 lo = __builtin_amdgcn_ds_read_tr16_b64_v4i16(LDSP(s16x4, a));
    const s16x4 hi = __builtin_amdgcn_ds_read_tr16_b64_v4i16(LDSP(s16x4, a + 4 * ld));
    return (bf16x8){lo[0], lo[1], lo[2], lo[3], hi[0], hi[1], hi[2], hi[3]};
}
__device__ __forceinline__ bf16x8 pack_frag(f32x4 a, f32x4 b) {
    u32x4 u = {pack2(a[0], a[1]), pack2(a[2], a[3]), pack2(b[0], b[1]), pack2(b[2], b[3])};
    return __builtin_bit_cast(bf16x8, u);
}
constexpr int RQ_LD = 264, RK_LD = 136;
template <int NCH> __device__ __forceinline__ void stage_tile(const bf16_t* g, int gld, bf16_t* l, int lld) {
    const int row = threadIdx.x / NCH, ch = threadIdx.x % NCH, goff = row * gld + ch * 8, loff = row * lld + ch * 8;
#pragma unroll
    for (int i = 0; i < (128 * NCH) / NT; ++i) { *(u32x4*)(l + loff + i * (NT / NCH) * lld) = *(const u32x4*)(g + (size_t)i * (NT / NCH) * gld + goff); if ((i & 3) == 3) asm volatile("" ::: "memory"); }
}
__device__ __forceinline__ void ph_ret_state(const Params& p, unsigned char* smem) {
    const bf16_t* K = (const bf16_t*)(p.ws + KB); const bf16_t* V = (const bf16_t*)(p.ws + VB); float* L = (float*)(p.ws + RET_L);
    bf16_t* Ks = (bf16_t*)smem; bf16_t* Vs = Ks + 128 * RQ_LD;
    const int lane = threadIdx.x & 63, w = __builtin_amdgcn_readfirstlane(threadIdx.x >> 6), g = lane >> 4, i16 = lane & 15;
    for (int unit = blockIdx.x; unit < 224; unit += gridDim.x) {
        const int slice = unit & 3, seg = (unit >> 2) % 7, bh = unit / 28, b = bh >> 2, h = bh & 3;
        const float lg = log2f(1.f - exp2f(-5.f - (float)h)), g128 = exp2f(128.f * lg);
        f32x4 S[16];
#pragma unroll
        for (int dt = 0; dt < 16; ++dt) S[dt] = (f32x4){0.f, 0.f, 0.f, 0.f};
        for (int ch = 0; ch < 8; ++ch) {
            const size_t tok0 = (size_t)b * S_ + seg * 1024 + ch * 128;
            __syncthreads();
            stage_tile<32>(K + tok0 * 1024 + h * 256, 1024, Ks, RQ_LD);
            stage_tile<16>(V + tok0 * 2048 + h * 512 + slice * 128, 2048, Vs, RK_LD);
            __syncthreads();
            bf16x8 Vf[4];
#pragma unroll
            for (int ks = 0; ks < 4; ++ks) Vf[ks] = tr_frag(Vs, RK_LD, 32 * ks, 16 * w, lane);
#pragma unroll
            for (int dt = 0; dt < 16; ++dt) {
                S[dt] = S[dt] * g128;
#pragma unroll
                for (int ks = 0; ks < 4; ++ks) S[dt] = __builtin_amdgcn_mfma_f32_16x16x32_bf16(tr_frag(Ks, RQ_LD, 32 * ks, 16 * dt, lane), Vf[ks], S[dt], 0, 0, 0);
            }
        }
        float* Lu = L + (size_t)((bh * 8 + seg) * 4 + slice) * (256 * 128) + threadIdx.x * 64;
#pragma unroll
        for (int dt = 0; dt < 16; ++dt) *(f32x4*)(Lu + dt * 4) = S[dt];
    }
}
__device__ __forceinline__ void ph_ret_scan(const Params& p, unsigned char* smem) {
    const bf16_t* Q = (const bf16_t*)(p.ws + QB); const bf16_t* K = (const bf16_t*)(p.ws + KB); const bf16_t* V = (const bf16_t*)(p.ws + VB);
    const float* L = (const float*)(p.ws + RET_L); bf16_t* O = (bf16_t*)p.out;
    bf16_t* Qs = (bf16_t*)smem; bf16_t* Ks = Qs + 128 * RK_LD; bf16_t* Vs = Ks + 128 * RK_LD; bf16_t* Ps = Vs + 128 * RK_LD;
    const int lane = threadIdx.x & 63, w = __builtin_amdgcn_readfirstlane(threadIdx.x >> 6), g = lane >> 4, i16 = lane & 15;
    for (int unit = blockIdx.x; unit < 256; unit += gridDim.x) {
        const int slice = unit & 3, seg = (unit >> 2) & 7, bh = unit >> 5, b = bh >> 2, h = bh & 3;
        const float lg = log2f(1.f - exp2f(-5.f - (float)h)), g128 = exp2f(128.f * lg), g1024 = exp2f(1024.f * lg), gm128 = exp2f(-128.f * lg);
        f32x4 S[16];
#pragma unroll
        for (int dt = 0; dt < 16; ++dt) S[dt] = (f32x4){0.f, 0.f, 0.f, 0.f};
        for (int j = 0; j < seg; ++j) {
            const float* Lu = L + (size_t)((bh * 8 + j) * 4 + slice) * (256 * 128) + threadIdx.x * 64;
#pragma unroll
            for (int dt = 0; dt < 16; ++dt) { S[dt] = S[dt] * g1024 + *(const f32x4*)(Lu + dt * 4); if ((dt & 3) == 3) asm volatile("" ::: "memory"); }
        }
        for (int ch = 0; ch < 8; ++ch) {
            const size_t tok0 = (size_t)b * S_ + seg * 1024 + ch * 128;
            f32x4 Oa[8], P[8];
#pragma unroll
            for (int i = 0; i < 8; ++i) { Oa[i] = (f32x4){0.f, 0.f, 0.f, 0.f}; P[i] = (f32x4){0.f, 0.f, 0.f, 0.f}; }
#pragma unroll
            for (int hf = 0; hf < 2; ++hf) {
                __syncthreads();
                stage_tile<16>(Q + tok0 * 1024 + h * 256 + hf * 128, 1024, Qs, RK_LD);
                stage_tile<16>(K + tok0 * 1024 + h * 256 + hf * 128, 1024, Ks, RK_LD);
                if (hf == 0) stage_tile<16>(V + tok0 * 2048 + h * 512 + slice * 128, 2048, Vs, RK_LD);
                __syncthreads();
                {
                    bf16x8 Sf[4];
#pragma unroll
                    for (int ks = 0; ks < 4; ++ks) Sf[ks] = pack_frag(S[8 * hf + 2 * ks], S[8 * hf + 2 * ks + 1]);
#pragma unroll
                    for (int ct = 0; ct < 8; ++ct) {
#pragma unroll
                        for (int ks = 0; ks < 4; ++ks) {
                            const bf16_t* qa = Qs + (16 * ct + i16) * RK_LD + 32 * ks + 4 * g;
                            const u32x2 lo = *(const u32x2*)qa, hi = *(const u32x2*)(qa + 16);
                            const u32x4 qq = {lo[0], lo[1], hi[0], hi[1]};
                            Oa[ct] = __builtin_amdgcn_mfma_f32_16x16x32_bf16(Sf[ks], __builtin_bit_cast(bf16x8, qq), Oa[ct], 0, 0, 0);
                        }
                        if (ct & 1) __builtin_amdgcn_sched_barrier(0);
                    }
                }
#pragma unroll
                for (int ks = 0; ks < 4; ++ks) {
                    const bf16x8 Qf = *(const bf16x8*)(Qs + (16 * w + i16) * RK_LD + 32 * ks + 8 * g);
#pragma unroll
                    for (int mt = 0; mt < 8; ++mt) if (mt <= w) P[mt] = __builtin_amdgcn_mfma_f32_16x16x32_bf16(*(const bf16x8*)(Ks + (16 * mt + i16) * RK_LD + 32 * ks + 8 * g), Qf, P[mt], 0, 0, 0);
                }
                __builtin_amdgcn_sched_barrier(0);
                if (hf == 1) {
                    const int c = 16 * w + i16;
#pragma unroll
                    for (int mt = 0; mt < 8; ++mt) {
                        float v[4];
#pragma unroll
                        for (int r = 0; r < 4; ++r) { const int m = 16 * mt + 4 * g + r; v[r] = (mt <= w && m <= c) ? P[mt][r] * gm128 : 0.f; }
                        *(u32x2*)(Ps + c * RK_LD + 16 * mt + 4 * g) = (u32x2){pack2(v[0], v[1]), pack2(v[2], v[3])};
                    }
                }
                {
                    bf16x8 Vf[4];
#pragma unroll
                    for (int ks = 0; ks < 4; ++ks) Vf[ks] = tr_frag(Vs, RK_LD, 32 * ks, 16 * w, lane);
#pragma unroll
                    for (int dt = 0; dt < 8; ++dt) {
                        S[8 * hf + dt] = S[8 * hf + dt] * g128;
#pragma unroll
                        for (int ks = 0; ks < 4; ++ks) S[8 * hf + dt] = __builtin_amdgcn_mfma_f32_16x16x32_bf16(tr_frag(Ks, RK_LD, 32 * ks, 16 * dt, lane), Vf[ks], S[8 * hf + dt], 0, 0, 0);
                        if (dt & 1) __builtin_amdgcn_sched_barrier(0);
                    }
                }
            }
            __syncthreads();
            {
                bf16x8 Vf[4];
#pragma unroll
                for (int ks = 0; ks < 4; ++ks) Vf[ks] = tr_frag(Vs, RK_LD, 32 * ks, 16 * w, lane);
#pragma unroll
                for (int ct = 0; ct < 8; ++ct)
#pragma unroll
                    for (int ks = 0; ks < 4; ++ks) if (ks <= ct / 2) Oa[ct] = __builtin_amdgcn_mfma_f32_16x16x32_bf16(Vf[ks], *(const bf16x8*)(Ps + (16 * ct + i16) * RK_LD + 32 * ks + 8 * g), Oa[ct], 0, 0, 0);
            }
            {
                bf16_t* ob = O + tok0 * 2048 + h * 512 + slice * 128 + 16 * w; const int ooff = i16 * 2048 + 4 * g;
#pragma unroll
                for (int ct = 0; ct < 8; ++ct) { const float sc = exp2f((float)(16 * ct + i16 + 1) * lg); *(u32x2*)(ob + (size_t)ct * 16 * 2048 + ooff) = (u32x2){pack2(Oa[ct][0] * sc, Oa[ct][1] * sc), pack2(Oa[ct][2] * sc, Oa[ct][3] * sc)}; }
            }
        }
    }
}
__device__ __forceinline__ void ph_gnorm_gate(const Params& p) {
    bf16_t* O = (bf16_t*)p.out; const bf16_t* G = (const bf16_t*)(p.ws + GB);
    const int lane = threadIdx.x & 63;
    for (int it = gwave(); it < T_ * 4; it += gwaves()) {
        const size_t off = (size_t)it * 512 + lane * 8;
        float x[8], g[8]; unpack8(*(const u32x4*)(O + off), x); unpack8(*(const u32x4*)(G + off), g);
        float s = 0.f;
#pragma unroll
        for (int j = 0; j < 8; ++j) s += x[j];
        const float mean = wave_sum(s) * (1.f / 512.f);
        float q = 0.f;
#pragma unroll
        for (int j = 0; j < 8; ++j) { x[j] -= mean; q += x[j] * x[j]; }
        const float rstd = rsqrtf(wave_sum(q) * (1.f / 512.f) + 1e-5f);
        float r[8];
#pragma unroll
        for (int j = 0; j < 8; ++j) r[j] = x[j] * rstd * (g[j] / (1.f + __expf(-g[j])));
        *(uint4*)(O + off) = make_uint4(pack2(r[0], r[1]), pack2(r[2], r[3]), pack2(r[4], r[5]), pack2(r[6], r[7]));
    }
}

template <bool COMBINE, bool ROUTER, bool FINAL> __forceinline__
__device__ __forceinline__ void ph_ln(const Params& p, const float* base, const float* mix, float* hout, bf16_t* hb, const float* lng, const float* lnb, int layer) {
    const int lane = threadIdx.x & 63;
    int* misc = (int*)(p.ws + MISC);
    const bf16_t* yexp = (const bf16_t*)(p.ws + YEXP);
    for (int tok = gwave(); tok < T_; tok += gwaves()) {
        float v[16];
        float w0 = 0.f, w1 = 0.f; int r0 = 0, r1 = 0;
        if (COMBINE) { w0 = __int_as_float(misc[MI_TW + tok * 2]); w1 = __int_as_float(misc[MI_TW + tok * 2 + 1]); r0 = misc[MI_TR + tok * 2]; r1 = misc[MI_TR + tok * 2 + 1]; }
#pragma unroll
        for (int i = 0; i < 4; ++i) {
            const float4 a = *(const float4*)(base + (size_t)tok * 1024 + i * 256 + lane * 4);
            float4 m;
            if (COMBINE) {
                const uint2 y0 = *(const uint2*)(yexp + (size_t)r0 * 1024 + i * 256 + lane * 4), y1 = *(const uint2*)(yexp + (size_t)r1 * 1024 + i * 256 + lane * 4);
                m.x = w0 * lo2f(y0.x) + w1 * lo2f(y1.x); m.y = w0 * hi2f(y0.x) + w1 * hi2f(y1.x); m.z = w0 * lo2f(y0.y) + w1 * lo2f(y1.y); m.w = w0 * hi2f(y0.y) + w1 * hi2f(y1.y);
            } else m = *(const float4*)(mix + (size_t)tok * 1024 + i * 256 + lane * 4);
            v[i * 4 + 0] = 1.41421356237f * a.x + m.x; v[i * 4 + 1] = 1.41421356237f * a.y + m.y; v[i * 4 + 2] = 1.41421356237f * a.z + m.z; v[i * 4 + 3] = 1.41421356237f * a.w + m.w;
        }
        float s = 0.f;
#pragma unroll
        for (int i = 0; i < 16; ++i) s += v[i];
        const float mean = wave_sum(s) * (1.f / 1024.f);
        float q = 0.f;
#pragma unroll
        for (int i = 0; i < 16; ++i) { v[i] -= mean; q += v[i] * v[i]; }
        const float rstd = rsqrtf(wave_sum(q) * (1.f / 1024.f) + 1e-5f);
#pragma unroll
        for (int i = 0; i < 4; ++i) {
            const float4 g = *(const float4*)(lng + i * 256 + lane * 4), bb = *(const float4*)(lnb + i * 256 + lane * 4);
            v[i * 4 + 0] = v[i * 4 + 0] * rstd * g.x + bb.x; v[i * 4 + 1] = v[i * 4 + 1] * rstd * g.y + bb.y; v[i * 4 + 2] = v[i * 4 + 2] * rstd * g.z + bb.z; v[i * 4 + 3] = v[i * 4 + 3] * rstd * g.w + bb.w;
            *(float4*)(hout + (size_t)tok * 1024 + i * 256 + lane * 4) = make_float4(v[i * 4 + 0], v[i * 4 + 1], v[i * 4 + 2], v[i * 4 + 3]);
            if (!FINAL) *(uint2*)(hb + (size_t)tok * 1024 + i * 256 + lane * 4) = make_uint2(pack2(v[i * 4 + 0], v[i * 4 + 1]), pack2(v[i * 4 + 2], v[i * 4 + 3]));
        }
        if (ROUTER) {
            float lg[16];
#pragma unroll
            for (int e = 0; e < 16; ++e) lg[e] = 0.f;
#pragma unroll
            for (int i = 0; i < 4; ++i)
#pragma unroll
                for (int j = 0; j < 4; ++j) {
                    const float4* rw = (const float4*)(p.router_w + (size_t)(i * 256 + lane * 4 + j) * 16);
                    const float hv = v[i * 4 + j];
#pragma unroll
                    for (int e4 = 0; e4 < 4; ++e4) { const float4 r = rw[e4]; lg[e4 * 4 + 0] += hv * r.x; lg[e4 * 4 + 1] += hv * r.y; lg[e4 * 4 + 2] += hv * r.z; lg[e4 * 4 + 3] += hv * r.w; }
                }
            float aff[16], sel[16];
#pragma unroll
            for (int e = 0; e < 16; ++e) { lg[e] = wave_sum(lg[e]); aff[e] = 1.f / (1.f + expf(-lg[e])); sel[e] = aff[e] + p.router_b[e]; }
            float best = -3.0e38f; int bg = 0; float b0 = 0, b1 = 0, b2 = 0, b3 = 0, a0 = 0, a1 = 0, a2 = 0, a3 = 0;
#pragma unroll
            for (int g = 0; g < 4; ++g) {
                const float x0 = sel[4 * g], x1 = sel[4 * g + 1], x2 = sel[4 * g + 2], x3 = sel[4 * g + 3];
                const float mx = fmaxf(fmaxf(x0, x1), fmaxf(x2, x3));
                const float m2 = fmaxf(fmaxf(fminf(x0, x1), fminf(x2, x3)), fminf(fmaxf(x0, x1), fmaxf(x2, x3)));
                const float gs = mx + m2;
                if (gs > best) { best = gs; bg = g; b0 = x0; b1 = x1; b2 = x2; b3 = x3; a0 = aff[4 * g]; a1 = aff[4 * g + 1]; a2 = aff[4 * g + 2]; a3 = aff[4 * g + 3]; }
            }
            int i1 = 0; float m = b0, wa = a0;
            if (b1 > m) { m = b1; i1 = 1; wa = a1; } if (b2 > m) { m = b2; i1 = 2; wa = a2; } if (b3 > m) { m = b3; i1 = 3; wa = a3; }
            int i2 = -1; float m2 = -3.0e38f, wb = 0.f;
            if (i1 != 0 && b0 > m2) { m2 = b0; i2 = 0; wb = a0; } if (i1 != 1 && b1 > m2) { m2 = b1; i2 = 1; wb = a1; }
            if (i1 != 2 && b2 > m2) { m2 = b2; i2 = 2; wb = a2; } if (i1 != 3 && b3 > m2) { m2 = b3; i2 = 3; wb = a3; }
            const float nrm = wa + wb;
            if (lane == 0) {
                const int e1 = bg * 4 + i1, e2 = bg * 4 + i2;
                misc[MI_TE + tok * 2] = e1; misc[MI_TE + tok * 2 + 1] = e2;
                misc[MI_TW + tok * 2] = __float_as_int(wa / nrm); misc[MI_TW + tok * 2 + 1] = __float_as_int(wb / nrm);
                misc[MI_TI + tok * 2] = atomicAdd(&misc[MI_CNT + layer * 16 + e1], 1);
                misc[MI_TI + tok * 2 + 1] = atomicAdd(&misc[MI_CNT + layer * 16 + e2], 1);
            }
        }
    }
}

__device__ __forceinline__ int moe_off(const int* cnt, int e) { int o = 0; for (int i = 0; i < e; ++i) o += (cnt[i] + 255) & ~255; return o; }
__device__ __forceinline__ void ph_moe_scatter(const Params& p, int layer) {
    int* misc = (int*)(p.ws + MISC); const int* cnt = misc + MI_CNT + layer * 16;
    const uint4* hb = (const uint4*)(p.ws + H_BF); uint4* xs = (uint4*)(p.ws + XS);
    const int lane = threadIdx.x & 63;
    for (int it = gwave(); it < T_ * 2; it += gwaves()) {
        const int tok = it >> 1, e = misc[MI_TE + it], row = moe_off(cnt, e) + misc[MI_TI + it];
        if (lane == 0) misc[MI_TR + it] = row;
        xs[(size_t)row * 128 + lane * 2] = hb[(size_t)tok * 128 + lane * 2];
        xs[(size_t)row * 128 + lane * 2 + 1] = hb[(size_t)tok * 128 + lane * 2 + 1];
    }
}
template <int WHICH> __device__ __forceinline__ void ph_moe_gemm(const Params& p, int layer, unsigned char* smem) {
    const int* cnt = (const int*)(p.ws + MISC) + MI_CNT + layer * 16;
    __shared__ int eoff[17];
    if (threadIdx.x == 0) { int o = 0; for (int e = 0; e < 16; ++e) { eoff[e] = o; o += (cnt[e] + 255) & ~255; } eoff[16] = o; }
    __syncthreads();
    const int Mt = eoff[16] >> 8;
    for (int t = blockIdx.x; t < Mt * 8; t += gridDim.x) {
        const int mt = t >> 3, nt = t & 7, row0 = mt << 8;
        int e = 0;
        while (e < 15 && row0 >= eoff[e + 1]) ++e;
        if (WHICH == 0) {
            const bf16_t* A = (const bf16_t*)(p.ws + XS) + (size_t)row0 * 1024;
            const bf16_t* Bt = (const bf16_t*)(p.ws + MOEW_GU) + ((size_t)e * 1024 + nt * 128) * 1024;
            gemm_tile(A, 1024, Bt, 1024, 1024, EpiSwiglu{(bf16_t*)p.out + (size_t)row0 * 512 + nt * 64, 512}, smem);
        } else {
            const bf16_t* A = (const bf16_t*)p.out + (size_t)row0 * 512;
            const bf16_t* Bt = (const bf16_t*)(p.ws + MOEW_D) + ((size_t)e * 1024 + nt * 128) * 512;
            gemm_tile(A, 512, Bt, 512, 512, EpiBf16{(bf16_t*)(p.ws + YEXP) + (size_t)row0 * 1024 + nt * 128, 1024}, smem);
        }
    }
}

__device__ __forceinline__ void ph_rope_nsa(const Params& p) {
    bf16_t* kvq = (bf16_t*)(p.ws + KVQ); float* gates = (float*)(p.ws + GATES);
    for (int it = gtid(); it < T_ * 896; it += gthreads()) {
        const int tok = it / 896, pp = it % 896, t = tok & (S_ - 1);
        int col, i; float sc = 1.f;
        if (pp < 384) { const int part = pp >> 7, w = pp & 127; i = w & 31; col = part * 512 + (w >> 5) * 64; }
        else { const int q = pp - 384; i = q & 31; col = 1536 + (q >> 5) * 64; sc = 0.125f; }
        const float inv = (float)pow(10000.0, (double)(-(float)(2 * i) / 64.0f));
        const float ang = (float)t * inv, c = cosf(ang), s = sinf(ang);
        bf16_t* x = kvq + (size_t)tok * KVQ_LD + col + i;
        const float x1 = bf2f(x[0]), x2 = bf2f(x[32]);
        x[0] = f2bf((x1 * c - x2 * s) * sc); x[32] = f2bf((x2 * c + x1 * s) * sc);
    }
    for (int it = gtid(); it < T_ * 48; it += gthreads()) {
        const int tok = it / 48, c = it % 48;
        gates[it] = 1.f / (1.f + expf(-bf2f(kvq[(size_t)tok * KVQ_LD + 2560 + c])));
    }
}
__device__ __forceinline__ float gelu_tanh(float x) { return 0.5f * x * (1.f + tanhf(0.7978845608028654f * (x + 0.044715f * x * x * x))); }
__device__ __forceinline__ void ph_cmp1(const Params& p) {
    const bf16_t* kvq = (const bf16_t*)(p.ws + KVQ); float* hc = (float*)(p.ws + HC);
    for (int it = gtid(); it < 2 * 4088 * 256; it += gthreads()) {
        const int j = it & 255, r = (it >> 8) % 4088, kv = it / (4088 * 256);
        const int n = r % 511, bg = r / 511, g = bg & 3, b = bg >> 2;
        const float* w1 = kv ? p.cv_w1 : p.ck_w1; const float* pe = kv ? p.pe_v : p.pe_k;
        const bf16_t* src = kvq + ((size_t)b * S_ + 16 * n) * KVQ_LD + kv * 256 + g * 64;
        float acc = 0.f;
        for (int l = 0; l < 32; ++l)
            for (int d = 0; d < 64; ++d) acc += (bf2f(src[(size_t)l * KVQ_LD + d]) + pe[l * 64 + d]) * w1[(size_t)(l * 64 + d) * 256 + j];
        hc[it] = gelu_tanh(acc);
    }
}
__device__ __forceinline__ void ph_cmp2(const Params& p) {
    const float* hc = (const float*)(p.ws + HC); float* kc = (float*)(p.ws + KCMP);
    for (int it = gtid(); it < 2 * 4088 * 64; it += gthreads()) {
        const int d = it & 63, rr = it >> 6, kv = rr / 4088;
        const float* w2 = kv ? p.cv_w2 : p.ck_w2;
        float acc = 0.f;
        for (int j = 0; j < 256; ++j) acc += hc[(size_t)rr * 256 + j] * w2[j * 64 + d];
        kc[it] = acc;
    }
}
__device__ __forceinline__ float dot16(const float* q, const float* k) {
    float s = 0.f;
#pragma unroll
    for (int d4 = 0; d4 < 4; ++d4) { const f32x4 k4 = *(const f32x4*)(k + d4 * 4); s += q[d4 * 4] * k4[0] + q[d4 * 4 + 1] * k4[1] + q[d4 * 4 + 2] * k4[2] + q[d4 * 4 + 3] * k4[3]; }
    return s;
}
__device__ __forceinline__ void load_q16(const bf16_t* ptr, float* q) { unpack8(*(const u32x4*)ptr, q); unpack8(*(const u32x4*)(ptr + 8), q + 8); }
__device__ __forceinline__ void ph_cmp_attn(const Params& p) {
    const bf16_t* kvq = (const bf16_t*)(p.ws + KVQ); const float* kc = (const float*)(p.ws + KCMP); const float* vc = kc + 4088 * 64;
    float* ml = (float*)(p.ws + MLB); float* ocmp = p.out;
    for (int it = gtid(); it < T_ * 64; it += gthreads()) {
        const int part = it & 3, h = (it >> 2) & 15, tok = it >> 6, t = tok & (S_ - 1), b = tok >> 13, g = h >> 2;
        const int nv = t >= 31 ? min((t - 31) / 16 + 1, 511) : 0;
        float q[16]; load_q16(kvq + (size_t)tok * KVQ_LD + 1536 + h * 64 + part * 16, q);
        const float* kr = kc + (size_t)(b * 4 + g) * 511 * 64 + part * 16; const float* vr = vc + (size_t)(b * 4 + g) * 511 * 64 + part * 16;
        float m = -1e30f;
        for (int n = 0; n < nv; ++n) { float s = dot16(q, kr + n * 64); s += __shfl_xor(s, 1); s += __shfl_xor(s, 2); m = fmaxf(m, s); }
        float l = 0.f, o[16];
#pragma unroll
        for (int d = 0; d < 16; ++d) o[d] = 0.f;
        for (int n = 0; n < nv; ++n) {
            float s = dot16(q, kr + n * 64); s += __shfl_xor(s, 1); s += __shfl_xor(s, 2);
            const float pr = expf(s - m); l += pr;
#pragma unroll
            for (int d4 = 0; d4 < 4; ++d4) { const f32x4 v4 = *(const f32x4*)(vr + n * 64 + d4 * 4); o[d4 * 4] += pr * v4[0]; o[d4 * 4 + 1] += pr * v4[1]; o[d4 * 4 + 2] += pr * v4[2]; o[d4 * 4 + 3] += pr * v4[3]; }
        }
        if (part == 0) { ml[(it >> 2) * 2] = m; ml[(it >> 2) * 2 + 1] = l; }
        const float il = l > 0.f ? 1.f / l : 0.f;
#pragma unroll
        for (int d4 = 0; d4 < 4; ++d4) *(f32x4*)(ocmp + (size_t)tok * 1024 + h * 64 + part * 16 + d4 * 4) = (f32x4){o[d4 * 4] * il, o[d4 * 4 + 1] * il, o[d4 * 4 + 2] * il, o[d4 * 4 + 3] * il};
    }
}
__device__ __forceinline__ void ph_topk(const Params& p) {
    const bf16_t* kvq = (const bf16_t*)(p.ws + KVQ); const float* kc = (const float*)(p.ws + KCMP);
    const float* ml = (const float*)(p.ws + MLB); int* sel = (int*)(p.ws + SEL);
    const int lane = threadIdx.x & 63;
    for (int it = gwave(); it < T_ * 4; it += gwaves()) {
        const int g = it & 3, tok = it >> 2, t = tok & (S_ - 1), b = tok >> 13;
        const int nv = t >= 31 ? min((t - 31) / 16 + 1, 511) : 0, cur = t >> 6;
        const float* kr = kc + (size_t)(b * 4 + g) * 511 * 64;
        float imp0 = 0.f, imp1 = 0.f;
#pragma unroll 1
        for (int r = 0; r < 4; ++r) {
            const int h = g * 4 + r;
            const float m = ml[(tok * 16 + h) * 2], l = ml[(tok * 16 + h) * 2 + 1];
            if (l <= 0.f) continue;
            const float il = 1.f / l;
#pragma unroll 1
            for (int cnd = 0; cnd < 2; ++cnd) {
                float acc = 0.f;
#pragma unroll 1
                for (int k = 0; k < 5; ++k) {
                    const int n = 4 * (lane + cnd * 64) - 1 + k;
                    if (n < 0 || n >= nv) continue;
                    float sd = 0.f;
#pragma unroll 1
                    for (int part = 0; part < 4; ++part) { float q[16]; load_q16(kvq + (size_t)tok * KVQ_LD + 1536 + h * 64 + part * 16, q); sd += dot16(q, kr + n * 64 + part * 16); }
                    acc += expf(sd - m) * il;
                }
                if (cnd == 0) imp0 += acc; else imp1 += acc;
            }
        }
        float sc0, sc1;
        { const int s = lane; const bool valid = s * 64 <= t, forced = (s == 0) || (s == cur) || (s == cur - 1); sc0 = valid ? imp0 + (forced ? 1000.f : 0.f) : -1e30f; }
        { const int s = lane + 64; const bool valid = s * 64 <= t, forced = (s == 0) || (s == cur) || (s == cur - 1); sc1 = valid ? imp1 + (forced ? 1000.f : 0.f) : -1e30f; }
        for (int rd = 0; rd < 16; ++rd) {
            const float loc = fmaxf(sc0, sc1), mx = wave_max(loc);
            const unsigned long long b0 = __ballot(sc0 == mx);
            int ws;
            if (b0) { const int wl = __ffsll((long long)b0) - 1; ws = wl; if (lane == wl) sc0 = -3.0e38f; }
            else { const unsigned long long b1 = __ballot(sc1 == mx); const int wl = __ffsll((long long)b1) - 1; ws = wl + 64; if (lane == wl) sc1 = -3.0e38f; }
            if (lane == 0) sel[it * 16 + rd] = ws;
        }
    }
}
__device__ __forceinline__ void ph_slc_win(const Params& p) {
    const bf16_t* kvq = (const bf16_t*)(p.ws + KVQ); const int* sel = (const int*)(p.ws + SEL); const float* gates = (const float*)(p.ws + GATES);
    float* ocmp = p.out; bf16_t* ao = (bf16_t*)(p.ws + ATTN_OUT);
    for (int it = gtid(); it < T_ * 64; it += gthreads()) {
        const int part = it & 3, h = (it >> 2) & 15, tok = it >> 6, t = tok & (S_ - 1), b = tok >> 13, g = h >> 2;
        float q[16], o[16]; load_q16(kvq + (size_t)tok * KVQ_LD + 1536 + h * 64 + part * 16, q);
        const float g0 = gates[tok * 48 + h * 3], g1 = gates[tok * 48 + h * 3 + 1], g2 = gates[tok * 48 + h * 3 + 2];
        float* oc = ocmp + (size_t)tok * 1024 + h * 64 + part * 16;
        for (int br = 0; br < 2; ++br) {
            float m = -1e30f, l = 0.f;
#pragma unroll
            for (int d = 0; d < 16; ++d) o[d] = 0.f;
            const int kcol = (br == 0 ? 512 : 1024) + g * 64 + part * 16, vcol = kcol + 256;
            const int nseg = br == 0 ? 16 : 1;
            for (int sg = 0; sg < nseg; ++sg) {
                int p0, p1;
                if (br == 0) { const int j = sel[(tok * 4 + g) * 16 + sg]; p0 = j * 64; p1 = min(p0 + 63, t); }
                else { p0 = max(0, t - 511); p1 = t; }
                for (int pos = p0; pos <= p1; ++pos) {
                    const bf16_t* row = kvq + ((size_t)b * S_ + pos) * KVQ_LD;
                    float kf[16]; load_q16(row + kcol, kf);
                    float s = 0.f;
#pragma unroll
                    for (int j = 0; j < 16; ++j) s += q[j] * kf[j];
                    s += __shfl_xor(s, 1); s += __shfl_xor(s, 2);
                    if (s > m) { const float a = expf(m - s); l *= a;
#pragma unroll
                        for (int d = 0; d < 16; ++d) o[d] *= a;
                        m = s; }
                    const float pr = expf(s - m); l += pr;
                    float vf[16]; load_q16(row + vcol, vf);
#pragma unroll
                    for (int j = 0; j < 16; ++j) o[j] += pr * vf[j];
                }
            }
            const float il = 1.f / l;
            if (br == 0) {
#pragma unroll
                for (int d4 = 0; d4 < 4; ++d4) { f32x4 c4 = *(f32x4*)(oc + d4 * 4);
                    c4[0] = g0 * c4[0] + g1 * o[d4 * 4] * il; c4[1] = g0 * c4[1] + g1 * o[d4 * 4 + 1] * il; c4[2] = g0 * c4[2] + g1 * o[d4 * 4 + 2] * il; c4[3] = g0 * c4[3] + g1 * o[d4 * 4 + 3] * il;
                    *(f32x4*)(oc + d4 * 4) = c4; }
            } else {
#pragma unroll
                for (int d4 = 0; d4 < 4; ++d4) { const f32x4 c4 = *(f32x4*)(oc + d4 * 4);
                    *(u32x2*)(ao + (size_t)tok * 1024 + h * 64 + part * 16 + d4 * 4) = (u32x2){pack2(c4[0] + g2 * o[d4 * 4] * il, c4[1] + g2 * o[d4 * 4 + 1] * il), pack2(c4[2] + g2 * o[d4 * 4 + 2] * il, c4[3] + g2 * o[d4 * 4 + 3] * il)}; }
            }
        }
    }
}

__global__ void __launch_bounds__(NT) fwd_kernel(Params p) {
    cg::grid_group grid = cg::this_grid();
    extern __shared__ __attribute__((aligned(16))) unsigned char smem[];
    float* hf = (float*)(p.ws + H_F32); bf16_t* hb = (bf16_t*)(p.ws + H_BF);
    ph_prep0(p, smem); ph_moe_weights(p, 0, smem);
    grid.sync();
    ph_gemm_retin(p, smem);
    grid.sync();
    ph_rope_ret(p);
    grid.sync();
    ph_ret_state(p, smem);
    grid.sync();
    ph_ret_scan(p, smem);
    grid.sync();
    ph_gnorm_gate(p);
    grid.sync();
    ph_gemm_f32((const bf16_t*)p.out, (const bf16_t*)(p.ws + WT_OUT), hf, 64, 8, 2048, 1024, smem);
    grid.sync();
    ph_ln<false, true, false>(p, p.x, hf, hf, hb, p.ln_mix_g, p.ln_mix_b, 0);
    grid.sync();
    ph_moe_scatter(p, 0);
    grid.sync();
    ph_moe_gemm<0>(p, 0, smem);
    grid.sync();
    ph_moe_gemm<1>(p, 0, smem);
    grid.sync();
    ph_ln<true, false, false>(p, hf, nullptr, hf, hb, p.ln_ffn_g, p.ln_ffn_b, 0);
    ph_moe_weights(p, 1, smem); ph_prep1(p, smem);
    grid.sync();
    ph_gemm_bf16(hb, (const bf16_t*)(p.ws + WT_KVQ), (bf16_t*)(p.ws + KVQ), 64, KVQ_LD / 128, 1024, KVQ_LD, smem);
    grid.sync();
    ph_rope_nsa(p);
    grid.sync();
    ph_cmp1(p);
    grid.sync();
    ph_cmp2(p);
    grid.sync();
    ph_cmp_attn(p);
    grid.sync();
    ph_topk(p);
    grid.sync();
    ph_slc_win(p);
    grid.sync();
    ph_gemm_f32((const bf16_t*)(p.ws + ATTN_OUT), (const bf16_t*)(p.ws + WT_NSAOUT), (float*)(p.ws + MIX2), 64, 8, 1024, 1024, smem);
    grid.sync();
    ph_ln<false, true, false>(p, hf, (const float*)(p.ws + MIX2), hf, hb, p.ln_mix_g + 1024, p.ln_mix_b + 1024, 1);
    grid.sync();
    ph_moe_scatter(p, 1);
    grid.sync();
    ph_moe_gemm<0>(p, 1, smem);
    grid.sync();
    ph_moe_gemm<1>(p, 1, smem);
    grid.sync();
    ph_ln<true, false, true>(p, hf, nullptr, p.out, nullptr, p.ln_ffn_g + 1024, p.ln_ffn_b + 1024, 1);
}

extern "C" void kernel_launch(void* const* d_in, const int* in_sizes, int n_in, void* d_out, int out_size, void* d_ws, size_t ws_size, hipStream_t stream) {
    (void)in_sizes; (void)n_in; (void)out_size;
    if (ws_size < WS_NEEDED) { fprintf(stderr, "workspace too small: %zu < %zu\n", ws_size, (size_t)WS_NEEDED); return; }
    static int grid_blocks = 0;
    if (!grid_blocks) {
        int dev = 0, cus = 0, per_cu = 0;
        (void)hipGetDevice(&dev);
        (void)hipDeviceGetAttribute(&cus, hipDeviceAttributeMultiprocessorCount, dev);
        (void)hipFuncSetAttribute((const void*)fwd_kernel, hipFuncAttributeMaxDynamicSharedMemorySize, LDS_BYTES);
        (void)hipOccupancyMaxActiveBlocksPerMultiprocessor(&per_cu, fwd_kernel, NT, LDS_BYTES);
        if (per_cu > 1) per_cu = 1;
        grid_blocks = cus * per_cu;
    }
    Params p{};
    const float** pp = (const float**)&p;
    for (int i = 0; i < 21; ++i) pp[i] = (const float*)d_in[i];
    p.out = (float*)d_out; p.ws = (unsigned char*)d_ws;
    void* args[] = {&p};
    hipError_t e = hipLaunchCooperativeKernel((void*)fwd_kernel, dim3(grid_blocks), dim3(NT), args, LDS_BYTES, stream);
    if (e != hipSuccess) fprintf(stderr, "cooperative launch failed: %s (grid %d)\n", hipGetErrorString(e), grid_blocks);
}
```

```cpp
#include <hip/hip_runtime.h>
#include <hip/hip_cooperative_groups.h>
#include <cstdio>
#include <cstdint>
namespace cg = cooperative_groups;

typedef unsigned short bf16_t;
typedef short bf16x8 __attribute__((ext_vector_type(8)));
typedef float f32x4 __attribute__((ext_vector_type(4)));
typedef unsigned u32x4 __attribute__((ext_vector_type(4)));
typedef unsigned u32x2 __attribute__((ext_vector_type(2)));

#define NT 512
constexpr int LDS_BYTES = 144 * 1024;
constexpr int T_ = 16384, D_ = 1024, S_ = 8192;
constexpr size_t MiB = 1u << 20;
constexpr size_t XB = 0, WT_IN = 32 * MiB, QB = 44 * MiB, KB = 76 * MiB, VB = 108 * MiB, GB = 172 * MiB;
constexpr size_t WT_OUT = 246 * MiB, MOEW_GU = 250 * MiB, MOEW_D = 282 * MiB;
constexpr size_t H_F32 = 0, H_BF = 64 * MiB, YEXP = 96 * MiB, XS = 172 * MiB, MISC = 244 * MiB;
constexpr size_t WT_KVQ = 236 * MiB, WT_NSAOUT = 242 * MiB;
constexpr size_t KVQ = 96 * MiB, GATES = 180 * MiB, HC = 183 * MiB, KCMPB = 187 * MiB, VCMPT = 187 * MiB + 512 * 1024, VST = 188 * MiB, VWT = 196 * MiB, ATTN_OUT = 204 * MiB, WT_CW1 = 246 * MiB;
constexpr size_t MIX2 = 96 * MiB;
constexpr size_t RET_L = 0;
constexpr size_t WS_NEEDED = 298 * MiB;
constexpr int KVQ_LD = 2688;
constexpr int MI_KMAX = 64, MI_KMAXC = 96, MI_PEW = 512;
constexpr int MI_CNT = 0, MI_TE = 1024, MI_TW = MI_TE + 32768, MI_TI = MI_TW + 32768, MI_TR = MI_TI + 32768;

struct Params {
    const float *x, *ret_w_in, *ret_w_out, *nsa_w_kv, *pe_k, *pe_v, *ck_w1, *ck_w2, *cv_w1, *cv_w2, *nsa_w_in, *nsa_w_out,
        *router_w, *router_b, *moe_wg, *moe_wu, *moe_wd, *ln_mix_g, *ln_mix_b, *ln_ffn_g, *ln_ffn_b;
    float* out; unsigned char* ws;
};

__device__ __forceinline__ bf16_t f2bf(float f) { unsigned u = __float_as_uint(f); u += 0x7fffu + ((u >> 16) & 1u); return (bf16_t)(u >> 16); }
__device__ __forceinline__ float bf2f(bf16_t h) { return __uint_as_float(((unsigned)h) << 16); }
typedef float f32x2 __attribute__((ext_vector_type(2)));
typedef __bf16 bf16x2_t __attribute__((ext_vector_type(2)));
__device__ __forceinline__ unsigned pack2(float a, float b) { const f32x2 v = {a, b}; return __builtin_bit_cast(unsigned, __builtin_convertvector(v, bf16x2_t)); }
__device__ __forceinline__ float lo2f(unsigned u) { return __uint_as_float(u << 16); }
__device__ __forceinline__ float hi2f(unsigned u) { return __uint_as_float(u & 0xffff0000u); }
__device__ __forceinline__ float wave_sum(float v) {
#pragma unroll
    for (int o = 32; o > 0; o >>= 1) v += __shfl_xor(v, o);
    return v;
}
__device__ __forceinline__ float wave_max(float v) {
#pragma unroll
    for (int o = 32; o > 0; o >>= 1) v = fmaxf(v, __shfl_xor(v, o));
    return v;
}
__device__ __forceinline__ int gtid() { return blockIdx.x * NT + threadIdx.x; }
__device__ __forceinline__ int gthreads() { return gridDim.x * NT; }
__device__ __forceinline__ int gwave() { return (threadIdx.x >> 6) * gridDim.x + blockIdx.x; }
__device__ __forceinline__ int gwaves() { return gridDim.x * (NT / 64); }
__device__ __forceinline__ void unpack8(u32x4 u, float* f) {
    f[0] = lo2f(u.x); f[1] = hi2f(u.x); f[2] = lo2f(u.y); f[3] = hi2f(u.y); f[4] = lo2f(u.z); f[5] = hi2f(u.z); f[6] = lo2f(u.w); f[7] = hi2f(u.w);
}

template <class F> __device__ __forceinline__ void transpose_conv(F src, bf16_t* dst, int K, int N, float* tile) {
    const int tilesK = K >> 6, ntile = (N >> 6) * tilesK;
    for (int t = blockIdx.x; t < ntile; t += gridDim.x) {
        const int n0 = (t / tilesK) << 6, k0 = (t % tilesK) << 6;
#pragma unroll
        for (int i = 0; i < 8; ++i) { const int idx = threadIdx.x + i * NT, kk = idx >> 6, r = idx & 63; tile[kk * 65 + r] = src(k0 + kk, n0 + r); }
        __syncthreads();
#pragma unroll
        for (int i = 0; i < 8; ++i) { const int idx = threadIdx.x + i * NT, r = idx >> 6, kk = idx & 63; dst[(size_t)(n0 + r) * K + k0 + kk] = f2bf(tile[kk * 65 + r]); }
        __syncthreads();
    }
}

template <class Epi> __device__ __forceinline__ void gemm_tile(const bf16_t* __restrict__ A, int lda, const bf16_t* __restrict__ Bt, int ldb, int K, const Epi& epi, unsigned char* smem, int akstride = 64) {
    const int tid = threadIdx.x, lane = tid & 63, wid = tid >> 6, wm = wid >> 1, wn = wid & 1, fr = lane & 15, fq = lane >> 4;
    bf16_t* As = (bf16_t*)smem;
    bf16_t* Bs = As + 256 * 72;
    f32x4 acc[4][4];
#pragma unroll
    for (int i = 0; i < 4; ++i)
#pragma unroll
        for (int j = 0; j < 4; ++j) acc[i][j] = (f32x4){0.f, 0.f, 0.f, 0.f};
    u32x4 ra[4], rb[2];
    const int lrow = tid >> 3, lkc = tid & 7;
    const bf16_t* ag = A + (size_t)lrow * lda + lkc * 8;
    const bf16_t* bg = Bt + (size_t)lrow * ldb + lkc * 8;
#pragma unroll
    for (int i = 0; i < 4; ++i) ra[i] = *(const u32x4*)(ag + (size_t)i * 64 * lda);
#pragma unroll
    for (int i = 0; i < 2; ++i) rb[i] = *(const u32x4*)(bg + (size_t)i * 64 * ldb);
    const int nk = K >> 6;
    for (int kt = 0; kt < nk; ++kt) {
#pragma unroll
        for (int i = 0; i < 4; ++i) *(u32x4*)(As + (lrow + i * 64) * 72 + lkc * 8) = ra[i];
#pragma unroll
        for (int i = 0; i < 2; ++i) *(u32x4*)(Bs + (lrow + i * 64) * 72 + lkc * 8) = rb[i];
        __syncthreads();
        if (kt + 1 < nk) {
            const int k0 = (kt + 1) << 6; const size_t ka = (size_t)(kt + 1) * akstride;
#pragma unroll
            for (int i = 0; i < 4; ++i) ra[i] = *(const u32x4*)(ag + (size_t)i * 64 * lda + ka);
#pragma unroll
            for (int i = 0; i < 2; ++i) rb[i] = *(const u32x4*)(bg + (size_t)i * 64 * ldb + k0);
        }
#pragma unroll
        for (int s = 0; s < 2; ++s) {
            bf16x8 af[4], bfr[4];
#pragma unroll
            for (int i = 0; i < 4; ++i) af[i] = *(const bf16x8*)(As + (wm * 64 + i * 16 + fr) * 72 + s * 32 + fq * 8);
#pragma unroll
            for (int j = 0; j < 4; ++j) bfr[j] = *(const bf16x8*)(Bs + (wn * 64 + j * 16 + fr) * 72 + s * 32 + fq * 8);
#pragma unroll
            for (int i = 0; i < 4; ++i)
#pragma unroll
                for (int j = 0; j < 4; ++j) acc[i][j] = __builtin_amdgcn_mfma_f32_16x16x32_bf16(bfr[j], af[i], acc[i][j], 0, 0, 0);
        }
        __syncthreads();
    }
#pragma unroll
    for (int i = 0; i < 4; ++i)
#pragma unroll
        for (int j = 0; j < 4; ++j) epi(wm * 64 + i * 16 + fr, wn * 64 + j * 16 + fq * 4, acc[i][j]);
}

struct EpiBf16 { bf16_t* C; int ldc;
    __device__ __forceinline__ void operator()(int m, int n, f32x4 v) const { *(uint2*)(C + (size_t)m * ldc + n) = make_uint2(pack2(v[0], v[1]), pack2(v[2], v[3])); } };
struct EpiF32 { float* C; int ldc;
    __device__ __forceinline__ void operator()(int m, int n, f32x4 v) const { *(float4*)(C + (size_t)m * ldc + n) = make_float4(v[0], v[1], v[2], v[3]); } };
struct EpiSwiglu { bf16_t* C; int ldc;
    __device__ __forceinline__ void operator()(int m, int n, f32x4 v) const {
        const float a0 = v[0] / (1.f + __expf(-v[0])) * v[1], a1 = v[2] / (1.f + __expf(-v[2])) * v[3];
        *(unsigned*)(C + (size_t)m * ldc + (n >> 1)) = pack2(a0, a1); } };

__device__ __forceinline__ void ph_prep0(const Params& p, unsigned char* smem) {
    if (blockIdx.x == 0 && threadIdx.x < 128) ((int*)(p.ws + MISC))[threadIdx.x] = 0;
    {   const float4* x4 = (const float4*)p.x; uint2* xb = (uint2*)(p.ws + XB);
        for (int i = gtid(); i < T_ * D_ / 4; i += gthreads()) { const float4 v = x4[i]; xb[i] = make_uint2(pack2(v.x, v.y), pack2(v.z, v.w)); } }
    float* tile = (float*)smem;
    { const float* w = p.ret_w_in; transpose_conv([w](int k, int n) { return w[(size_t)k * 6144 + n]; }, (bf16_t*)(p.ws + WT_IN), 1024, 6144, tile); }
    { const float* w = p.ret_w_out; transpose_conv([w](int k, int n) { return w[(size_t)k * 1024 + n]; }, (bf16_t*)(p.ws + WT_OUT), 2048, 1024, tile); }
}
__device__ __forceinline__ void ph_moe_weights(const Params& p, int l, unsigned char* smem) {
    float* tile = (float*)smem;
    { const float* wg = p.moe_wg + (size_t)l * 16 * 1024 * 512; const float* wu = p.moe_wu + (size_t)l * 16 * 1024 * 512;
      const ptrdiff_t du = wu - wg;
      transpose_conv([wg, du](int k, int n) { const int e = n >> 10, c = n & 1023; return wg[(ptrdiff_t)(c & 1) * du + ((size_t)e * 1024 + k) * 512 + (c >> 1)]; },
                     (bf16_t*)(p.ws + MOEW_GU), 1024, 16 * 1024, tile); }
    { const float* wd = p.moe_wd + (size_t)l * 16 * 512 * 1024;
      transpose_conv([wd](int k, int n) { const int e = n >> 10, c = n & 1023; return wd[((size_t)e * 512 + k) * 1024 + c]; }, (bf16_t*)(p.ws + MOEW_D), 512, 16 * 1024, tile); }
}
__device__ __forceinline__ void ph_prep1(const Params& p, unsigned char* smem) {
    float* tile = (float*)smem;
    { const float* wkv = p.nsa_w_kv; const float* win = p.nsa_w_in;
      transpose_conv([wkv, win](int k, int n) { return n < 1536 ? wkv[(size_t)k * 1536 + n] : (n < 2608 ? win[(size_t)k * 1072 + (n - 1536)] : 0.f); },
                     (bf16_t*)(p.ws + WT_KVQ), 1024, KVQ_LD, tile); }
    { const float* w = p.nsa_w_out; transpose_conv([w](int k, int n) { return w[(size_t)k * 1024 + n]; }, (bf16_t*)(p.ws + WT_NSAOUT), 1024, 1024, tile); }
    { const float* wk = p.ck_w1; const ptrdiff_t dv = p.cv_w1 - p.ck_w1; transpose_conv([wk, dv](int k, int n) { return wk[(ptrdiff_t)(n >> 8) * dv + (size_t)k * 256 + (n & 255)]; }, (bf16_t*)(p.ws + WT_CW1), 2048, 512, tile); }
}

__device__ __forceinline__ void ph_gemm_retin(const Params& p, unsigned char* smem) {
    const bf16_t* A = (const bf16_t*)(p.ws + XB); const bf16_t* Bt = (const bf16_t*)(p.ws + WT_IN);
    for (int t = blockIdx.x; t < 64 * 48; t += gridDim.x) {
        const int mt = t / 48, nt = t % 48, n0 = nt * 128;
        bf16_t* C; int ldc;
        if (n0 < 1024) { C = (bf16_t*)(p.ws + QB) + n0; ldc = 1024; }
        else if (n0 < 2048) { C = (bf16_t*)(p.ws + KB) + (n0 - 1024); ldc = 1024; }
        else if (n0 < 4096) { C = (bf16_t*)(p.ws + VB) + (n0 - 2048); ldc = 2048; }
        else { C = (bf16_t*)(p.ws + GB) + (n0 - 4096); ldc = 2048; }
        gemm_tile(A + (size_t)mt * 256 * 1024, 1024, Bt + (size_t)n0 * 1024, 1024, 1024, EpiBf16{C + (size_t)mt * 256 * ldc, ldc}, smem);
    }
}
__device__ __forceinline__ void ph_gemm_f32(const bf16_t* A, const bf16_t* Bt, float* C, int Mt, int Nt, int K, int N, unsigned char* smem) {
    for (int t = blockIdx.x; t < Mt * Nt; t += gridDim.x) {
        const int mt = t / Nt, nt = t % Nt;
        gemm_tile(A + (size_t)mt * 256 * K, K, Bt + (size_t)nt * 128 * K, K, K, EpiF32{C + (size_t)mt * 256 * N + nt * 128, N}, smem);
    }
}
__device__ __forceinline__ void ph_gemm_bf16(const bf16_t* A, const bf16_t* Bt, bf16_t* C, int Mt, int Nt, int K, int N, unsigned char* smem) {
    for (int t = blockIdx.x; t < Mt * Nt; t += gridDim.x) {
        const int mt = t / Nt, nt = t % Nt;
        gemm_tile(A + (size_t)mt * 256 * K, K, Bt + (size_t)nt * 128 * K, K, K, EpiBf16{C + (size_t)mt * 256 * N + nt * 128, N}, smem);
    }
}

__device__ __forceinline__ void ph_rope_ret(const Params& p) {
    bf16_t* Q = (bf16_t*)(p.ws + QB); bf16_t* K = (bf16_t*)(p.ws + KB);
    for (int it = gtid(); it < T_ * 4 * 128; it += gthreads()) {
        const int i = it & 127, h = (it >> 7) & 3, tok = it >> 9, t = tok & (S_ - 1);
        const float inv = (float)pow(10000.0, (double)(-(float)(2 * i) / 256.0f));
        const float ang = (float)t * inv, c = cosf(ang), s = sinf(ang);
        const size_t o = (size_t)tok * 1024 + h * 256 + i;
        { const float x1 = bf2f(Q[o]), x2 = bf2f(Q[o + 128]); Q[o] = f2bf(x1 * c - x2 * s); Q[o + 128] = f2bf(x2 * c + x1 * s); }
        { const float kd = 0.0625f * exp2f((float)(127 - (t & 127)) * log2f(1.f - exp2f(-5.f - (float)h)));
          const float x1 = bf2f(K[o]), x2 = bf2f(K[o + 128]); K[o] = f2bf((x1 * c - x2 * s) * kd); K[o + 128] = f2bf((x2 * c + x1 * s) * kd); }
    }
}
typedef short s16x4 __attribute__((ext_vector_type(4)));
#define LDSP(T, ptr) ((__attribute__((address_space(3))) T*)(ptr))
__device__ __forceinline__ bf16x8 tr_frag(const bf16_t* tile, int ld, int row0, int col0, int lane) {
    const int g = lane >> 4, q = (lane & 15) >> 2, pp = lane & 3;
    const bf16_t* a = tile + (row0 + 8 * g + q) * ld + col0 + 4 * pp;
    const s16x4 lo = __builtin_amdgcn_ds_read_tr16_b64_v4i16(LDSP(s16x4, a));
    const s16x4 hi = __builtin_amdgcn_ds_read_tr16_b64_v4i16(LDSP(s16x4, a + 4 * ld));
    return (bf16x8){lo[0], lo[1], lo[2], lo[3], hi[0], hi[1], hi[2], hi[3]};
}
__device__ __forceinline__ bf16x8 pack_frag(f32x4 a, f32x4 b) {
    u32x4 u = {pack2(a[0], a[1]), pack2(a[2], a[3]), pack2(b[0], b[1]), pack2(b[2], b[3])};
    return __builtin_bit_cast(bf16x8, u);
}
constexpr int RQ_LD = 264, RK_LD = 136;
template <int NCH> __device__ __forceinline__ void stage_tile(const bf16_t* g, int gld, bf16_t* l, int lld) {
    const int row = threadIdx.x / NCH, ch = threadIdx.x % NCH, goff = row * gld + ch * 8, loff = row * lld + ch * 8;
#pragma unroll
    for (int i = 0; i < (128 * NCH) / NT; ++i) { *(u32x4*)(l + loff + i * (NT / NCH) * lld) = *(const u32x4*)(g + (size_t)i * (NT / NCH) * gld + goff); if ((i & 3) == 3) asm volatile("" ::: "memory"); }
}
__device__ __forceinline__ void ph_ret_state(const Params& p, unsigned char* smem) {
    const bf16_t* K = (const bf16_t*)(p.ws + KB); const bf16_t* V = (const bf16_t*)(p.ws + VB); float* L = (float*)(p.ws + RET_L);
    bf16_t* Ks = (bf16_t*)smem; bf16_t* Vs = Ks + 128 * RQ_LD;
    const int lane = threadIdx.x & 63, w = __builtin_amdgcn_readfirstlane(threadIdx.x >> 6), g = lane >> 4, i16 = lane & 15;
    for (int unit = blockIdx.x; unit < 224; unit += gridDim.x) {
        const int slice = unit & 3, seg = (unit >> 2) % 7, bh = unit / 28, b = bh >> 2, h = bh & 3;
        const float lg = log2f(1.f - exp2f(-5.f - (float)h)), g128 = exp2f(128.f * lg);
        f32x4 S[16];
#pragma unroll
        for (int dt = 0; dt < 16; ++dt) S[dt] = (f32x4){0.f, 0.f, 0.f, 0.f};
        for (int ch = 0; ch < 8; ++ch) {
            const size_t tok0 = (size_t)b * S_ + seg * 1024 + ch * 128;
            __syncthreads();
            stage_tile<32>(K + tok0 * 1024 + h * 256, 1024, Ks, RQ_LD);
            stage_tile<16>(V + tok0 * 2048 + h * 512 + slice * 128, 2048, Vs, RK_LD);
            __syncthreads();
            bf16x8 Vf[4];
#pragma unroll
            for (int ks = 0; ks < 4; ++ks) Vf[ks] = tr_frag(Vs, RK_LD, 32 * ks, 16 * w, lane);
#pragma unroll
            for (int dt = 0; dt < 16; ++dt) {
                S[dt] = S[dt] * g128;
#pragma unroll
                for (int ks = 0; ks < 4; ++ks) S[dt] = __builtin_amdgcn_mfma_f32_16x16x32_bf16(tr_frag(Ks, RQ_LD, 32 * ks, 16 * dt, lane), Vf[ks], S[dt], 0, 0, 0);
            }
        }
        float* Lu = L + (size_t)((bh * 8 + seg) * 4 + slice) * (256 * 128) + threadIdx.x * 64;
#pragma unroll
        for (int dt = 0; dt < 16; ++dt) *(f32x4*)(Lu + dt * 4) = S[dt];
    }
}
__device__ __forceinline__ void ph_ret_scan(const Params& p, unsigned char* smem) {
    const bf16_t* Q = (const bf16_t*)(p.ws + QB); const bf16_t* K = (const bf16_t*)(p.ws + KB); const bf16_t* V = (const bf16_t*)(p.ws + VB);
    const float* L = (const float*)(p.ws + RET_L); bf16_t* O = (bf16_t*)p.out;
    bf16_t* Qs = (bf16_t*)smem; bf16_t* Ks = Qs + 128 * RK_LD; bf16_t* Vs = Ks + 128 * RK_LD; bf16_t* Ps = Vs + 128 * RK_LD;
    const int lane = threadIdx.x & 63, w = __builtin_amdgcn_readfirstlane(threadIdx.x >> 6), g = lane >> 4, i16 = lane & 15;
    for (int unit = blockIdx.x; unit < 256; unit += gridDim.x) {
        const int slice = unit & 3, seg = (unit >> 2) & 7, bh = unit >> 5, b = bh >> 2, h = bh & 3;
        const float lg = log2f(1.f - exp2f(-5.f - (float)h)), g128 = exp2f(128.f * lg), g1024 = exp2f(1024.f * lg), gm128 = exp2f(-128.f * lg);
        f32x4 S[16];
#pragma unroll
        for (int dt = 0; dt < 16; ++dt) S[dt] = (f32x4){0.f, 0.f, 0.f, 0.f};
        for (int j = 0; j < seg; ++j) {
            const float* Lu = L + (size_t)((bh * 8 + j) * 4 + slice) * (256 * 128) + threadIdx.x * 64;
#pragma unroll
            for (int dt = 0; dt < 16; ++dt) { S[dt] = S[dt] * g1024 + *(const f32x4*)(Lu + dt * 4); if ((dt & 3) == 3) asm volatile("" ::: "memory"); }
        }
        for (int ch = 0; ch < 8; ++ch) {
            const size_t tok0 = (size_t)b * S_ + seg * 1024 + ch * 128;
            f32x4 Oa[8], P[8];
#pragma unroll
            for (int i = 0; i < 8; ++i) { Oa[i] = (f32x4){0.f, 0.f, 0.f, 0.f}; P[i] = (f32x4){0.f, 0.f, 0.f, 0.f}; }
#pragma unroll
            for (int hf = 0; hf < 2; ++hf) {
                __syncthreads();
                stage_tile<16>(Q + tok0 * 1024 + h * 256 + hf * 128, 1024, Qs, RK_LD);
                stage_tile<16>(K + tok0 * 1024 + h * 256 + hf * 128, 1024, Ks, RK_LD);
                if (hf == 0) stage_tile<16>(V + tok0 * 2048 + h * 512 + slice * 128, 2048, Vs, RK_LD);
                __syncthreads();
                {
                    bf16x8 Sf[4];
#pragma unroll
                    for (int ks = 0; ks < 4; ++ks) Sf[ks] = pack_frag(S[8 * hf + 2 * ks], S[8 * hf + 2 * ks + 1]);
#pragma unroll
                    for (int ct = 0; ct < 8; ++ct) {
#pragma unroll
                        for (int ks = 0; ks < 4; ++ks) {
                            const bf16_t* qa = Qs + (16 * ct + i16) * RK_LD + 32 * ks + 4 * g;
                            const u32x2 lo = *(const u32x2*)qa, hi = *(const u32x2*)(qa + 16);
                            const u32x4 qq = {lo[0], lo[1], hi[0], hi[1]};
                            Oa[ct] = __builtin_amdgcn_mfma_f32_16x16x32_bf16(Sf[ks], __builtin_bit_cast(bf16x8, qq), Oa[ct], 0, 0, 0);
                        }
                        if (ct & 1) __builtin_amdgcn_sched_barrier(0);
                    }
                }
#pragma unroll
                for (int ks = 0; ks < 4; ++ks) {
                    const bf16x8 Qf = *(const bf16x8*)(Qs + (16 * w + i16) * RK_LD + 32 * ks + 8 * g);
#pragma unroll
                    for (int mt = 0; mt < 8; ++mt) if (mt <= w) P[mt] = __builtin_amdgcn_mfma_f32_16x16x32_bf16(*(const bf16x8*)(Ks + (16 * mt + i16) * RK_LD + 32 * ks + 8 * g), Qf, P[mt], 0, 0, 0);
                }
                __builtin_amdgcn_sched_barrier(0);
                if (hf == 1) {
                    const int c = 16 * w + i16;
#pragma unroll
                    for (int mt = 0; mt < 8; ++mt) {
                        float v[4];
#pragma unroll
                        for (int r = 0; r < 4; ++r) { const int m = 16 * mt + 4 * g + r; v[r] = (mt <= w && m <= c) ? P[mt][r] * gm128 : 0.f; }
                        *(u32x2*)(Ps + c * RK_LD + 16 * mt + 4 * g) = (u32x2){pack2(v[0], v[1]), pack2(v[2], v[3])};
                    }
                }
                {
                    bf16x8 Vf[4];
#pragma unroll
                    for (int ks = 0; ks < 4; ++ks) Vf[ks] = tr_frag(Vs, RK_LD, 32 * ks, 16 * w, lane);
#pragma unroll
                    for (int dt = 0; dt < 8; ++dt) {
                        S[8 * hf + dt] = S[8 * hf + dt] * g128;
#pragma unroll
                        for (int ks = 0; ks < 4; ++ks) S[8 * hf + dt] = __builtin_amdgcn_mfma_f32_16x16x32_bf16(tr_frag(Ks, RK_LD, 32 * ks, 16 * dt, lane), Vf[ks], S[8 * hf + dt], 0, 0, 0);
                        if (dt & 1) __builtin_amdgcn_sched_barrier(0);
                    }
                }
            }
            __syncthreads();
            {
                bf16x8 Vf[4];
#pragma unroll
                for (int ks = 0; ks < 4; ++ks) Vf[ks] = tr_frag(Vs, RK_LD, 32 * ks, 16 * w, lane);
#pragma unroll
                for (int ct = 0; ct < 8; ++ct)
#pragma unroll
                    for (int ks = 0; ks < 4; ++ks) if (ks <= ct / 2) Oa[ct] = __builtin_amdgcn_mfma_f32_16x16x32_bf16(Vf[ks], *(const bf16x8*)(Ps + (16 * ct + i16) * RK_LD + 32 * ks + 8 * g), Oa[ct], 0, 0, 0);
            }
            {
                bf16_t* ob = O + tok0 * 2048 + h * 512 + slice * 128 + 16 * w; const int ooff = i16 * 2048 + 4 * g;
#pragma unroll
                for (int ct = 0; ct < 8; ++ct) { const float sc = exp2f((float)(16 * ct + i16 + 1) * lg); *(u32x2*)(ob + (size_t)ct * 16 * 2048 + ooff) = (u32x2){pack2(Oa[ct][0] * sc, Oa[ct][1] * sc), pack2(Oa[ct][2] * sc, Oa[ct][3] * sc)}; }
            }
        }
    }
}
__device__ __forceinline__ void ph_gnorm_gate(const Params& p) {
    bf16_t* O = (bf16_t*)p.out; const bf16_t* G = (const bf16_t*)(p.ws + GB);
    const int lane = threadIdx.x & 63;
    for (int it = gwave(); it < T_ * 4; it += gwaves()) {
        const size_t off = (size_t)it * 512 + lane * 8;
        float x[8], g[8]; unpack8(*(const u32x4*)(O + off), x); unpack8(*(const u32x4*)(G + off), g);
        float s = 0.f;
#pragma unroll
        for (int j = 0; j < 8; ++j) s += x[j];
        const float mean = wave_sum(s) * (1.f / 512.f);
        float q = 0.f;
#pragma unroll
        for (int j = 0; j < 8; ++j) { x[j] -= mean; q += x[j] * x[j]; }
        const float rstd = rsqrtf(wave_sum(q) * (1.f / 512.f) + 1e-5f);
        float r[8];
#pragma unroll
        for (int j = 0; j < 8; ++j) r[j] = x[j] * rstd * (g[j] / (1.f + __expf(-g[j])));
        *(uint4*)(O + off) = make_uint4(pack2(r[0], r[1]), pack2(r[2], r[3]), pack2(r[4], r[5]), pack2(r[6], r[7]));
    }
}

template <bool COMBINE, bool ROUTER, bool FINAL> __forceinline__
__device__ __forceinline__ void ph_ln(const Params& p, const float* base, const float* mix, float* hout, bf16_t* hb, const float* lng, const float* lnb, int layer) {
    const int lane = threadIdx.x & 63;
    int* misc = (int*)(p.ws + MISC);
    const bf16_t* yexp = (const bf16_t*)(p.ws + YEXP);
    for (int tok = gwave(); tok < T_; tok += gwaves()) {
        float v[16];
        float w0 = 0.f, w1 = 0.f; int r0 = 0, r1 = 0;
        if (COMBINE) { w0 = __int_as_float(misc[MI_TW + tok * 2]); w1 = __int_as_float(misc[MI_TW + tok * 2 + 1]); r0 = misc[MI_TR + tok * 2]; r1 = misc[MI_TR + tok * 2 + 1]; }
#pragma unroll
        for (int i = 0; i < 4; ++i) {
            const float4 a = *(const float4*)(base + (size_t)tok * 1024 + i * 256 + lane * 4);
            float4 m;
            if (COMBINE) {
                const uint2 y0 = *(const uint2*)(yexp + (size_t)r0 * 1024 + i * 256 + lane * 4), y1 = *(const uint2*)(yexp + (size_t)r1 * 1024 + i * 256 + lane * 4);
                m.x = w0 * lo2f(y0.x) + w1 * lo2f(y1.x); m.y = w0 * hi2f(y0.x) + w1 * hi2f(y1.x); m.z = w0 * lo2f(y0.y) + w1 * lo2f(y1.y); m.w = w0 * hi2f(y0.y) + w1 * hi2f(y1.y);
            } else m = *(const float4*)(mix + (size_t)tok * 1024 + i * 256 + lane * 4);
            v[i * 4 + 0] = 1.41421356237f * a.x + m.x; v[i * 4 + 1] = 1.41421356237f * a.y + m.y; v[i * 4 + 2] = 1.41421356237f * a.z + m.z; v[i * 4 + 3] = 1.41421356237f * a.w + m.w;
        }
        float s = 0.f;
#pragma unroll
        for (int i = 0; i < 16; ++i) s += v[i];
        const float mean = wave_sum(s) * (1.f / 1024.f);
        float q = 0.f;
#pragma unroll
        for (int i = 0; i < 16; ++i) { v[i] -= mean; q += v[i] * v[i]; }
        const float rstd = rsqrtf(wave_sum(q) * (1.f / 1024.f) + 1e-5f);
#pragma unroll
        for (int i = 0; i < 4; ++i) {
            const float4 g = *(const float4*)(lng + i * 256 + lane * 4), bb = *(const float4*)(lnb + i * 256 + lane * 4);
            v[i * 4 + 0] = v[i * 4 + 0] * rstd * g.x + bb.x; v[i * 4 + 1] = v[i * 4 + 1] * rstd * g.y + bb.y; v[i * 4 + 2] = v[i * 4 + 2] * rstd * g.z + bb.z; v[i * 4 + 3] = v[i * 4 + 3] * rstd * g.w + bb.w;
            *(float4*)(hout + (size_t)tok * 1024 + i * 256 + lane * 4) = make_float4(v[i * 4 + 0], v[i * 4 + 1], v[i * 4 + 2], v[i * 4 + 3]);
            if (!FINAL) *(uint2*)(hb + (size_t)tok * 1024 + i * 256 + lane * 4) = make_uint2(pack2(v[i * 4 + 0], v[i * 4 + 1]), pack2(v[i * 4 + 2], v[i * 4 + 3]));
        }
        if (ROUTER) {
            float lg[16];
#pragma unroll
            for (int e = 0; e < 16; ++e) lg[e] = 0.f;
#pragma unroll
            for (int i = 0; i < 4; ++i)
#pragma unroll
                for (int j = 0; j < 4; ++j) {
                    const float4* rw = (const float4*)(p.router_w + (size_t)(i * 256 + lane * 4 + j) * 16);
                    const float hv = v[i * 4 + j];
#pragma unroll
                    for (int e4 = 0; e4 < 4; ++e4) { const float4 r = rw[e4]; lg[e4 * 4 + 0] += hv * r.x; lg[e4 * 4 + 1] += hv * r.y; lg[e4 * 4 + 2] += hv * r.z; lg[e4 * 4 + 3] += hv * r.w; }
                }
            float aff[16], sel[16];
#pragma unroll
            for (int e = 0; e < 16; ++e) { lg[e] = wave_sum(lg[e]); aff[e] = 1.f / (1.f + expf(-lg[e])); sel[e] = aff[e] + p.router_b[e]; }
            float best = -3.0e38f; int bg = 0; float b0 = 0, b1 = 0, b2 = 0, b3 = 0, a0 = 0, a1 = 0, a2 = 0, a3 = 0;
#pragma unroll
            for (int g = 0; g < 4; ++g) {
                const float x0 = sel[4 * g], x1 = sel[4 * g + 1], x2 = sel[4 * g + 2], x3 = sel[4 * g + 3];
                const float mx = fmaxf(fmaxf(x0, x1), fmaxf(x2, x3));
                const float m2 = fmaxf(fmaxf(fminf(x0, x1), fminf(x2, x3)), fminf(fmaxf(x0, x1), fmaxf(x2, x3)));
                const float gs = mx + m2;
                if (gs > best) { best = gs; bg = g; b0 = x0; b1 = x1; b2 = x2; b3 = x3; a0 = aff[4 * g]; a1 = aff[4 * g + 1]; a2 = aff[4 * g + 2]; a3 = aff[4 * g + 3]; }
            }
            int i1 = 0; float m = b0, wa = a0;
            if (b1 > m) { m = b1; i1 = 1; wa = a1; } if (b2 > m) { m = b2; i1 = 2; wa = a2; } if (b3 > m) { m = b3; i1 = 3; wa = a3; }
            int i2 = -1; float m2 = -3.0e38f, wb = 0.f;
            if (i1 != 0 && b0 > m2) { m2 = b0; i2 = 0; wb = a0; } if (i1 != 1 && b1 > m2) { m2 = b1; i2 = 1; wb = a1; }
            if (i1 != 2 && b2 > m2) { m2 = b2; i2 = 2; wb = a2; } if (i1 != 3 && b3 > m2) { m2 = b3; i2 = 3; wb = a3; }
            const float nrm = wa + wb;
            if (lane == 0) {
                const int e1 = bg * 4 + i1, e2 = bg * 4 + i2;
                misc[MI_TE + tok * 2] = e1; misc[MI_TE + tok * 2 + 1] = e2;
                misc[MI_TW + tok * 2] = __float_as_int(wa / nrm); misc[MI_TW + tok * 2 + 1] = __float_as_int(wb / nrm);
                misc[MI_TI + tok * 2] = atomicAdd(&misc[MI_CNT + layer * 16 + e1], 1);
                misc[MI_TI + tok * 2 + 1] = atomicAdd(&misc[MI_CNT + layer * 16 + e2], 1);
            }
        }
    }
}

__device__ __forceinline__ int moe_off(const int* cnt, int e) { int o = 0; for (int i = 0; i < e; ++i) o += (cnt[i] + 255) & ~255; return o; }
__device__ __forceinline__ void ph_moe_scatter(const Params& p, int layer) {
    int* misc = (int*)(p.ws + MISC); const int* cnt = misc + MI_CNT + layer * 16;
    const uint4* hb = (const uint4*)(p.ws + H_BF); uint4* xs = (uint4*)(p.ws + XS);
    const int lane = threadIdx.x & 63;
    for (int it = gwave(); it < T_ * 2; it += gwaves()) {
        const int tok = it >> 1, e = misc[MI_TE + it], row = moe_off(cnt, e) + misc[MI_TI + it];
        if (lane == 0) misc[MI_TR + it] = row;
        xs[(size_t)row * 128 + lane * 2] = hb[(size_t)tok * 128 + lane * 2];
        xs[(size_t)row * 128 + lane * 2 + 1] = hb[(size_t)tok * 128 + lane * 2 + 1];
    }
}
template <int WHICH> __device__ __forceinline__ void ph_moe_gemm(const Params& p, int layer, unsigned char* smem) {
    const int* cnt = (const int*)(p.ws + MISC) + MI_CNT + layer * 16;
    __shared__ int eoff[17];
    if (threadIdx.x == 0) { int o = 0; for (int e = 0; e < 16; ++e) { eoff[e] = o; o += (cnt[e] + 255) & ~255; } eoff[16] = o; }
    __syncthreads();
    const int Mt = eoff[16] >> 8;
    for (int t = blockIdx.x; t < Mt * 8; t += gridDim.x) {
        const int mt = t >> 3, nt = t & 7, row0 = mt << 8;
        int e = 0;
        while (e < 15 && row0 >= eoff[e + 1]) ++e;
        if (WHICH == 0) {
            const bf16_t* A = (const bf16_t*)(p.ws + XS) + (size_t)row0 * 1024;
            const bf16_t* Bt = (const bf16_t*)(p.ws + MOEW_GU) + ((size_t)e * 1024 + nt * 128) * 1024;
            gemm_tile(A, 1024, Bt, 1024, 1024, EpiSwiglu{(bf16_t*)p.out + (size_t)row0 * 512 + nt * 64, 512}, smem);
        } else {
            const bf16_t* A = (const bf16_t*)p.out + (size_t)row0 * 512;
            const bf16_t* Bt = (const bf16_t*)(p.ws + MOEW_D) + ((size_t)e * 1024 + nt * 128) * 512;
            gemm_tile(A, 512, Bt, 512, 512, EpiBf16{(bf16_t*)(p.ws + YEXP) + (size_t)row0 * 1024 + nt * 128, 1024}, smem);
        }
    }
}

__device__ __forceinline__ void ph_rope_nsa(const Params& p) {
    bf16_t* kvq = (bf16_t*)(p.ws + KVQ); float* gates = (float*)(p.ws + GATES); int* misc = (int*)(p.ws + MISC);
    const int lane = threadIdx.x & 63, i = lane & 31, half = lane >> 5;
    const float inv = (float)pow(10000.0, (double)(-(float)(2 * i) / 64.0f));
    float kmx[6];
#pragma unroll
    for (int it = 0; it < 6; ++it) kmx[it] = 0.f;
    for (int tok = gwave(); tok < T_; tok += gwaves()) {
        const int t = tok & (S_ - 1), b = tok >> 13;
        const float ang = (float)t * inv, c = cosf(ang), s = sinf(ang);
        bf16_t* row = kvq + (size_t)tok * KVQ_LD;
#pragma unroll
        for (int it = 0; it < 14; ++it) {
            const int rid = it * 2 + half;
            const int col = rid < 12 ? (rid >> 2) * 512 + (rid & 3) * 64 : 1536 + (rid - 12) * 64;
            const float sc = rid < 12 ? 1.f : 0.125f;
            const float x1 = bf2f(row[col + i]), x2 = bf2f(row[col + 32 + i]);
            const float y1 = (x1 * c - x2 * s) * sc, y2 = (x2 * c + x1 * s) * sc;
            row[col + i] = f2bf(y1); row[col + 32 + i] = f2bf(y2);
            if (it < 6) {
                float n2 = y1 * y1 + y2 * y2;
#pragma unroll
                for (int o = 16; o > 0; o >>= 1) n2 += __shfl_xor(n2, o);
                kmx[it] = fmaxf(kmx[it], n2);
            }
        }
        if (lane < 48) gates[tok * 48 + lane] = 1.f / (1.f + expf(-bf2f(row[2560 + lane])));
        const int nt = tok + gwaves();
        if (nt >= T_ || (nt >> 13) != b) {
#pragma unroll
            for (int it = 0; it < 6; ++it) {
                const int rid = it * 2 + half;
                if (i == 0) atomicMax(&misc[MI_KMAX + ((rid >> 2) * 2 + b) * 4 + (rid & 3)], __float_as_int(sqrtf(kmx[it]) * 1.01f + 1e-6f));
                kmx[it] = 0.f;
            }
        }
    }
    for (int o = gwave(); o < 512; o += gwaves()) {
        const int kv = o >> 8, j = o & 255; const float* w1 = kv ? p.cv_w1 : p.ck_w1; const float* pe = kv ? p.pe_v : p.pe_k;
        float a = 0.f;
        for (int k = lane; k < 2048; k += 64) a += pe[k] * w1[(size_t)k * 256 + j];
        a = wave_sum(a);
        if (lane == 0) ((float*)misc)[MI_PEW + o] = a;
    }
}
__device__ __forceinline__ void ph_vt(const Params& p) {
    const bf16_t* kvq = (const bf16_t*)(p.ws + KVQ);
    const int lane = threadIdx.x & 63;
    for (int it = gwave(); it < 2048; it += gwaves()) {
        const int part = it >> 10, bg = (it >> 7) & 7, blk = it & 127, b = bg >> 2, g = bg & 3;
        const bf16_t* src = kvq + ((size_t)b * S_ + blk * 64 + lane) * KVQ_LD + (part ? 1280 : 768) + g * 64;
        bf16_t* dst = (bf16_t*)(p.ws + (part ? VWT : VST)) + (size_t)(bg * 128 + blk) * 4096 + lane;
        u32x4 v[8];
#pragma unroll
        for (int c = 0; c < 8; ++c) v[c] = *(const u32x4*)(src + c * 8);
#pragma unroll
        for (int c = 0; c < 8; ++c)
#pragma unroll
            for (int e = 0; e < 4; ++e) { dst[(c * 8 + e * 2) * 64] = (bf16_t)(v[c][e] & 0xffffu); dst[(c * 8 + e * 2 + 1) * 64] = (bf16_t)(v[c][e] >> 16); }
    }
}
__device__ __forceinline__ void ph_cmp2(const Params& p) {
    const bf16_t* hc = (const bf16_t*)(p.ws + HC); bf16_t* kc = (bf16_t*)(p.ws + KCMPB); bf16_t* vt = (bf16_t*)(p.ws + VCMPT); int* misc = (int*)(p.ws + MISC);
    const int lane = threadIdx.x & 63;
    for (int it = gwave(); it < 2 * 8 * 512; it += gwaves()) {
        const int n = it & 511, bg = (it >> 9) & 7, kv = it >> 12;
        const float* w2 = kv ? p.cv_w2 : p.ck_w2;
        float acc = 0.f;
        if (n < 511) { const bf16_t* hr = hc + (size_t)((kv * 8 + bg) * 512 + n) * 256; for (int j = 0; j < 256; ++j) acc += bf2f(hr[j]) * w2[j * 64 + lane]; }
        if (kv == 0) {
            kc[(size_t)(bg * 512 + n) * 64 + lane] = f2bf(acc);
            const float n2 = wave_sum(acc * acc);
            if (lane == 0) atomicMax(&misc[MI_KMAXC + bg], __float_as_int(sqrtf(n2) * 1.01f + 1e-6f));
        } else vt[(size_t)(bg * 64 + lane) * 512 + n] = f2bf(acc);
    }
}
constexpr int AQ_LD = 72, AO_LD = 68;
constexpr int AL_Q = 0, AL_O = 36864, AL_L = AL_O + 256 * AO_LD * 4, AL_M = AL_L + 1024, AL_QN = AL_M + 1024, AL_IMP = AL_QN + 1024, AL_MASK = AL_IMP + 32768, AL_END = AL_MASK + 1024;
static_assert(AL_END <= LDS_BYTES, "attention LDS");
constexpr float LOG2E = 1.4426950408889634f;
struct AttnBlk { const bf16_t* K; int ldk; const bf16_t* VT; int ldv; };
template <int MODE> __device__ __forceinline__ void attn_item(unsigned char* smem, const AttnBlk blk, unsigned long long qbits, int kind, int jc, int cur, int lane) {
    const int g = lane >> 4, i16 = lane & 15;
    const bf16_t* Qs = (const bf16_t*)(smem + AL_Q); float* Oacc = (float*)(smem + AL_O); float* lacc = (float*)(smem + AL_L); const float* Mrow = (const float*)(smem + AL_M); float* imp = (float*)(smem + AL_IMP);
    bf16x8 Kf[4][2];
#pragma unroll
    for (int mt = 0; mt < 4; ++mt)
#pragma unroll
        for (int ks = 0; ks < 2; ++ks) Kf[mt][ks] = *(const bf16x8*)(blk.K + (size_t)(16 * mt + i16) * blk.ldk + 32 * ks + 8 * g);
    bf16x8 Vf[4][2];
    if (MODE != 1) {
#pragma unroll
        for (int dt = 0; dt < 4; ++dt)
#pragma unroll
            for (int ks = 0; ks < 2; ++ks) {
                const bf16_t* va = blk.VT + (size_t)(16 * dt + i16) * blk.ldv + 32 * ks + 4 * g;
                const u32x2 lo = *(const u32x2*)va, hi = *(const u32x2*)(va + 16);
                const u32x4 vv = {lo[0], lo[1], hi[0], hi[1]};
                Vf[dt][ks] = __builtin_bit_cast(bf16x8, vv);
            }
    }
    while (qbits) {
        int tq4[4];
#pragma unroll
        for (int k = 0; k < 4; ++k) { if (qbits) { tq4[k] = __builtin_ctzll(qbits); qbits &= qbits - 1; } else tq4[k] = -1; }
        const int qi = i16 >> 2;
        const int tq = qi == 0 ? tq4[0] : (qi == 1 ? tq4[1] : (qi == 2 ? tq4[2] : tq4[3]));
        const bool cval = tq >= 0;
        const int row = (cval ? tq : 0) * 4 + (i16 & 3);
        const bf16x8 Qf0 = *(const bf16x8*)(Qs + row * AQ_LD + 8 * g), Qf1 = *(const bf16x8*)(Qs + row * AQ_LD + 32 + 8 * g);
        const float mrow = Mrow[row];
        f32x4 St[4];
#pragma unroll
        for (int mt = 0; mt < 4; ++mt) {
            St[mt] = __builtin_amdgcn_mfma_f32_16x16x32_bf16(Kf[mt][0], Qf0, (f32x4){0.f, 0.f, 0.f, 0.f}, 0, 0, 0);
            St[mt] = __builtin_amdgcn_mfma_f32_16x16x32_bf16(Kf[mt][1], Qf1, St[mt], 0, 0, 0);
        }
        const int nmax = (64 * cur + tq - 31) >> 4;
        float lsum = 0.f;
#pragma unroll
        for (int mt = 0; mt < 4; ++mt)
#pragma unroll
            for (int r = 0; r < 4; ++r) {
                const int key = 16 * mt + 4 * g + r;
                bool ok = cval;
                if (kind == 1) ok = ok && key <= tq;
                if (kind == 2) ok = ok && key >= tq + 1;
                if (kind == 3) ok = ok && (64 * jc + key) <= nmax;
                const float pv = ok ? __builtin_amdgcn_exp2f(St[mt][r] * LOG2E - mrow) : 0.f;
                St[mt][r] = pv; lsum += pv;
            }
        if (MODE == 1) {
            const float il = lacc[row]; const float sc = il > 0.f ? 1.f / il : 0.f;
#pragma unroll
            for (int mt = 0; mt < 4; ++mt) {
                float s4 = (St[mt][0] + St[mt][1] + St[mt][2] + St[mt][3]) * sc, p3 = St[mt][3] * sc;
                s4 += __shfl_xor(s4, 1); s4 += __shfl_xor(s4, 2); p3 += __shfl_xor(p3, 1); p3 += __shfl_xor(p3, 2);
                const int sb = 16 * jc + 4 * mt + g;
                if (cval && (i16 & 3) == 0) { atomicAdd(&imp[tq * 128 + sb], s4); if (sb + 1 < 128) atomicAdd(&imp[tq * 128 + sb + 1], p3); }
            }
        } else {
            lsum += __shfl_xor(lsum, 16); lsum += __shfl_xor(lsum, 32);
            if (cval && g == 0) atomicAdd(&lacc[row], lsum);
            const bf16x8 Pf0 = pack_frag(St[0], St[1]), Pf1 = pack_frag(St[2], St[3]);
#pragma unroll
            for (int dt = 0; dt < 4; ++dt) {
                f32x4 o = __builtin_amdgcn_mfma_f32_16x16x32_bf16(Vf[dt][0], Pf0, (f32x4){0.f, 0.f, 0.f, 0.f}, 0, 0, 0);
                o = __builtin_amdgcn_mfma_f32_16x16x32_bf16(Vf[dt][1], Pf1, o, 0, 0, 0);
                if (cval) {
                    float* oa = Oacc + row * AO_LD + 16 * dt + 4 * g;
                    atomicAdd(oa, o[0]); atomicAdd(oa + 1, o[1]); atomicAdd(oa + 2, o[2]); atomicAdd(oa + 3, o[3]);
                }
            }
        }
    }
}
__device__ __forceinline__ unsigned long long lds_u64_uniform(const unsigned char* ptr) {
    const unsigned lo = __builtin_amdgcn_readfirstlane(((const unsigned*)ptr)[0]), hi = __builtin_amdgcn_readfirstlane(((const unsigned*)ptr)[1]);
    return ((unsigned long long)hi << 32) | lo;
}
__device__ __forceinline__ void ph_attn(const Params& p, unsigned char* smem) {
    const bf16_t* kvq = (const bf16_t*)(p.ws + KVQ); const float* gates = (const float*)(p.ws + GATES); const int* misc = (const int*)(p.ws + MISC);
    bf16_t* ao = (bf16_t*)(p.ws + ATTN_OUT);
    bf16_t* Qs = (bf16_t*)(smem + AL_Q); float* Oacc = (float*)(smem + AL_O); float* lacc = (float*)(smem + AL_L); float* Mrow = (float*)(smem + AL_M); float* qn = (float*)(smem + AL_QN);
    float* imp = (float*)(smem + AL_IMP); unsigned long long* mask = (unsigned long long*)(smem + AL_MASK);
    const int tid = threadIdx.x, lane = tid & 63, w = __builtin_amdgcn_readfirstlane(tid >> 6);
    for (int rnd = 0; rnd < 4; ++rnd) {
        const int u = blockIdx.x + rnd * gridDim.x;
        if (u >= 1024) break;
        const int bg = u & 7, c5 = (u >> 3) & 31, kq = u >> 8;
        const int cur = kq == 0 ? c5 : (kq == 1 ? 63 - c5 : (kq == 2 ? 64 + c5 : 127 - c5));
        const int b = bg >> 2, g = bg & 3; const size_t tok0 = (size_t)b * S_ + cur * 64;
        __syncthreads();
#pragma unroll
        for (int i = 0; i < 4; ++i) { const int idx = tid + i * NT, row = idx >> 3, ch = idx & 7; *(u32x4*)(Qs + row * AQ_LD + ch * 8) = *(const u32x4*)(kvq + (tok0 + (row >> 2)) * KVQ_LD + 1536 + (g * 4 + (row & 3)) * 64 + ch * 8); }
        if (tid < 128) mask[tid] = 0ull;
        for (int i = tid; i < 64 * 128; i += NT) imp[i] = 0.f;
        __syncthreads();
        if (tid < 256) { float s = 0.f;
#pragma unroll
            for (int c = 0; c < 8; ++c) { float f[8]; unpack8(*(const u32x4*)(Qs + tid * AQ_LD + c * 8), f);
#pragma unroll
                for (int j = 0; j < 8; ++j) s += f[j] * f[j]; }
            qn[tid] = sqrtf(s) * 1.01f + 1e-6f; }
        const int orow = tid >> 1, oh = (tid & 1) * 32;
        float outv[32];
#pragma unroll
        for (int i = 0; i < 32; ++i) outv[i] = 0.f;
        const float* grow = gates + (tok0 + (orow >> 2)) * 48 + (g * 4 + (orow & 3)) * 3;
#pragma unroll 1
        for (int br = 0; br < 3; ++br) {
            __syncthreads();
            const float kmx = __int_as_float(br == 0 ? misc[MI_KMAXC + bg] : misc[MI_KMAX + ((br == 1 ? 1 : 2) * 2 + b) * 4 + g]);
            if (tid < 256) { Mrow[tid] = qn[tid] * kmx * LOG2E; lacc[tid] = 0.f; }
            for (int i = tid; i < 256 * AO_LD; i += NT) Oacc[i] = 0.f;
            __syncthreads();
            if (br == 0) {
                const int nblk = min(8, (4 * cur + 2) / 64 + 1);
                for (int it = w; it < nblk * 4; it += 8) {
                    const int jc = it >> 2, qc = it & 3;
                    const AttnBlk blk = {(const bf16_t*)(p.ws + KCMPB) + (size_t)(bg * 512 + jc * 64) * 64, 64, (const bf16_t*)(p.ws + VCMPT) + (size_t)bg * 64 * 512 + jc * 64, 512};
                    attn_item<0>(smem, blk, 0xffffull << (16 * qc), 3, jc, cur, lane);
                }
                __syncthreads();
                for (int it = w; it < nblk * 4; it += 8) {
                    const int jc = it >> 2, qc = it & 3;
                    const AttnBlk blk = {(const bf16_t*)(p.ws + KCMPB) + (size_t)(bg * 512 + jc * 64) * 64, 64, nullptr, 0};
                    attn_item<1>(smem, blk, 0xffffull << (16 * qc), 3, jc, cur, lane);
                }
                __syncthreads();
                for (int k = 0; k < 8; ++k) {
                    const int tl = w * 8 + k;
                    float sc0, sc1;
                    { const int s = lane; const bool valid = s <= cur, forced = (s == 0) || (s == cur) || (s == cur - 1); sc0 = valid ? imp[tl * 128 + s] + (forced ? 1000.f : 0.f) : -1e30f; }
                    { const int s = lane + 64; const bool valid = s <= cur, forced = (s == 0) || (s == cur) || (s == cur - 1); sc1 = valid ? imp[tl * 128 + s] + (forced ? 1000.f : 0.f) : -1e30f; }
                    for (int rd = 0; rd < 16; ++rd) {
                        const float mx = wave_max(fmaxf(sc0, sc1));
                        const unsigned long long b0 = __ballot(sc0 == mx);
                        int wsel;
                        if (b0) { const int wl = __ffsll((long long)b0) - 1; wsel = wl; if (lane == wl) sc0 = -3.0e38f; }
                        else { const unsigned long long b1 = __ballot(sc1 == mx); const int wl = __ffsll((long long)b1) - 1; wsel = wl + 64; if (lane == wl) sc1 = -3.0e38f; }
                        if (lane == 0 && wsel <= cur) atomicOr(&mask[wsel], 1ull << tl);
                    }
                }
            } else if (br == 1) {
                int item = 0;
                for (int j = 0; j <= cur; ++j) {
                    unsigned long long m = lds_u64_uniform((const unsigned char*)&mask[j]);
                    while (m) {
                        unsigned long long sub = 0ull;
                        for (int k = 0; k < 16 && m; ++k) { const unsigned long long low = m & (~m + 1ull); sub |= low; m ^= low; }
                        if ((item++ & 7) == w) {
                            const AttnBlk blk = {kvq + ((size_t)b * S_ + j * 64) * KVQ_LD + 512 + g * 64, KVQ_LD, (const bf16_t*)(p.ws + VST) + (size_t)(bg * 128 + j) * 4096, 64};
                            attn_item<2>(smem, blk, sub, j == cur ? 1 : 0, 0, cur, lane);
                        }
                    }
                }
            } else {
                const int j0 = max(0, cur - 8);
                for (int it = w; it < (cur - j0 + 1) * 4; it += 8) {
                    const int j = j0 + (it >> 2), qc = it & 3;
                    const AttnBlk blk = {kvq + ((size_t)b * S_ + j * 64) * KVQ_LD + 1024 + g * 64, KVQ_LD, (const bf16_t*)(p.ws + VWT) + (size_t)(bg * 128 + j) * 4096, 64};
                    attn_item<3>(smem, blk, 0xffffull << (16 * qc), j == cur ? 1 : (j == cur - 8 ? 2 : 0), 0, cur, lane);
                }
            }
            __syncthreads();
            {   const float l = lacc[orow]; const float sc = l > 0.f ? grow[br] / l : 0.f;
#pragma unroll
                for (int i4 = 0; i4 < 8; ++i4) { const f32x4 o = *(const f32x4*)(Oacc + orow * AO_LD + oh + i4 * 4); outv[i4 * 4] += sc * o[0]; outv[i4 * 4 + 1] += sc * o[1]; outv[i4 * 4 + 2] += sc * o[2]; outv[i4 * 4 + 3] += sc * o[3]; } }
        }
        {   bf16_t* dst = ao + (tok0 + (orow >> 2)) * 1024 + (g * 4 + (orow & 3)) * 64 + oh;
#pragma unroll
            for (int i8 = 0; i8 < 4; ++i8) *(u32x4*)(dst + i8 * 8) = (u32x4){pack2(outv[i8 * 8], outv[i8 * 8 + 1]), pack2(outv[i8 * 8 + 2], outv[i8 * 8 + 3]), pack2(outv[i8 * 8 + 4], outv[i8 * 8 + 5]), pack2(outv[i8 * 8 + 6], outv[i8 * 8 + 7])}; }
    }
}

struct EpiGeluBias { bf16_t* C; int ldc; const float* bias;
    __device__ __forceinline__ void operator()(int m, int n, f32x4 v) const {
        float y[4];
#pragma unroll
        for (int i = 0; i < 4; ++i) { const float x = v[i] + bias[n + i]; const float u2 = 1.5957691216057308f * (x + 0.044715f * x * x * x); y[i] = x / (1.f + __expf(-u2)); }
        *(u32x2*)(C + (size_t)m * ldc + n) = (u32x2){pack2(y[0], y[1]), pack2(y[2], y[3])}; } };
__device__ __forceinline__ void ph_cmp_gemm(const Params& p, unsigned char* smem) {
    const bf16_t* kvq = (const bf16_t*)(p.ws + KVQ); const float* pew = (const float*)(p.ws + MISC) + MI_PEW;
    for (int t = blockIdx.x; t < 64; t += gridDim.x) {
        const int nt = t & 1, mt = (t >> 1) & 1, bg = (t >> 2) & 7, kv = t >> 5, b = bg >> 2, g = bg & 3;
        const bf16_t* A = kvq + ((size_t)b * S_ + 16 * (mt * 256)) * KVQ_LD + kv * 256 + g * 64;
        const bf16_t* Bt = (const bf16_t*)(p.ws + WT_CW1) + (size_t)(kv * 256 + nt * 128) * 2048;
        bf16_t* C = (bf16_t*)(p.ws + HC) + (size_t)((kv * 8 + bg) * 512 + mt * 256) * 256 + nt * 128;
        gemm_tile(A, 16 * KVQ_LD, Bt, 2048, 2048, EpiGeluBias{C, 256, pew + kv * 256 + nt * 128}, smem, KVQ_LD);
    }
}
__global__ void __launch_bounds__(NT) fwd_kernel(Params p) {
    cg::grid_group grid = cg::this_grid();
    extern __shared__ __attribute__((aligned(16))) unsigned char smem[];
    float* hf = (float*)(p.ws + H_F32); bf16_t* hb = (bf16_t*)(p.ws + H_BF);
    ph_prep0(p, smem); ph_moe_weights(p, 0, smem);
    grid.sync();
    ph_gemm_retin(p, smem);
    grid.sync();
    ph_rope_ret(p);
    grid.sync();
    ph_ret_state(p, smem);
    grid.sync();
    ph_ret_scan(p, smem);
    grid.sync();
    ph_gnorm_gate(p);
    grid.sync();
    ph_gemm_f32((const bf16_t*)p.out, (const bf16_t*)(p.ws + WT_OUT), hf, 64, 8, 2048, 1024, smem);
    grid.sync();
    ph_ln<false, true, false>(p, p.x, hf, hf, hb, p.ln_mix_g, p.ln_mix_b, 0);
    grid.sync();
    ph_moe_scatter(p, 0);
    grid.sync();
    ph_moe_gemm<0>(p, 0, smem);
    grid.sync();
    ph_moe_gemm<1>(p, 0, smem);
    grid.sync();
    ph_ln<true, false, false>(p, hf, nullptr, hf, hb, p.ln_ffn_g, p.ln_ffn_b, 0);
    ph_moe_weights(p, 1, smem); ph_prep1(p, smem);
    grid.sync();
    ph_gemm_bf16(hb, (const bf16_t*)(p.ws + WT_KVQ), (bf16_t*)(p.ws + KVQ), 64, KVQ_LD / 128, 1024, KVQ_LD, smem);
    grid.sync();
    ph_rope_nsa(p); ph_vt(p);
    grid.sync();
    ph_cmp_gemm(p, smem);
    grid.sync();
    ph_cmp2(p);
    grid.sync();
    ph_attn(p, smem);
    grid.sync();
    ph_gemm_f32((const bf16_t*)(p.ws + ATTN_OUT), (const bf16_t*)(p.ws + WT_NSAOUT), (float*)(p.ws + MIX2), 64, 8, 1024, 1024, smem);
    grid.sync();
    ph_ln<false, true, false>(p, hf, (const float*)(p.ws + MIX2), hf, hb, p.ln_mix_g + 1024, p.ln_mix_b + 1024, 1);
    grid.sync();
    ph_moe_scatter(p, 1);
    grid.sync();
    ph_moe_gemm<0>(p, 1, smem);
    grid.sync();
    ph_moe_gemm<1>(p, 1, smem);
    grid.sync();
    ph_ln<true, false, true>(p, hf, nullptr, p.out, nullptr, p.ln_ffn_g + 1024, p.ln_ffn_b + 1024, 1);
}

extern "C" void kernel_launch(void* const* d_in, const int* in_sizes, int n_in, void* d_out, int out_size, void* d_ws, size_t ws_size, hipStream_t stream) {
    (void)in_sizes; (void)n_in; (void)out_size;
    if (ws_size < WS_NEEDED) { fprintf(stderr, "workspace too small: %zu < %zu\n", ws_size, (size_t)WS_NEEDED); return; }
    static int grid_blocks = 0;
    if (!grid_blocks) {
        int dev = 0, cus = 0, per_cu = 0;
        (void)hipGetDevice(&dev);
        (void)hipDeviceGetAttribute(&cus, hipDeviceAttributeMultiprocessorCount, dev);
        (void)hipFuncSetAttribute((const void*)fwd_kernel, hipFuncAttributeMaxDynamicSharedMemorySize, LDS_BYTES);
        (void)hipOccupancyMaxActiveBlocksPerMultiprocessor(&per_cu, fwd_kernel, NT, LDS_BYTES);
        if (per_cu > 1) per_cu = 1;
        grid_blocks = cus * per_cu;
    }
    Params p{};
    const float** pp = (const float**)&p;
    for (int i = 0; i < 21; ++i) pp[i] = (const float*)d_in[i];
    p.out = (float*)d_out; p.ws = (unsigned char*)d_ws;
    void* args[] = {&p};
    hipError_t e = hipLaunchCooperativeKernel((void*)fwd_kernel, dim3(grid_blocks), dim3(NT), args, LDS_BYTES, stream);
    if (e != hipSuccess) fprintf(stderr, "cooperative launch failed: %s (grid %d)\n", hipGetErrorString(e), grid_blocks);
}
```

```cpp
#include <hip/hip_runtime.h>
#include <hip/hip_cooperative_groups.h>
#include <cstdio>
#include <cstdint>
namespace cg = cooperative_groups;

typedef unsigned short bf16_t;
typedef short bf16x8 __attribute__((ext_vector_type(8)));
typedef float f32x4 __attribute__((ext_vector_type(4)));
typedef unsigned u32x4 __attribute__((ext_vector_type(4)));
typedef unsigned u32x2 __attribute__((ext_vector_type(2)));

#define NT 512
#ifndef DUPMASK
#define DUPMASK 0u
#endif
#define RUN(bit, call) do { call; if (DUPMASK & (1u << (bit))) { xcd_barrier(xb); call; } } while (0)
constexpr int LDS_BYTES = 144 * 1024;
constexpr int T_ = 16384, D_ = 1024, S_ = 8192;
constexpr size_t MiB = 1u << 20;
constexpr size_t XB = 0, WT_IN = 32 * MiB, QB = 44 * MiB, KB = 76 * MiB, VB = 108 * MiB, GB = 172 * MiB;
constexpr size_t WT_OUT = 246 * MiB, MOEW_GU = 250 * MiB, MOEW_D = 282 * MiB;
constexpr size_t H_F32 = 0, H_BF = 64 * MiB, YEXP = 96 * MiB, XS = 172 * MiB, MISC = 244 * MiB;
constexpr size_t WT_KVQ = 236 * MiB, WT_NSAOUT = 242 * MiB;
constexpr size_t KVQ = 96 * MiB, GATES = 180 * MiB, HC = 183 * MiB, KCMPB = 187 * MiB, VCMPT = 187 * MiB + 512 * 1024, VST = 188 * MiB, VWT = 196 * MiB, ATTN_OUT = 204 * MiB, WT_CW1 = 246 * MiB;
constexpr size_t MIX2 = 96 * MiB;
constexpr size_t RET_L = 0;
constexpr size_t WS_NEEDED = 298 * MiB;
constexpr int KVQ_LD = 2688;
constexpr size_t BAR_OFF = 245 * MiB;
constexpr int MI_KMAX = 64, MI_KMAXC = 96, MI_PEW = 512;
constexpr int MI_CNT = 0, MI_TE = 1024, MI_TW = MI_TE + 32768, MI_TI = MI_TW + 32768, MI_TR = MI_TI + 32768;

struct Params {
    const float *x, *ret_w_in, *ret_w_out, *nsa_w_kv, *pe_k, *pe_v, *ck_w1, *ck_w2, *cv_w1, *cv_w2, *nsa_w_in, *nsa_w_out,
        *router_w, *router_b, *moe_wg, *moe_wu, *moe_wd, *ln_mix_g, *ln_mix_b, *ln_ffn_g, *ln_ffn_b;
    float* out; unsigned char* ws;
};

__device__ __forceinline__ bf16_t f2bf(float f) { unsigned u = __float_as_uint(f); u += 0x7fffu + ((u >> 16) & 1u); return (bf16_t)(u >> 16); }
__device__ __forceinline__ float bf2f(bf16_t h) { return __uint_as_float(((unsigned)h) << 16); }
typedef float f32x2 __attribute__((ext_vector_type(2)));
typedef __bf16 bf16x2_t __attribute__((ext_vector_type(2)));
__device__ __forceinline__ unsigned pack2(float a, float b) { const f32x2 v = {a, b}; return __builtin_bit_cast(unsigned, __builtin_convertvector(v, bf16x2_t)); }
__device__ __forceinline__ float lo2f(unsigned u) { return __uint_as_float(u << 16); }
__device__ __forceinline__ float hi2f(unsigned u) { return __uint_as_float(u & 0xffff0000u); }
__device__ __forceinline__ float wave_sum(float v) {
#pragma unroll
    for (int o = 32; o > 0; o >>= 1) v += __shfl_xor(v, o);
    return v;
}
__device__ __forceinline__ float wave_max(float v) {
#pragma unroll
    for (int o = 32; o > 0; o >>= 1) v = fmaxf(v, __shfl_xor(v, o));
    return v;
}
__device__ __forceinline__ int gtid() { return blockIdx.x * NT + threadIdx.x; }
__device__ __forceinline__ int gthreads() { return gridDim.x * NT; }
__device__ __forceinline__ int gwave() { return (threadIdx.x >> 6) * gridDim.x + blockIdx.x; }
__device__ __forceinline__ int gwaves() { return gridDim.x * (NT / 64); }
__device__ __forceinline__ void unpack8(u32x4 u, float* f) {
    f[0] = lo2f(u.x); f[1] = hi2f(u.x); f[2] = lo2f(u.y); f[3] = hi2f(u.y); f[4] = lo2f(u.z); f[5] = hi2f(u.z); f[6] = lo2f(u.w); f[7] = hi2f(u.w);
}

template <class F> __device__ __forceinline__ void transpose_conv(F src, bf16_t* dst, int K, int N, float* tile) {
    const int tilesK = K >> 6, ntile = (N >> 6) * tilesK;
    for (int t = blockIdx.x; t < ntile; t += gridDim.x) {
        const int n0 = (t / tilesK) << 6, k0 = (t % tilesK) << 6;
#pragma unroll
        for (int i = 0; i < 8; ++i) { const int idx = threadIdx.x + i * NT, kk = idx >> 6, r = idx & 63; tile[kk * 65 + r] = src(k0 + kk, n0 + r); }
        __syncthreads();
#pragma unroll
        for (int i = 0; i < 8; ++i) { const int idx = threadIdx.x + i * NT, r = idx >> 6, kk = idx & 63; dst[(size_t)(n0 + r) * K + k0 + kk] = f2bf(tile[kk * 65 + r]); }
        __syncthreads();
    }
}

template <class Epi> __device__ __forceinline__ void gemm_tile(const bf16_t* __restrict__ A, int lda, const bf16_t* __restrict__ Bt, int ldb, int K, const Epi& epi, unsigned char* smem, int akstride = 64) {
    const int tid = threadIdx.x, lane = tid & 63, wid = tid >> 6, wm = wid >> 1, wn = wid & 1, fr = lane & 15, fq = lane >> 4;
    bf16_t* As = (bf16_t*)smem;
    bf16_t* Bs = As + 256 * 72;
    f32x4 acc[4][4];
#pragma unroll
    for (int i = 0; i < 4; ++i)
#pragma unroll
        for (int j = 0; j < 4; ++j) acc[i][j] = (f32x4){0.f, 0.f, 0.f, 0.f};
    u32x4 ra[4], rb[2];
    const int lrow = tid >> 3, lkc = tid & 7;
    const bf16_t* ag = A + (size_t)lrow * lda + lkc * 8;
    const bf16_t* bg = Bt + (size_t)lrow * ldb + lkc * 8;
#pragma unroll
    for (int i = 0; i < 4; ++i) ra[i] = *(const u32x4*)(ag + (size_t)i * 64 * lda);
#pragma unroll
    for (int i = 0; i < 2; ++i) rb[i] = *(const u32x4*)(bg + (size_t)i * 64 * ldb);
    const int nk = K >> 6;
    for (int kt = 0; kt < nk; ++kt) {
#pragma unroll
        for (int i = 0; i < 4; ++i) *(u32x4*)(As + (lrow + i * 64) * 72 + lkc * 8) = ra[i];
#pragma unroll
        for (int i = 0; i < 2; ++i) *(u32x4*)(Bs + (lrow + i * 64) * 72 + lkc * 8) = rb[i];
        __syncthreads();
        if (kt + 1 < nk) {
            const int k0 = (kt + 1) << 6; const size_t ka = (size_t)(kt + 1) * akstride;
#pragma unroll
            for (int i = 0; i < 4; ++i) ra[i] = *(const u32x4*)(ag + (size_t)i * 64 * lda + ka);
#pragma unroll
            for (int i = 0; i < 2; ++i) rb[i] = *(const u32x4*)(bg + (size_t)i * 64 * ldb + k0);
        }
#pragma unroll
        for (int s = 0; s < 2; ++s) {
            bf16x8 af[4], bfr[4];
#pragma unroll
            for (int i = 0; i < 4; ++i) af[i] = *(const bf16x8*)(As + (wm * 64 + i * 16 + fr) * 72 + s * 32 + fq * 8);
#pragma unroll
            for (int j = 0; j < 4; ++j) bfr[j] = *(const bf16x8*)(Bs + (wn * 64 + j * 16 + fr) * 72 + s * 32 + fq * 8);
#pragma unroll
            for (int i = 0; i < 4; ++i)
#pragma unroll
                for (int j = 0; j < 4; ++j) acc[i][j] = __builtin_amdgcn_mfma_f32_16x16x32_bf16(bfr[j], af[i], acc[i][j], 0, 0, 0);
        }
        __syncthreads();
    }
#pragma unroll
    for (int i = 0; i < 4; ++i)
#pragma unroll
        for (int j = 0; j < 4; ++j) epi(wm * 64 + i * 16 + fr, wn * 64 + j * 16 + fq * 4, acc[i][j]);
}

struct EpiBf16 { bf16_t* C; int ldc;
    __device__ __forceinline__ void operator()(int m, int n, f32x4 v) const { *(uint2*)(C + (size_t)m * ldc + n) = make_uint2(pack2(v[0], v[1]), pack2(v[2], v[3])); } };
struct EpiF32 { float* C; int ldc;
    __device__ __forceinline__ void operator()(int m, int n, f32x4 v) const { *(float4*)(C + (size_t)m * ldc + n) = make_float4(v[0], v[1], v[2], v[3]); } };
struct EpiSwiglu { bf16_t* C; int ldc;
    __device__ __forceinline__ void operator()(int m, int n, f32x4 v) const {
        const float a0 = v[0] / (1.f + __expf(-v[0])) * v[1], a1 = v[2] / (1.f + __expf(-v[2])) * v[3];
        *(unsigned*)(C + (size_t)m * ldc + (n >> 1)) = pack2(a0, a1); } };

__device__ __forceinline__ void ph_prep0(const Params& p, unsigned char* smem) {
    if (blockIdx.x == 0 && threadIdx.x < 128) ((int*)(p.ws + MISC))[threadIdx.x] = 0;
    {   const float4* x4 = (const float4*)p.x; uint2* xb = (uint2*)(p.ws + XB);
        for (int i = gtid(); i < T_ * D_ / 4; i += gthreads()) { const float4 v = x4[i]; xb[i] = make_uint2(pack2(v.x, v.y), pack2(v.z, v.w)); } }
    float* tile = (float*)smem;
    { const float* w = p.ret_w_in; transpose_conv([w](int k, int n) { return w[(size_t)k * 6144 + n]; }, (bf16_t*)(p.ws + WT_IN), 1024, 6144, tile); }
    { const float* w = p.ret_w_out; transpose_conv([w](int k, int n) { return w[(size_t)k * 1024 + n]; }, (bf16_t*)(p.ws + WT_OUT), 2048, 1024, tile); }
}
__device__ __forceinline__ void ph_moe_weights(const Params& p, int l, unsigned char* smem) {
    float* tile = (float*)smem;
    { const float* wg = p.moe_wg + (size_t)l * 16 * 1024 * 512; const float* wu = p.moe_wu + (size_t)l * 16 * 1024 * 512;
      const ptrdiff_t du = wu - wg;
      transpose_conv([wg, du](int k, int n) { const int e = n >> 10, c = n & 1023; return wg[(ptrdiff_t)(c & 1) * du + ((size_t)e * 1024 + k) * 512 + (c >> 1)]; },
                     (bf16_t*)(p.ws + MOEW_GU), 1024, 16 * 1024, tile); }
    { const float* wd = p.moe_wd + (size_t)l * 16 * 512 * 1024;
      transpose_conv([wd](int k, int n) { const int e = n >> 10, c = n & 1023; return wd[((size_t)e * 512 + k) * 1024 + c]; }, (bf16_t*)(p.ws + MOEW_D), 512, 16 * 1024, tile); }
}
__device__ __forceinline__ void ph_prep1(const Params& p, unsigned char* smem) {
    float* tile = (float*)smem;
    { const float* wkv = p.nsa_w_kv; const float* win = p.nsa_w_in;
      transpose_conv([wkv, win](int k, int n) { return n < 1536 ? wkv[(size_t)k * 1536 + n] : (n < 2608 ? win[(size_t)k * 1072 + (n - 1536)] : 0.f); },
                     (bf16_t*)(p.ws + WT_KVQ), 1024, KVQ_LD, tile); }
    { const float* w = p.nsa_w_out; transpose_conv([w](int k, int n) { return w[(size_t)k * 1024 + n]; }, (bf16_t*)(p.ws + WT_NSAOUT), 1024, 1024, tile); }
    { const float* wk = p.ck_w1; const ptrdiff_t dv = p.cv_w1 - p.ck_w1; transpose_conv([wk, dv](int k, int n) { return wk[(ptrdiff_t)(n >> 8) * dv + (size_t)k * 256 + (n & 255)]; }, (bf16_t*)(p.ws + WT_CW1), 2048, 512, tile); }
}

__device__ __forceinline__ void ph_gemm_retin(const Params& p, unsigned char* smem) {
    const bf16_t* A = (const bf16_t*)(p.ws + XB); const bf16_t* Bt = (const bf16_t*)(p.ws + WT_IN);
    for (int t = blockIdx.x; t < 64 * 48; t += gridDim.x) {
        const int mt = t / 48, nt = t % 48, n0 = nt * 128;
        bf16_t* C; int ldc;
        if (n0 < 1024) { C = (bf16_t*)(p.ws + QB) + n0; ldc = 1024; }
        else if (n0 < 2048) { C = (bf16_t*)(p.ws + KB) + (n0 - 1024); ldc = 1024; }
        else if (n0 < 4096) { C = (bf16_t*)(p.ws + VB) + (n0 - 2048); ldc = 2048; }
        else { C = (bf16_t*)(p.ws + GB) + (n0 - 4096); ldc = 2048; }
        gemm_tile(A + (size_t)mt * 256 * 1024, 1024, Bt + (size_t)n0 * 1024, 1024, 1024, EpiBf16{C + (size_t)mt * 256 * ldc, ldc}, smem);
    }
}
__device__ __forceinline__ void ph_gemm_f32(const bf16_t* A, const bf16_t* Bt, float* C, int Mt, int Nt, int K, int N, unsigned char* smem) {
    for (int t = blockIdx.x; t < Mt * Nt; t += gridDim.x) {
        const int mt = t / Nt, nt = t % Nt;
        gemm_tile(A + (size_t)mt * 256 * K, K, Bt + (size_t)nt * 128 * K, K, K, EpiF32{C + (size_t)mt * 256 * N + nt * 128, N}, smem);
    }
}
__device__ __forceinline__ void ph_gemm_bf16(const bf16_t* A, const bf16_t* Bt, bf16_t* C, int Mt, int Nt, int K, int N, unsigned char* smem) {
    for (int t = blockIdx.x; t < Mt * Nt; t += gridDim.x) {
        const int mt = t / Nt, nt = t % Nt;
        gemm_tile(A + (size_t)mt * 256 * K, K, Bt + (size_t)nt * 128 * K, K, K, EpiBf16{C + (size_t)mt * 256 * N + nt * 128, N}, smem);
    }
}

__device__ __forceinline__ void ph_rope_ret(const Params& p) {
    bf16_t* Q = (bf16_t*)(p.ws + QB); bf16_t* K = (bf16_t*)(p.ws + KB);
    for (int it = gtid(); it < T_ * 4 * 128; it += gthreads()) {
        const int i = it & 127, h = (it >> 7) & 3, tok = it >> 9, t = tok & (S_ - 1);
        const float inv = (float)pow(10000.0, (double)(-(float)(2 * i) / 256.0f));
        const float ang = (float)t * inv, c = cosf(ang), s = sinf(ang);
        const size_t o = (size_t)tok * 1024 + h * 256 + i;
        { const float x1 = bf2f(Q[o]), x2 = bf2f(Q[o + 128]); Q[o] = f2bf(x1 * c - x2 * s); Q[o + 128] = f2bf(x2 * c + x1 * s); }
        { const float kd = 0.0625f * exp2f((float)(127 - (t & 127)) * log2f(1.f - exp2f(-5.f - (float)h)));
          const float x1 = bf2f(K[o]), x2 = bf2f(K[o + 128]); K[o] = f2bf((x1 * c - x2 * s) * kd); K[o + 128] = f2bf((x2 * c + x1 * s) * kd); }
    }
}
typedef short s16x4 __attribute__((ext_vector_type(4)));
#define LDSP(T, ptr) ((__attribute__((address_space(3))) T*)(ptr))
__device__ __forceinline__ bf16x8 tr_frag(const bf16_t* tile, int ld, int row0, int col0, int lane) {
    const int g = lane >> 4, q = (lane & 15) >> 2, pp = lane & 3;
    const bf16_t* a = tile + (row0 + 8 * g + q) * ld + col0 + 4 * pp;
    const s16x4 lo = __builtin_amdgcn_ds_read_tr16_b64_v4i16(LDSP(s16x4, a));
    const s16x4 hi = __builtin_amdgcn_ds_read_tr16_b64_v4i16(LDSP(s16x4, a + 4 * ld));
    return (bf16x8){lo[0], lo[1], lo[2], lo[3], hi[0], hi[1], hi[2], hi[3]};
}
__device__ __forceinline__ bf16x8 pack_frag(f32x4 a, f32x4 b) {
    u32x4 u = {pack2(a[0], a[1]), pack2(a[2], a[3]), pack2(b[0], b[1]), pack2(b[2], b[3])};
    return __builtin_bit_cast(bf16x8, u);
}
constexpr int RQ_LD = 264, RK_LD = 136;
template <int NCH> __device__ __forceinline__ void stage_tile(const bf16_t* g, int gld, bf16_t* l, int lld) {
    const int row = threadIdx.x / NCH, ch = threadIdx.x % NCH, goff = row * gld + ch * 8, loff = row * lld + ch * 8;
#pragma unroll
    for (int i = 0; i < (128 * NCH) / NT; ++i) { *(u32x4*)(l + loff + i * (NT / NCH) * lld) = *(const u32x4*)(g + (size_t)i * (NT / NCH) * gld + goff); if ((i & 3) == 3) asm volatile("" ::: "memory"); }
}
__device__ __forceinline__ void ph_ret_state(const Params& p, unsigned char* smem) {
    const bf16_t* K = (const bf16_t*)(p.ws + KB); const bf16_t* V = (const bf16_t*)(p.ws + VB); float* L = (float*)(p.ws + RET_L);
    bf16_t* Ks = (bf16_t*)smem; bf16_t* Vs = Ks + 128 * RQ_LD;
    const int lane = threadIdx.x & 63, w = __builtin_amdgcn_readfirstlane(threadIdx.x >> 6), g = lane >> 4, i16 = lane & 15;
    for (int unit = blockIdx.x; unit < 224; unit += gridDim.x) {
        const int slice = unit & 3, seg = (unit >> 2) % 7, bh = unit / 28, b = bh >> 2, h = bh & 3;
        const float lg = log2f(1.f - exp2f(-5.f - (float)h)), g128 = exp2f(128.f * lg);
        f32x4 S[16];
#pragma unroll
        for (int dt = 0; dt < 16; ++dt) S[dt] = (f32x4){0.f, 0.f, 0.f, 0.f};
        for (int ch = 0; ch < 8; ++ch) {
            const size_t tok0 = (size_t)b * S_ + seg * 1024 + ch * 128;
            __syncthreads();
            stage_tile<32>(K + tok0 * 1024 + h * 256, 1024, Ks, RQ_LD);
            stage_tile<16>(V + tok0 * 2048 + h * 512 + slice * 128, 2048, Vs, RK_LD);
            __syncthreads();
            bf16x8 Vf[4];
#pragma unroll
            for (int ks = 0; ks < 4; ++ks) Vf[ks] = tr_frag(Vs, RK_LD, 32 * ks, 16 * w, lane);
#pragma unroll
            for (int dt = 0; dt < 16; ++dt) {
                S[dt] = S[dt] * g128;
#pragma unroll
                for (int ks = 0; ks < 4; ++ks) S[dt] = __builtin_amdgcn_mfma_f32_16x16x32_bf16(tr_frag(Ks, RQ_LD, 32 * ks, 16 * dt, lane), Vf[ks], S[dt], 0, 0, 0);
            }
        }
        float* Lu = L + (size_t)((bh * 8 + seg) * 4 + slice) * (256 * 128) + threadIdx.x * 64;
#pragma unroll
        for (int dt = 0; dt < 16; ++dt) *(f32x4*)(Lu + dt * 4) = S[dt];
    }
}
__device__ __forceinline__ void ph_ret_scan(const Params& p, unsigned char* smem) {
    const bf16_t* Q = (const bf16_t*)(p.ws + QB); const bf16_t* K = (const bf16_t*)(p.ws + KB); const bf16_t* V = (const bf16_t*)(p.ws + VB);
    const float* L = (const float*)(p.ws + RET_L); bf16_t* O = (bf16_t*)p.out;
    bf16_t* Qs = (bf16_t*)smem; bf16_t* Ks = Qs + 128 * RK_LD; bf16_t* Vs = Ks + 128 * RK_LD; bf16_t* Ps = Vs + 128 * RK_LD;
    const int lane = threadIdx.x & 63, w = __builtin_amdgcn_readfirstlane(threadIdx.x >> 6), g = lane >> 4, i16 = lane & 15;
    for (int unit = blockIdx.x; unit < 256; unit += gridDim.x) {
        const int slice = unit & 3, seg = (unit >> 2) & 7, bh = unit >> 5, b = bh >> 2, h = bh & 3;
        const float lg = log2f(1.f - exp2f(-5.f - (float)h)), g128 = exp2f(128.f * lg), g1024 = exp2f(1024.f * lg), gm128 = exp2f(-128.f * lg);
        f32x4 S[16];
#pragma unroll
        for (int dt = 0; dt < 16; ++dt) S[dt] = (f32x4){0.f, 0.f, 0.f, 0.f};
        for (int j = 0; j < seg; ++j) {
            const float* Lu = L + (size_t)((bh * 8 + j) * 4 + slice) * (256 * 128) + threadIdx.x * 64;
#pragma unroll
            for (int dt = 0; dt < 16; ++dt) { S[dt] = S[dt] * g1024 + *(const f32x4*)(Lu + dt * 4); if ((dt & 3) == 3) asm volatile("" ::: "memory"); }
        }
        for (int ch = 0; ch < 8; ++ch) {
            const size_t tok0 = (size_t)b * S_ + seg * 1024 + ch * 128;
            f32x4 Oa[8], P[8];
#pragma unroll
            for (int i = 0; i < 8; ++i) { Oa[i] = (f32x4){0.f, 0.f, 0.f, 0.f}; P[i] = (f32x4){0.f, 0.f, 0.f, 0.f}; }
#pragma unroll
            for (int hf = 0; hf < 2; ++hf) {
                __syncthreads();
                stage_tile<16>(Q + tok0 * 1024 + h * 256 + hf * 128, 1024, Qs, RK_LD);
                stage_tile<16>(K + tok0 * 1024 + h * 256 + hf * 128, 1024, Ks, RK_LD);
                if (hf == 0) stage_tile<16>(V + tok0 * 2048 + h * 512 + slice * 128, 2048, Vs, RK_LD);
                __syncthreads();
                {
                    bf16x8 Sf[4];
#pragma unroll
                    for (int ks = 0; ks < 4; ++ks) Sf[ks] = pack_frag(S[8 * hf + 2 * ks], S[8 * hf + 2 * ks + 1]);
#pragma unroll
                    for (int ct = 0; ct < 8; ++ct) {
#pragma unroll
                        for (int ks = 0; ks < 4; ++ks) {
                            const bf16_t* qa = Qs + (16 * ct + i16) * RK_LD + 32 * ks + 4 * g;
                            const u32x2 lo = *(const u32x2*)qa, hi = *(const u32x2*)(qa + 16);
                            const u32x4 qq = {lo[0], lo[1], hi[0], hi[1]};
                            Oa[ct] = __builtin_amdgcn_mfma_f32_16x16x32_bf16(Sf[ks], __builtin_bit_cast(bf16x8, qq), Oa[ct], 0, 0, 0);
                        }
                        if (ct & 1) __builtin_amdgcn_sched_barrier(0);
                    }
                }
#pragma unroll
                for (int ks = 0; ks < 4; ++ks) {
                    const bf16x8 Qf = *(const bf16x8*)(Qs + (16 * w + i16) * RK_LD + 32 * ks + 8 * g);
#pragma unroll
                    for (int mt = 0; mt < 8; ++mt) if (mt <= w) P[mt] = __builtin_amdgcn_mfma_f32_16x16x32_bf16(*(const bf16x8*)(Ks + (16 * mt + i16) * RK_LD + 32 * ks + 8 * g), Qf, P[mt], 0, 0, 0);
                }
                __builtin_amdgcn_sched_barrier(0);
                if (hf == 1) {
                    const int c = 16 * w + i16;
#pragma unroll
                    for (int mt = 0; mt < 8; ++mt) {
                        float v[4];
#pragma unroll
                        for (int r = 0; r < 4; ++r) { const int m = 16 * mt + 4 * g + r; v[r] = (mt <= w && m <= c) ? P[mt][r] * gm128 : 0.f; }
                        *(u32x2*)(Ps + c * RK_LD + 16 * mt + 4 * g) = (u32x2){pack2(v[0], v[1]), pack2(v[2], v[3])};
                    }
                }
                {
                    bf16x8 Vf[4];
#pragma unroll
                    for (int ks = 0; ks < 4; ++ks) Vf[ks] = tr_frag(Vs, RK_LD, 32 * ks, 16 * w, lane);
#pragma unroll
                    for (int dt = 0; dt < 8; ++dt) {
                        S[8 * hf + dt] = S[8 * hf + dt] * g128;
#pragma unroll
                        for (int ks = 0; ks < 4; ++ks) S[8 * hf + dt] = __builtin_amdgcn_mfma_f32_16x16x32_bf16(tr_frag(Ks, RK_LD, 32 * ks, 16 * dt, lane), Vf[ks], S[8 * hf + dt], 0, 0, 0);
                        if (dt & 1) __builtin_amdgcn_sched_barrier(0);
                    }
                }
            }
            __syncthreads();
            {
                bf16x8 Vf[4];
#pragma unroll
                for (int ks = 0; ks < 4; ++ks) Vf[ks] = tr_frag(Vs, RK_LD, 32 * ks, 16 * w, lane);
#pragma unroll
                for (int ct = 0; ct < 8; ++ct)
#pragma unroll
                    for (int ks = 0; ks < 4; ++ks) if (ks <= ct / 2) Oa[ct] = __builtin_amdgcn_mfma_f32_16x16x32_bf16(Vf[ks], *(const bf16x8*)(Ps + (16 * ct + i16) * RK_LD + 32 * ks + 8 * g), Oa[ct], 0, 0, 0);
            }
            {
                bf16_t* ob = O + tok0 * 2048 + h * 512 + slice * 128 + 16 * w; const int ooff = i16 * 2048 + 4 * g;
#pragma unroll
                for (int ct = 0; ct < 8; ++ct) { const float sc = exp2f((float)(16 * ct + i16 + 1) * lg); *(u32x2*)(ob + (size_t)ct * 16 * 2048 + ooff) = (u32x2){pack2(Oa[ct][0] * sc, Oa[ct][1] * sc), pack2(Oa[ct][2] * sc, Oa[ct][3] * sc)}; }
            }
        }
    }
}
__device__ __forceinline__ void ph_gnorm_gate(const Params& p) {
    bf16_t* O = (bf16_t*)p.out; const bf16_t* G = (const bf16_t*)(p.ws + GB);
    const int lane = threadIdx.x & 63;
    for (int it = gwave(); it < T_ * 4; it += gwaves()) {
        const size_t off = (size_t)it * 512 + lane * 8;
        float x[8], g[8]; unpack8(*(const u32x4*)(O + off), x); unpack8(*(const u32x4*)(G + off), g);
        float s = 0.f;
#pragma unroll
        for (int j = 0; j < 8; ++j) s += x[j];
        const float mean = wave_sum(s) * (1.f / 512.f);
        float q = 0.f;
#pragma unroll
        for (int j = 0; j < 8; ++j) { x[j] -= mean; q += x[j] * x[j]; }
        const float rstd = rsqrtf(wave_sum(q) * (1.f / 512.f) + 1e-5f);
        float r[8];
#pragma unroll
        for (int j = 0; j < 8; ++j) r[j] = x[j] * rstd * (g[j] / (1.f + __expf(-g[j])));
        *(uint4*)(O + off) = make_uint4(pack2(r[0], r[1]), pack2(r[2], r[3]), pack2(r[4], r[5]), pack2(r[6], r[7]));
    }
}

template <bool COMBINE, bool ROUTER, bool FINAL> __forceinline__
__device__ __forceinline__ void ph_ln(const Params& p, const float* base, const float* mix, float* hout, bf16_t* hb, const float* lng, const float* lnb, int layer) {
    const int lane = threadIdx.x & 63;
    int* misc = (int*)(p.ws + MISC);
    const bf16_t* yexp = (const bf16_t*)(p.ws + YEXP);
    for (int tok = gwave(); tok < T_; tok += gwaves()) {
        float v[16];
        float w0 = 0.f, w1 = 0.f; int r0 = 0, r1 = 0;
        if (COMBINE) { w0 = __int_as_float(misc[MI_TW + tok * 2]); w1 = __int_as_float(misc[MI_TW + tok * 2 + 1]); r0 = misc[MI_TR + tok * 2]; r1 = misc[MI_TR + tok * 2 + 1]; }
#pragma unroll
        for (int i = 0; i < 4; ++i) {
            const float4 a = *(const float4*)(base + (size_t)tok * 1024 + i * 256 + lane * 4);
            float4 m;
            if (COMBINE) {
                const uint2 y0 = *(const uint2*)(yexp + (size_t)r0 * 1024 + i * 256 + lane * 4), y1 = *(const uint2*)(yexp + (size_t)r1 * 1024 + i * 256 + lane * 4);
                m.x = w0 * lo2f(y0.x) + w1 * lo2f(y1.x); m.y = w0 * hi2f(y0.x) + w1 * hi2f(y1.x); m.z = w0 * lo2f(y0.y) + w1 * lo2f(y1.y); m.w = w0 * hi2f(y0.y) + w1 * hi2f(y1.y);
            } else m = *(const float4*)(mix + (size_t)tok * 1024 + i * 256 + lane * 4);
            v[i * 4 + 0] = 1.41421356237f * a.x + m.x; v[i * 4 + 1] = 1.41421356237f * a.y + m.y; v[i * 4 + 2] = 1.41421356237f * a.z + m.z; v[i * 4 + 3] = 1.41421356237f * a.w + m.w;
        }
        float s = 0.f;
#pragma unroll
        for (int i = 0; i < 16; ++i) s += v[i];
        const float mean = wave_sum(s) * (1.f / 1024.f);
        float q = 0.f;
#pragma unroll
        for (int i = 0; i < 16; ++i) { v[i] -= mean; q += v[i] * v[i]; }
        const float rstd = rsqrtf(wave_sum(q) * (1.f / 1024.f) + 1e-5f);
#pragma unroll
        for (int i = 0; i < 4; ++i) {
            const float4 g = *(const float4*)(lng + i * 256 + lane * 4), bb = *(const float4*)(lnb + i * 256 + lane * 4);
            v[i * 4 + 0] = v[i * 4 + 0] * rstd * g.x + bb.x; v[i * 4 + 1] = v[i * 4 + 1] * rstd * g.y + bb.y; v[i * 4 + 2] = v[i * 4 + 2] * rstd * g.z + bb.z; v[i * 4 + 3] = v[i * 4 + 3] * rstd * g.w + bb.w;
            *(float4*)(hout + (size_t)tok * 1024 + i * 256 + lane * 4) = make_float4(v[i * 4 + 0], v[i * 4 + 1], v[i * 4 + 2], v[i * 4 + 3]);
            if (!FINAL) *(uint2*)(hb + (size_t)tok * 1024 + i * 256 + lane * 4) = make_uint2(pack2(v[i * 4 + 0], v[i * 4 + 1]), pack2(v[i * 4 + 2], v[i * 4 + 3]));
        }
        if (ROUTER) {
            float lg[16];
#pragma unroll
            for (int e = 0; e < 16; ++e) lg[e] = 0.f;
#pragma unroll
            for (int i = 0; i < 4; ++i)
#pragma unroll
                for (int j = 0; j < 4; ++j) {
                    const float4* rw = (const float4*)(p.router_w + (size_t)(i * 256 + lane * 4 + j) * 16);
                    const float hv = v[i * 4 + j];
#pragma unroll
                    for (int e4 = 0; e4 < 4; ++e4) { const float4 r = rw[e4]; lg[e4 * 4 + 0] += hv * r.x; lg[e4 * 4 + 1] += hv * r.y; lg[e4 * 4 + 2] += hv * r.z; lg[e4 * 4 + 3] += hv * r.w; }
                }
            float aff[16], sel[16];
#pragma unroll
            for (int e = 0; e < 16; ++e) { lg[e] = wave_sum(lg[e]); aff[e] = 1.f / (1.f + expf(-lg[e])); sel[e] = aff[e] + p.router_b[e]; }
            float best = -3.0e38f; int bg = 0; float b0 = 0, b1 = 0, b2 = 0, b3 = 0, a0 = 0, a1 = 0, a2 = 0, a3 = 0;
#pragma unroll
            for (int g = 0; g < 4; ++g) {
                const float x0 = sel[4 * g], x1 = sel[4 * g + 1], x2 = sel[4 * g + 2], x3 = sel[4 * g + 3];
                const float mx = fmaxf(fmaxf(x0, x1), fmaxf(x2, x3));
                const float m2 = fmaxf(fmaxf(fminf(x0, x1), fminf(x2, x3)), fminf(fmaxf(x0, x1), fmaxf(x2, x3)));
                const float gs = mx + m2;
                if (gs > best) { best = gs; bg = g; b0 = x0; b1 = x1; b2 = x2; b3 = x3; a0 = aff[4 * g]; a1 = aff[4 * g + 1]; a2 = aff[4 * g + 2]; a3 = aff[4 * g + 3]; }
            }
            int i1 = 0; float m = b0, wa = a0;
            if (b1 > m) { m = b1; i1 = 1; wa = a1; } if (b2 > m) { m = b2; i1 = 2; wa = a2; } if (b3 > m) { m = b3; i1 = 3; wa = a3; }
            int i2 = -1; float m2 = -3.0e38f, wb = 0.f;
            if (i1 != 0 && b0 > m2) { m2 = b0; i2 = 0; wb = a0; } if (i1 != 1 && b1 > m2) { m2 = b1; i2 = 1; wb = a1; }
            if (i1 != 2 && b2 > m2) { m2 = b2; i2 = 2; wb = a2; } if (i1 != 3 && b3 > m2) { m2 = b3; i2 = 3; wb = a3; }
            const float nrm = wa + wb;
            if (lane == 0) {
                const int e1 = bg * 4 + i1, e2 = bg * 4 + i2;
                misc[MI_TE + tok * 2] = e1; misc[MI_TE + tok * 2 + 1] = e2;
                misc[MI_TW + tok * 2] = __float_as_int(wa / nrm); misc[MI_TW + tok * 2 + 1] = __float_as_int(wb / nrm);
                misc[MI_TI + tok * 2] = atomicAdd(&misc[MI_CNT + layer * 16 + e1], 1);
                misc[MI_TI + tok * 2 + 1] = atomicAdd(&misc[MI_CNT + layer * 16 + e2], 1);
            }
        }
    }
}

__device__ __forceinline__ int moe_off(const int* cnt, int e) { int o = 0; for (int i = 0; i < e; ++i) o += (cnt[i] + 255) & ~255; return o; }
__device__ __forceinline__ void ph_moe_scatter(const Params& p, int layer) {
    int* misc = (int*)(p.ws + MISC); const int* cnt = misc + MI_CNT + layer * 16;
    const uint4* hb = (const uint4*)(p.ws + H_BF); uint4* xs = (uint4*)(p.ws + XS);
    const int lane = threadIdx.x & 63;
    for (int it = gwave(); it < T_ * 2; it += gwaves()) {
        const int tok = it >> 1, e = misc[MI_TE + it], row = moe_off(cnt, e) + misc[MI_TI + it];
        if (lane == 0) misc[MI_TR + it] = row;
        xs[(size_t)row * 128 + lane * 2] = hb[(size_t)tok * 128 + lane * 2];
        xs[(size_t)row * 128 + lane * 2 + 1] = hb[(size_t)tok * 128 + lane * 2 + 1];
    }
}
template <int WHICH> __device__ __forceinline__ void ph_moe_gemm(const Params& p, int layer, unsigned char* smem) {
    const int* cnt = (const int*)(p.ws + MISC) + MI_CNT + layer * 16;
    __shared__ int eoff[17];
    if (threadIdx.x == 0) { int o = 0; for (int e = 0; e < 16; ++e) { eoff[e] = o; o += (cnt[e] + 255) & ~255; } eoff[16] = o; }
    __syncthreads();
    const int Mt = eoff[16] >> 8;
    for (int t = blockIdx.x; t < Mt * 8; t += gridDim.x) {
        const int mt = t >> 3, nt = t & 7, row0 = mt << 8;
        int e = 0;
        while (e < 15 && row0 >= eoff[e + 1]) ++e;
        if (WHICH == 0) {
            const bf16_t* A = (const bf16_t*)(p.ws + XS) + (size_t)row0 * 1024;
            const bf16_t* Bt = (const bf16_t*)(p.ws + MOEW_GU) + ((size_t)e * 1024 + nt * 128) * 1024;
            gemm_tile(A, 1024, Bt, 1024, 1024, EpiSwiglu{(bf16_t*)p.out + (size_t)row0 * 512 + nt * 64, 512}, smem);
        } else {
            const bf16_t* A = (const bf16_t*)p.out + (size_t)row0 * 512;
            const bf16_t* Bt = (const bf16_t*)(p.ws + MOEW_D) + ((size_t)e * 1024 + nt * 128) * 512;
            gemm_tile(A, 512, Bt, 512, 512, EpiBf16{(bf16_t*)(p.ws + YEXP) + (size_t)row0 * 1024 + nt * 128, 1024}, smem);
        }
    }
}

__device__ __forceinline__ void ph_rope_nsa(const Params& p) {
    bf16_t* kvq = (bf16_t*)(p.ws + KVQ); float* gates = (float*)(p.ws + GATES); int* misc = (int*)(p.ws + MISC);
    const int lane = threadIdx.x & 63, i = lane & 31, half = lane >> 5;
    const float inv = (float)pow(10000.0, (double)(-(float)(2 * i) / 64.0f));
    float kmx[6];
#pragma unroll
    for (int it = 0; it < 6; ++it) kmx[it] = 0.f;
    for (int tok = gwave(); tok < T_; tok += gwaves()) {
        const int t = tok & (S_ - 1), b = tok >> 13;
        const float ang = (float)t * inv, c = cosf(ang), s = sinf(ang);
        bf16_t* row = kvq + (size_t)tok * KVQ_LD;
#pragma unroll
        for (int it = 0; it < 14; ++it) {
            const int rid = it * 2 + half;
            const int col = rid < 12 ? (rid >> 2) * 512 + (rid & 3) * 64 : 1536 + (rid - 12) * 64;
            const float sc = rid < 12 ? 1.f : 0.125f;
            const float x1 = bf2f(row[col + i]), x2 = bf2f(row[col + 32 + i]);
            const float y1 = (x1 * c - x2 * s) * sc, y2 = (x2 * c + x1 * s) * sc;
            row[col + i] = f2bf(y1); row[col + 32 + i] = f2bf(y2);
            if (it < 6) {
                float n2 = y1 * y1 + y2 * y2;
#pragma unroll
                for (int o = 16; o > 0; o >>= 1) n2 += __shfl_xor(n2, o);
                kmx[it] = fmaxf(kmx[it], n2);
            }
        }
        if (lane < 48) gates[tok * 48 + lane] = 1.f / (1.f + expf(-bf2f(row[2560 + lane])));
        const int nt = tok + gwaves();
        if (nt >= T_ || (nt >> 13) != b) {
#pragma unroll
            for (int it = 0; it < 6; ++it) {
                const int rid = it * 2 + half;
                if (i == 0) atomicMax(&misc[MI_KMAX + ((rid >> 2) * 2 + b) * 4 + (rid & 3)], __float_as_int(sqrtf(kmx[it]) * 1.01f + 1e-6f));
                kmx[it] = 0.f;
            }
        }
    }
    for (int o = gwave(); o < 512; o += gwaves()) {
        const int kv = o >> 8, j = o & 255; const float* w1 = kv ? p.cv_w1 : p.ck_w1; const float* pe = kv ? p.pe_v : p.pe_k;
        float a = 0.f;
        for (int k = lane; k < 2048; k += 64) a += pe[k] * w1[(size_t)k * 256 + j];
        a = wave_sum(a);
        if (lane == 0) ((float*)misc)[MI_PEW + o] = a;
    }
}
__device__ __forceinline__ void ph_vt(const Params& p) {
    const bf16_t* kvq = (const bf16_t*)(p.ws + KVQ);
    const int lane = threadIdx.x & 63;
    for (int it = gwave(); it < 2048; it += gwaves()) {
        const int part = it >> 10, bg = (it >> 7) & 7, blk = it & 127, b = bg >> 2, g = bg & 3;
        const bf16_t* src = kvq + ((size_t)b * S_ + blk * 64 + lane) * KVQ_LD + (part ? 1280 : 768) + g * 64;
        bf16_t* dst = (bf16_t*)(p.ws + (part ? VWT : VST)) + (size_t)(bg * 128 + blk) * 4096 + lane;
        u32x4 v[8];
#pragma unroll
        for (int c = 0; c < 8; ++c) v[c] = *(const u32x4*)(src + c * 8);
#pragma unroll
        for (int c = 0; c < 8; ++c)
#pragma unroll
            for (int e = 0; e < 4; ++e) { dst[(c * 8 + e * 2) * 64] = (bf16_t)(v[c][e] & 0xffffu); dst[(c * 8 + e * 2 + 1) * 64] = (bf16_t)(v[c][e] >> 16); }
    }
}
__device__ __forceinline__ void ph_cmp2(const Params& p) {
    const bf16_t* hc = (const bf16_t*)(p.ws + HC); bf16_t* kc = (bf16_t*)(p.ws + KCMPB); bf16_t* vt = (bf16_t*)(p.ws + VCMPT); int* misc = (int*)(p.ws + MISC);
    const int lane = threadIdx.x & 63;
    for (int it = gwave(); it < 2 * 8 * 512; it += gwaves()) {
        const int n = it & 511, bg = (it >> 9) & 7, kv = it >> 12;
        const float* w2 = kv ? p.cv_w2 : p.ck_w2;
        float acc = 0.f;
        if (n < 511) { const bf16_t* hr = hc + (size_t)((kv * 8 + bg) * 512 + n) * 256; for (int j = 0; j < 256; ++j) acc += bf2f(hr[j]) * w2[j * 64 + lane]; }
        if (kv == 0) {
            kc[(size_t)(bg * 512 + n) * 64 + lane] = f2bf(acc);
            const float n2 = wave_sum(acc * acc);
            if (lane == 0) atomicMax(&misc[MI_KMAXC + bg], __float_as_int(sqrtf(n2) * 1.01f + 1e-6f));
        } else vt[(size_t)(bg * 64 + lane) * 512 + n] = f2bf(acc);
    }
}
constexpr int KT_LD = 72;
constexpr int A2_BUF = 0, A2_BUFSZ = 2 * 64 * KT_LD * 2, A2_IMP = 2 * A2_BUFSZ, A2_TM = A2_IMP + 32768, A2_OR = A2_TM + 1024, A2_OUT = A2_OR + 16, A2_END = A2_OUT + 256 * 68 * 4;
static_assert(A2_END <= LDS_BYTES - 16, "attention LDS");
constexpr float LOG2E = 1.4426950408889634f;
struct BlkSrc { const bf16_t* K; int ldk; const bf16_t* VT; int ldv; };
__device__ __forceinline__ int next_bit128(const unsigned (&m)[4], int j) {
    for (int k = j + 1; k < 128; ++k) if ((m[k >> 5] >> (k & 31)) & 1u) return k;
    return 128;
}
template <int BR> __device__ __forceinline__ void attn_branch(const Params& p, unsigned char* smem, const unsigned (&orm)[4], int bg, int cur, const bf16x8 (&Qf)[2][2], const float (&mrow)[2],
                                                               const unsigned (&tm)[2][4], const float (&invl)[2], float (&lsum)[2], f32x4 (&Oacc)[2][4]) {
    const int tid = threadIdx.x, lane = tid & 63, w = __builtin_amdgcn_readfirstlane(tid >> 6), g = lane >> 4, i16 = lane & 15;
    const int b = bg >> 2, g4 = bg & 3;
    const bf16_t* kvq = (const bf16_t*)(p.ws + KVQ);
    float* imp = (float*)(smem + A2_IMP);
    const int srow = tid >> 3, sch = tid & 7;
    auto src = [&](int j) -> BlkSrc {
        if (BR <= 1) return BlkSrc{(const bf16_t*)(p.ws + KCMPB) + (size_t)(bg * 512 + j * 64) * 64, 64, (const bf16_t*)(p.ws + VCMPT) + (size_t)bg * 64 * 512 + j * 64, 512};
        if (BR == 2) return BlkSrc{kvq + ((size_t)b * S_ + j * 64) * KVQ_LD + 512 + g4 * 64, KVQ_LD, (const bf16_t*)(p.ws + VST) + (size_t)(bg * 128 + j) * 4096, 64};
        return BlkSrc{kvq + ((size_t)b * S_ + j * 64) * KVQ_LD + 1024 + g4 * 64, KVQ_LD, (const bf16_t*)(p.ws + VWT) + (size_t)(bg * 128 + j) * 4096, 64};
    };
    u32x4 rk, rv;
    auto ld = [&](int j) { const BlkSrc s = src(j); rk = *(const u32x4*)(s.K + (size_t)srow * s.ldk + sch * 8); if (BR != 1) rv = *(const u32x4*)(s.VT + (size_t)srow * s.ldv + sch * 8); };
    auto st = [&](int bi) {
        bf16_t* buf = (bf16_t*)(smem + A2_BUF + bi * A2_BUFSZ);
        *(u32x4*)(buf + srow * KT_LD + sch * 8) = rk;
        if (BR != 1) {
#pragma unroll
            for (int hf = 0; hf < 2; ++hf) { const int k0 = sch * 8 + hf * 4, k32 = k0 & 31, pos = (k0 & ~31) + 8 * ((k32 & 15) >> 2) + 4 * (k32 >> 4);
                *(u32x2*)(buf + 64 * KT_LD + srow * KT_LD + pos) = hf ? (u32x2){rv[2], rv[3]} : (u32x2){rv[0], rv[1]}; }
        }
    };
    int j = next_bit128(orm, -1);
    if (j >= 128) return;
    ld(j);
    __syncthreads();
    st(0);
    __syncthreads();
    int bi = 0;
    while (j < 128) {
        const int jn = next_bit128(orm, j);
        if (jn < 128) ld(jn);
        const bf16_t* Kt = (const bf16_t*)(smem + A2_BUF + bi * A2_BUFSZ); const bf16_t* Vt = Kt + 64 * KT_LD;
        bool need[2]; unsigned selb[2];
#pragma unroll
        for (int bt = 0; bt < 2; ++bt) { selb[bt] = BR == 2 ? ((tm[bt][j >> 5] >> (j & 31)) & 1u) : 1u; need[bt] = BR == 2 ? (__ballot(selb[bt] != 0u) != 0ull) : true; }
        if (need[0] || need[1]) {
            bf16x8 Kf[4][2];
#pragma unroll
            for (int mt = 0; mt < 4; ++mt)
#pragma unroll
                for (int ks = 0; ks < 2; ++ks) Kf[mt][ks] = *(const bf16x8*)(Kt + (16 * mt + i16) * KT_LD + 32 * ks + 8 * g);
#pragma unroll
            for (int bt = 0; bt < 2; ++bt) {
                if (!need[bt]) continue;
                const int tq = 8 * w + 4 * bt + (i16 >> 2);
                f32x4 St[4];
#pragma unroll
                for (int mt = 0; mt < 4; ++mt) {
                    St[mt] = __builtin_amdgcn_mfma_f32_16x16x32_bf16(Kf[mt][0], Qf[bt][0], (f32x4){0.f, 0.f, 0.f, 0.f}, 0, 0, 0);
                    St[mt] = __builtin_amdgcn_mfma_f32_16x16x32_bf16(Kf[mt][1], Qf[bt][1], St[mt], 0, 0, 0);
                }
                const int nmax = (64 * cur + tq - 31) >> 4;
                float ls = 0.f;
#pragma unroll
                for (int mt = 0; mt < 4; ++mt)
#pragma unroll
                    for (int r = 0; r < 4; ++r) {
                        const int key = 16 * mt + 4 * g + r;
                        bool ok = selb[bt] != 0u;
                        if (BR <= 1) ok = (64 * j + key) <= nmax;
                        if (BR >= 2 && j == cur) ok = ok && key <= tq;
                        if (BR == 3 && j == cur - 8) ok = ok && key >= tq + 1;
                        const float pv = ok ? __builtin_amdgcn_exp2f(St[mt][r] * LOG2E - mrow[bt]) : 0.f;
                        St[mt][r] = pv; ls += pv;
                    }
                if (BR == 1) {
#pragma unroll
                    for (int mt = 0; mt < 4; ++mt) {
                        float s4 = (St[mt][0] + St[mt][1] + St[mt][2] + St[mt][3]) * invl[bt], p3 = St[mt][3] * invl[bt];
                        s4 += __shfl_xor(s4, 1); s4 += __shfl_xor(s4, 2); p3 += __shfl_xor(p3, 1); p3 += __shfl_xor(p3, 2);
                        const int sb = 16 * j + 4 * mt + g;
                        if ((i16 & 3) == 0) { atomicAdd(&imp[tq * 128 + sb], s4); if (sb + 1 < 128) atomicAdd(&imp[tq * 128 + sb + 1], p3); }
                    }
                } else {
                    lsum[bt] += ls;
                    const bf16x8 Pf0 = pack_frag(St[0], St[1]), Pf1 = pack_frag(St[2], St[3]);
#pragma unroll
                    for (int dt = 0; dt < 4; ++dt) {
                        Oacc[bt][dt] = __builtin_amdgcn_mfma_f32_16x16x32_bf16(*(const bf16x8*)(Vt + (16 * dt + i16) * KT_LD + 8 * g), Pf0, Oacc[bt][dt], 0, 0, 0);
                        Oacc[bt][dt] = __builtin_amdgcn_mfma_f32_16x16x32_bf16(*(const bf16x8*)(Vt + (16 * dt + i16) * KT_LD + 32 + 8 * g), Pf1, Oacc[bt][dt], 0, 0, 0);
                    }
                }
            }
        }
        if (jn < 128) st(bi ^ 1);
        __syncthreads();
        bi ^= 1; j = jn;
    }
}
__device__ __forceinline__ void ph_attn(const Params& p, unsigned char* smem) {
    const bf16_t* kvq = (const bf16_t*)(p.ws + KVQ); const float* gates = (const float*)(p.ws + GATES); const int* misc = (const int*)(p.ws + MISC);
    bf16_t* ao = (bf16_t*)(p.ws + ATTN_OUT);
    float* imp = (float*)(smem + A2_IMP); unsigned* tmask = (unsigned*)(smem + A2_TM); unsigned* tor = (unsigned*)(smem + A2_OR); float* outl = (float*)(smem + A2_OUT);
    const int tid = threadIdx.x, lane = tid & 63, w = __builtin_amdgcn_readfirstlane(tid >> 6), g = lane >> 4, i16 = lane & 15;
    for (int rnd = 0; rnd < 4; ++rnd) {
        const int u = blockIdx.x + rnd * gridDim.x;
        if (u >= 1024) break;
        const int bg = u & 7, c5 = (u >> 3) & 31, kq = u >> 8;
        const int cur = kq == 0 ? c5 : (kq == 1 ? 63 - c5 : (kq == 2 ? 64 + c5 : 127 - c5));
        const int b = bg >> 2, g4 = bg & 3; const size_t tok0 = (size_t)b * S_ + cur * 64;
        bf16x8 Qf[2][2]; float qn[2];
        const int head = g4 * 4 + (i16 & 3);
#pragma unroll
        for (int bt = 0; bt < 2; ++bt) {
            const size_t tok = tok0 + 8 * w + 4 * bt + (i16 >> 2);
            const bf16_t* qp = kvq + tok * KVQ_LD + 1536 + head * 64 + 8 * g;
            Qf[bt][0] = *(const bf16x8*)qp; Qf[bt][1] = *(const bf16x8*)(qp + 32);
            float f[16]; unpack8(__builtin_bit_cast(u32x4, Qf[bt][0]), f); unpack8(__builtin_bit_cast(u32x4, Qf[bt][1]), f + 8);
            float s = 0.f;
#pragma unroll
            for (int k = 0; k < 16; ++k) s += f[k] * f[k];
            s += __shfl_xor(s, 16); s += __shfl_xor(s, 32);
            qn[bt] = sqrtf(s) * 1.01f + 1e-6f;
        }
        __syncthreads();
        for (int k = lane; k < 8 * 128; k += 64) imp[w * 8 * 128 + k] = 0.f;
        if (tid < 4) tor[tid] = 0u;
        f32x4 Oacc[2][4]; float lsum[2] = {0.f, 0.f}, mrow[2], invl[2] = {0.f, 0.f}; unsigned tm[2][4];
#pragma unroll
        for (int bt = 0; bt < 2; ++bt) {
#pragma unroll
            for (int dt = 0; dt < 4; ++dt) Oacc[bt][dt] = (f32x4){0.f, 0.f, 0.f, 0.f};
#pragma unroll
            for (int k = 0; k < 4; ++k) tm[bt][k] = 0u;
        }
        auto finish = [&](int c) {
#pragma unroll
            for (int bt = 0; bt < 2; ++bt) {
                float l = lsum[bt]; l += __shfl_xor(l, 16); l += __shfl_xor(l, 32);
                invl[bt] = l > 0.f ? 1.f / l : 0.f;
                const float sc = gates[(tok0 + 8 * w + 4 * bt + (i16 >> 2)) * 48 + head * 3 + c] * invl[bt];
                float* orow = outl + ((8 * w + 4 * bt + (i16 >> 2)) * 4 + (i16 & 3)) * 68 + 4 * g;
#pragma unroll
                for (int dt = 0; dt < 4; ++dt) { f32x4 o = Oacc[bt][dt] * sc; if (c > 0) o += *(const f32x4*)(orow + 16 * dt); *(f32x4*)(orow + 16 * dt) = o; Oacc[bt][dt] = (f32x4){0.f, 0.f, 0.f, 0.f}; }
                lsum[bt] = 0.f;
            }
        };
        {
            const int nblk = min(8, (4 * cur + 2) / 64 + 1);
            unsigned orm[4] = {(1u << nblk) - 1u, 0u, 0u, 0u};
            const float kmx = __int_as_float(misc[MI_KMAXC + bg]);
            mrow[0] = qn[0] * kmx * LOG2E; mrow[1] = qn[1] * kmx * LOG2E;
            attn_branch<0>(p, smem, orm, bg, cur, Qf, mrow, tm, invl, lsum, Oacc);
            finish(0);
            attn_branch<1>(p, smem, orm, bg, cur, Qf, mrow, tm, invl, lsum, Oacc);
        }
        for (int k = 0; k < 8; ++k) {
            const int tl = w * 8 + k;
            float sc0, sc1;
            { const int s = lane; const bool valid = s <= cur, forced = (s == 0) || (s == cur) || (s == cur - 1); sc0 = valid ? imp[tl * 128 + s] + (forced ? 1000.f : 0.f) : -1e30f; }
            { const int s = lane + 64; const bool valid = s <= cur, forced = (s == 0) || (s == cur) || (s == cur - 1); sc1 = valid ? imp[tl * 128 + s] + (forced ? 1000.f : 0.f) : -1e30f; }
            unsigned m0 = 0u, m1 = 0u, m2 = 0u, m3 = 0u;
            for (int rd = 0; rd < 16; ++rd) {
                const float mx = wave_max(fmaxf(sc0, sc1));
                const unsigned long long b0 = __ballot(sc0 == mx);
                int wsel;
                if (b0) { const int wl = __ffsll((long long)b0) - 1; wsel = wl; if (lane == wl) sc0 = -3.0e38f; }
                else { const unsigned long long b1 = __ballot(sc1 == mx); const int wl = __ffsll((long long)b1) - 1; wsel = wl + 64; if (lane == wl) sc1 = -3.0e38f; }
                if (wsel <= cur) { const unsigned bit = 1u << (wsel & 31); const int wd = wsel >> 5; m0 |= wd == 0 ? bit : 0u; m1 |= wd == 1 ? bit : 0u; m2 |= wd == 2 ? bit : 0u; m3 |= wd == 3 ? bit : 0u; }
            }
            if (lane == 0) { tmask[tl * 4] = m0; tmask[tl * 4 + 1] = m1; tmask[tl * 4 + 2] = m2; tmask[tl * 4 + 3] = m3; atomicOr(&tor[0], m0); atomicOr(&tor[1], m1); atomicOr(&tor[2], m2); atomicOr(&tor[3], m3); }
        }
        __syncthreads();
        {
            unsigned orm[4];
#pragma unroll
            for (int k = 0; k < 4; ++k) orm[k] = __builtin_amdgcn_readfirstlane(tor[k]);
#pragma unroll
            for (int bt = 0; bt < 2; ++bt)
#pragma unroll
                for (int k = 0; k < 4; ++k) tm[bt][k] = tmask[(8 * w + 4 * bt + (i16 >> 2)) * 4 + k];
            const float kmx = __int_as_float(misc[MI_KMAX + (1 * 2 + b) * 4 + g4]);
            mrow[0] = qn[0] * kmx * LOG2E; mrow[1] = qn[1] * kmx * LOG2E;
            attn_branch<2>(p, smem, orm, bg, cur, Qf, mrow, tm, invl, lsum, Oacc);
            finish(1);
        }
        {
            unsigned orm[4] = {0u, 0u, 0u, 0u};
            for (int jj = max(0, cur - 8); jj <= cur; ++jj) orm[jj >> 5] |= 1u << (jj & 31);
            const float kmx = __int_as_float(misc[MI_KMAX + (2 * 2 + b) * 4 + g4]);
            mrow[0] = qn[0] * kmx * LOG2E; mrow[1] = qn[1] * kmx * LOG2E;
            attn_branch<3>(p, smem, orm, bg, cur, Qf, mrow, tm, invl, lsum, Oacc);
            finish(2);
        }
#pragma unroll
        for (int bt = 0; bt < 2; ++bt) {
            bf16_t* dst = ao + (tok0 + 8 * w + 4 * bt + (i16 >> 2)) * 1024 + head * 64 + 4 * g;
            const float* orow = outl + ((8 * w + 4 * bt + (i16 >> 2)) * 4 + (i16 & 3)) * 68 + 4 * g;
#pragma unroll
            for (int dt = 0; dt < 4; ++dt) { const f32x4 o = *(const f32x4*)(orow + 16 * dt); *(u32x2*)(dst + 16 * dt) = (u32x2){pack2(o[0], o[1]), pack2(o[2], o[3])}; }
        }
    }
}

struct EpiGeluBias { bf16_t* C; int ldc; const float* bias;
    __device__ __forceinline__ void operator()(int m, int n, f32x4 v) const {
        float y[4];
#pragma unroll
        for (int i = 0; i < 4; ++i) { const float x = v[i] + bias[n + i]; const float u2 = 1.5957691216057308f * (x + 0.044715f * x * x * x); y[i] = x / (1.f + __expf(-u2)); }
        *(u32x2*)(C + (size_t)m * ldc + n) = (u32x2){pack2(y[0], y[1]), pack2(y[2], y[3])}; } };
__device__ __forceinline__ void ph_cmp_gemm(const Params& p, unsigned char* smem) {
    const bf16_t* kvq = (const bf16_t*)(p.ws + KVQ); const float* pew = (const float*)(p.ws + MISC) + MI_PEW;
    for (int t = blockIdx.x; t < 64; t += gridDim.x) {
        const int nt = t & 1, mt = (t >> 1) & 1, bg = (t >> 2) & 7, kv = t >> 5, b = bg >> 2, g = bg & 3;
        const bf16_t* A = kvq + ((size_t)b * S_ + 16 * (mt * 256)) * KVQ_LD + kv * 256 + g * 64;
        const bf16_t* Bt = (const bf16_t*)(p.ws + WT_CW1) + (size_t)(kv * 256 + nt * 128) * 2048;
        bf16_t* C = (bf16_t*)(p.ws + HC) + (size_t)((kv * 8 + bg) * 512 + mt * 256) * 256 + nt * 128;
        gemm_tile(A, 16 * KVQ_LD, Bt, 2048, 2048, EpiGeluBias{C, 256, pew + kv * 256 + nt * 128}, smem, KVQ_LD);
    }
}

#define XB_TMO      128
#define XB_XCNT(j)  (256  + 64 * (j))
#define XB_XSUB(j)  (1280 + 64 * (j))
#define XB_XGEN(j)  (2304 + 64 * (j))
#define XB_TOP      3328
#define XB_TOPGEN   3392
#define XCD_BAR_WORDS 3456
#define XB_SPIN_CAP (1u << 20)
#define LAS __attribute__((address_space(3)))
__device__ __forceinline__ unsigned xb_ld(unsigned* p) { return __hip_atomic_load(p, __ATOMIC_RELAXED, __HIP_MEMORY_SCOPE_AGENT); }
__device__ __forceinline__ unsigned xb_add(unsigned* p, unsigned v) { return __hip_atomic_fetch_add(p, v, __ATOMIC_RELAXED, __HIP_MEMORY_SCOPE_AGENT); }
__device__ __forceinline__ unsigned xb_xcc_id() { return (unsigned)__builtin_amdgcn_s_getreg((3 << 11) | 20) & 0xFu; }
#define XB_SPIN(cond, bar) do { unsigned _sp = 0; while (cond) { __builtin_amdgcn_s_sleep(1); \
    if ((++_sp & 255u) == 0u) { if (xb_ld(&(bar)[XB_TMO])) break; if (_sp > XB_SPIN_CAP) { atomicAdd(&(bar)[XB_TMO], 1u); break; } } } } while (0)
struct XcdBarrier { unsigned* bar; unsigned x; volatile LAS unsigned* st; };
__device__ __forceinline__ XcdBarrier xcd_barrier_post(unsigned* bar, volatile LAS unsigned* st) {
    XcdBarrier b; b.bar = bar; b.x = xb_xcc_id(); b.st = st;
    if (threadIdx.x == 0) (void)xb_add(&bar[XB_XCNT(b.x)], 1u);
    return b;
}
__device__ __forceinline__ void xcd_barrier_complete(unsigned* bar, unsigned x, unsigned& nloc, unsigned& nx) {
    const unsigned G = gridDim.x * gridDim.y * gridDim.z;
    unsigned sum, cnt, mine, sp = 0u;
    for (;;) {
        sum = 0u; cnt = 0u; mine = 0u;
#pragma unroll
        for (unsigned j = 0; j < 16; ++j) { const unsigned c = xb_ld(&bar[XB_XCNT(j)]); sum += c; cnt += (c > 0u) ? 1u : 0u; mine = (j == x) ? c : mine; }
        if (sum == G) break;
        __builtin_amdgcn_s_sleep(1);
        if ((++sp & 255u) == 0u) { if (xb_ld(&bar[XB_TMO])) break; if (sp > XB_SPIN_CAP) { atomicAdd(&bar[XB_TMO], 1u); break; } }
    }
    nloc = mine > 0u ? mine : 1u; nx = cnt > 0u ? cnt : 1u;
}
__device__ __forceinline__ void xcd_barrier(const XcdBarrier& b) {
    asm volatile("s_waitcnt vmcnt(0)" ::: "memory");
    __syncthreads();
    if (threadIdx.x == 0) {
        unsigned* bar = b.bar;
        __builtin_amdgcn_s_waitcnt(0);
        unsigned nloc = b.st[0], nx = b.st[1];
        if (nloc == 0u) { xcd_barrier_complete(bar, b.x, nloc, nx); b.st[0] = nloc; b.st[1] = nx; }
        const unsigned old = xb_add(&bar[XB_XSUB(b.x)], 1u);
        const unsigned gen = old / nloc;
        if (old + 1u == (gen + 1u) * nloc) {
            __builtin_amdgcn_fence(__ATOMIC_RELEASE, "agent");
            asm volatile("s_waitcnt vmcnt(0)" ::: "memory");
            const unsigned og = xb_add(&bar[XB_TOP], 1u);
            const unsigned tg = og / nx;
            if (og + 1u == (tg + 1u) * nx) xb_add(&bar[XB_TOPGEN], 1u);
            else XB_SPIN(xb_ld(&bar[XB_TOPGEN]) == tg, bar);
            __builtin_amdgcn_fence(__ATOMIC_ACQUIRE, "agent");
            xb_add(&bar[XB_XGEN(b.x)], 1u);
            asm volatile("s_waitcnt vmcnt(0)" ::: "memory");
        } else {
            XB_SPIN(xb_ld(&bar[XB_XGEN(b.x)]) == gen, bar);
            __builtin_amdgcn_fence(__ATOMIC_ACQUIRE, "agent");
            asm volatile("s_waitcnt vmcnt(0)" ::: "memory");
        }
    }
    __syncthreads();
}
__global__ void __launch_bounds__(NT) fwd_kernel(Params p) {
    cg::grid_group grid = cg::this_grid();
    extern __shared__ __attribute__((aligned(16))) unsigned char smem[];
    float* hf = (float*)(p.ws + H_F32); bf16_t* hb = (bf16_t*)(p.ws + H_BF);
    volatile LAS unsigned* xst = (volatile LAS unsigned*)(smem + LDS_BYTES - 16);
    if (threadIdx.x == 0) { xst[0] = 0u; xst[1] = 0u; }
    __syncthreads();
    const XcdBarrier xb = xcd_barrier_post((unsigned*)(p.ws + BAR_OFF), xst);
    RUN(0, (ph_prep0(p, smem), ph_moe_weights(p, 0, smem)));
    grid.sync();
    RUN(1, ph_gemm_retin(p, smem));
    xcd_barrier(xb);
    ph_rope_ret(p);
    xcd_barrier(xb);
    RUN(2, ph_ret_state(p, smem));
    xcd_barrier(xb);
    RUN(3, ph_ret_scan(p, smem));
    xcd_barrier(xb);
    ph_gnorm_gate(p);
    xcd_barrier(xb);
    RUN(4, ph_gemm_f32((const bf16_t*)p.out, (const bf16_t*)(p.ws + WT_OUT), hf, 64, 8, 2048, 1024, smem));
    xcd_barrier(xb);
    ph_ln<false, true, false>(p, p.x, hf, hf, hb, p.ln_mix_g, p.ln_mix_b, 0);
    xcd_barrier(xb);
    ph_moe_scatter(p, 0);
    xcd_barrier(xb);
    RUN(5, ph_moe_gemm<0>(p, 0, smem));
    xcd_barrier(xb);
    RUN(6, ph_moe_gemm<1>(p, 0, smem));
    xcd_barrier(xb);
    ph_ln<true, false, false>(p, hf, nullptr, hf, hb, p.ln_ffn_g, p.ln_ffn_b, 0);
    RUN(7, (ph_moe_weights(p, 1, smem), ph_prep1(p, smem)));
    xcd_barrier(xb);
    RUN(8, ph_gemm_bf16(hb, (const bf16_t*)(p.ws + WT_KVQ), (bf16_t*)(p.ws + KVQ), 64, KVQ_LD / 128, 1024, KVQ_LD, smem));
    xcd_barrier(xb);
    ph_rope_nsa(p); RUN(9, ph_vt(p));
    xcd_barrier(xb);
    RUN(10, ph_cmp_gemm(p, smem));
    xcd_barrier(xb);
    RUN(11, ph_cmp2(p));
    xcd_barrier(xb);
    RUN(12, ph_attn(p, smem));
    xcd_barrier(xb);
    RUN(13, ph_gemm_f32((const bf16_t*)(p.ws + ATTN_OUT), (const bf16_t*)(p.ws + WT_NSAOUT), (float*)(p.ws + MIX2), 64, 8, 1024, 1024, smem));
    xcd_barrier(xb);
    ph_ln<false, true, false>(p, hf, (const float*)(p.ws + MIX2), hf, hb, p.ln_mix_g + 1024, p.ln_mix_b + 1024, 1);
    xcd_barrier(xb);
    ph_moe_scatter(p, 1);
    xcd_barrier(xb);
    RUN(14, ph_moe_gemm<0>(p, 1, smem));
    xcd_barrier(xb);
    RUN(15, ph_moe_gemm<1>(p, 1, smem));
    xcd_barrier(xb);
    ph_ln<true, false, true>(p, hf, nullptr, p.out, nullptr, p.ln_ffn_g + 1024, p.ln_ffn_b + 1024, 1);
}

extern "C" void kernel_launch(void* const* d_in, const int* in_sizes, int n_in, void* d_out, int out_size, void* d_ws, size_t ws_size, hipStream_t stream) {
    (void)in_sizes; (void)n_in; (void)out_size;
    if (ws_size < WS_NEEDED) { fprintf(stderr, "workspace too small: %zu < %zu\n", ws_size, (size_t)WS_NEEDED); return; }
    static int grid_blocks = 0;
    if (!grid_blocks) {
        int dev = 0, cus = 0, per_cu = 0;
        (void)hipGetDevice(&dev);
        (void)hipDeviceGetAttribute(&cus, hipDeviceAttributeMultiprocessorCount, dev);
        (void)hipFuncSetAttribute((const void*)fwd_kernel, hipFuncAttributeMaxDynamicSharedMemorySize, LDS_BYTES);
        (void)hipOccupancyMaxActiveBlocksPerMultiprocessor(&per_cu, fwd_kernel, NT, LDS_BYTES);
        if (per_cu > 1) per_cu = 1;
        grid_blocks = cus * per_cu;
    }
    Params p{};
    const float** pp = (const float**)&p;
    for (int i = 0; i < 21; ++i) pp[i] = (const float*)d_in[i];
    p.out = (float*)d_out; p.ws = (unsigned char*)d_ws;
    (void)hipMemsetAsync((unsigned char*)d_ws + BAR_OFF, 0, 3456 * 4, stream);
    void* args[] = {&p};
    hipError_t e = hipLaunchCooperativeKernel((void*)fwd_kernel, dim3(grid_blocks), dim3(NT), args, LDS_BYTES, stream);
    if (e != hipSuccess) fprintf(stderr, "cooperative launch failed: %s (grid %d)\n", hipGetErrorString(e), grid_blocks);
}
```

```cpp
#include <hip/hip_runtime.h>
#include <hip/hip_cooperative_groups.h>
#include <cstdio>
#include <cstdint>
namespace cg = cooperative_groups;

typedef unsigned short bf16_t;
typedef short bf16x8 __attribute__((ext_vector_type(8)));
typedef float f32x4 __attribute__((ext_vector_type(4)));
typedef unsigned u32x4 __attribute__((ext_vector_type(4)));
typedef unsigned u32x2 __attribute__((ext_vector_type(2)));

#define NT 512
#ifndef PROBEMASK
#define PROBEMASK 0u
#endif
#define PROBE_W 3ull
#define PROBE_ON(id) ((PROBEMASK >> (id)) & 1u)
#define PHASE(id, ...) do { const unsigned long long _t0 = PROBE_ON(id) ? __builtin_amdgcn_s_memrealtime() : 0ull; __VA_ARGS__; xcd_barrier(xb); \
    if (PROBE_ON(id)) { const unsigned long long _t1 = __builtin_amdgcn_s_memrealtime(), _end = _t1 + PROBE_W * (_t1 - _t0); while (__builtin_amdgcn_s_memrealtime() < _end) __builtin_amdgcn_s_sleep(8); } } while (0)
constexpr int LDS_BYTES = 144 * 1024;
constexpr int T_ = 16384, D_ = 1024, S_ = 8192;
constexpr size_t MiB = 1u << 20;
constexpr size_t XB = 0, WT_IN = 32 * MiB, QB = 44 * MiB, KB = 76 * MiB, VB = 108 * MiB, GB = 172 * MiB;
constexpr size_t WT_OUT = 246 * MiB, MOEW_GU = 250 * MiB, MOEW_D = 282 * MiB;
constexpr size_t H_F32 = 0, H_BF = 64 * MiB, YEXP = 96 * MiB, XS = 172 * MiB, MISC = 244 * MiB;
constexpr size_t WT_KVQ = 236 * MiB, WT_NSAOUT = 242 * MiB;
constexpr size_t KVQ = 96 * MiB, GATES = 180 * MiB, HC = 183 * MiB, KCMPB = 187 * MiB, VCMPT = 187 * MiB + 512 * 1024, VST = 188 * MiB, VWT = 196 * MiB, ATTN_OUT = 204 * MiB, WT_CW1 = 246 * MiB, WT_CW2 = 248 * MiB;
constexpr size_t MIX2 = 96 * MiB;
constexpr size_t MOEW1_GU = 0, MOEW1_D = 32 * MiB;
constexpr size_t RET_L = 0;
constexpr size_t WS_NEEDED = 298 * MiB;
constexpr size_t MOE_INV = 168 * MiB;
constexpr size_t ROPE_RT = 236 * MiB, ROPE_NT = 232 * MiB;
constexpr int KVQ_LD = 2688, KVQ_N = 2816;
constexpr size_t BAR_OFF = 245 * MiB;
constexpr size_t CNT_OFF = BAR_OFF + 16384;
constexpr int CTL_ZERO_BYTES = 16384 + 32 * 256;
constexpr int MI_KMAX = 64, MI_KMAXC = 120, MI_PEW = 512;
constexpr int MI_CNT = 0, MI_TE = 1024, MI_TW = MI_TE + 32768, MI_TI = MI_TW + 32768, MI_TR = MI_TI + 32768;

struct Params {
    const float *x, *ret_w_in, *ret_w_out, *nsa_w_kv, *pe_k, *pe_v, *ck_w1, *ck_w2, *cv_w1, *cv_w2, *nsa_w_in, *nsa_w_out,
        *router_w, *router_b, *moe_wg, *moe_wu, *moe_wd, *ln_mix_g, *ln_mix_b, *ln_ffn_g, *ln_ffn_b;
    float* out; unsigned char* ws;
};

__device__ __forceinline__ bf16_t f2bf(float f) { unsigned u = __float_as_uint(f); u += 0x7fffu + ((u >> 16) & 1u); return (bf16_t)(u >> 16); }
__device__ __forceinline__ float bf2f(bf16_t h) { return __uint_as_float(((unsigned)h) << 16); }
typedef float f32x2 __attribute__((ext_vector_type(2)));
typedef __bf16 bf16x2_t __attribute__((ext_vector_type(2)));
__device__ __forceinline__ unsigned pack2(float a, float b) { const f32x2 v = {a, b}; return __builtin_bit_cast(unsigned, __builtin_convertvector(v, bf16x2_t)); }
__device__ __forceinline__ float lo2f(unsigned u) { return __uint_as_float(u << 16); }
__device__ __forceinline__ float hi2f(unsigned u) { return __uint_as_float(u & 0xffff0000u); }
__device__ __forceinline__ float wave_sum(float v) {
#pragma unroll
    for (int o = 32; o > 0; o >>= 1) v += __shfl_xor(v, o);
    return v;
}
__device__ __forceinline__ float wave_max(float v) {
#pragma unroll
    for (int o = 32; o > 0; o >>= 1) v = fmaxf(v, __shfl_xor(v, o));
    return v;
}
__device__ __forceinline__ int ptid() { int t = threadIdx.x; asm volatile("" : "+v"(t)); return t; }
__device__ __forceinline__ int gtid() { return blockIdx.x * NT + ptid(); }
__device__ __forceinline__ int gthreads() { return gridDim.x * NT; }
__device__ __forceinline__ int gwave() { return (ptid() >> 6) * gridDim.x + blockIdx.x; }
__device__ __forceinline__ int gwaves() { return gridDim.x * (NT / 64); }
__device__ __forceinline__ void unpack8(u32x4 u, float* f) {
    f[0] = lo2f(u.x); f[1] = hi2f(u.x); f[2] = lo2f(u.y); f[3] = hi2f(u.y); f[4] = lo2f(u.z); f[5] = hi2f(u.z); f[6] = lo2f(u.w); f[7] = hi2f(u.w);
}

template <class F> __device__ __forceinline__ void transpose_conv_tiles(F src, bf16_t* dst, int K, float* tile, int tb, int te, int rank, int nranks) {
    const int tilesK = K >> 6, tix = ptid();
    for (int t = tb + rank; t < te; t += nranks) {
        const int n0 = (t / tilesK) << 6, k0 = (t % tilesK) << 6;
#pragma unroll
        for (int i = 0; i < 8; ++i) { const int idx = tix + i * NT, kk = idx >> 6, r = idx & 63; tile[kk * 65 + r] = src(k0 + kk, n0 + r); }
        __syncthreads();
        {   const int r = tix >> 3, kk0 = (tix & 7) * 8; float f[8];
#pragma unroll
            for (int j = 0; j < 8; ++j) f[j] = tile[(kk0 + j) * 65 + r];
            *(u32x4*)(dst + (size_t)(n0 + r) * K + k0 + kk0) = (u32x4){pack2(f[0], f[1]), pack2(f[2], f[3]), pack2(f[4], f[5]), pack2(f[6], f[7])}; }
        __syncthreads();
    }
}
template <class F> __device__ __forceinline__ void transpose_conv(F src, bf16_t* dst, int K, int N, float* tile) { transpose_conv_tiles(src, dst, K, tile, 0, (N >> 6) * (K >> 6), (int)blockIdx.x, (int)gridDim.x); }

template <class Epi> __device__ __forceinline__ void gemm_tile_rows(const bf16_t* const (&ap)[4], const bf16_t* __restrict__ Bt, int ldb, int K, Epi epi, unsigned char* smem, int akstride = 64) {
    const int tid = ptid(), lane = tid & 63, wid = tid >> 6, wm = wid >> 1, wn = wid & 1, fr = lane & 15, fq = lane >> 4;
    bf16_t* As = (bf16_t*)smem;
    bf16_t* Bs = As + 256 * 72;
    f32x4 acc[4][4];
#pragma unroll
    for (int i = 0; i < 4; ++i)
#pragma unroll
        for (int j = 0; j < 4; ++j) acc[i][j] = (f32x4){0.f, 0.f, 0.f, 0.f};
    u32x4 ra[4], rb[2];
    const int lrow = tid >> 3, lkc = tid & 7;
    const bf16_t* bg = Bt + (size_t)lrow * ldb + lkc * 8;
#pragma unroll
    for (int i = 0; i < 4; ++i) ra[i] = *(const u32x4*)(ap[i]);
#pragma unroll
    for (int i = 0; i < 2; ++i) rb[i] = *(const u32x4*)(bg + (size_t)i * 64 * ldb);
    const int nk = K >> 6;
    for (int kt = 0; kt < nk; ++kt) {
#pragma unroll
        for (int i = 0; i < 4; ++i) *(u32x4*)(As + (lrow + i * 64) * 72 + lkc * 8) = ra[i];
#pragma unroll
        for (int i = 0; i < 2; ++i) *(u32x4*)(Bs + (lrow + i * 64) * 72 + lkc * 8) = rb[i];
        __syncthreads();
        if (kt + 1 < nk) {
            const int k0 = (kt + 1) << 6; const size_t ka = (size_t)(kt + 1) * akstride;
#pragma unroll
            for (int i = 0; i < 4; ++i) ra[i] = *(const u32x4*)(ap[i] + ka);
#pragma unroll
            for (int i = 0; i < 2; ++i) rb[i] = *(const u32x4*)(bg + (size_t)i * 64 * ldb + k0);
        }
#pragma unroll
        for (int s = 0; s < 2; ++s) {
            bf16x8 af[4], bfr[4];
#pragma unroll
            for (int i = 0; i < 4; ++i) af[i] = *(const bf16x8*)(As + (wm * 64 + i * 16 + fr) * 72 + s * 32 + fq * 8);
#pragma unroll
            for (int j = 0; j < 4; ++j) bfr[j] = *(const bf16x8*)(Bs + (wn * 64 + j * 16 + fr) * 72 + s * 32 + fq * 8);
#pragma unroll
            for (int i = 0; i < 4; ++i)
#pragma unroll
                for (int j = 0; j < 4; ++j) acc[i][j] = __builtin_amdgcn_mfma_f32_16x16x32_bf16(bfr[j], af[i], acc[i][j], 0, 0, 0);
        }
        __syncthreads();
    }
    epi.start(wm, wn, fr, fq);
#pragma unroll
    for (int i = 0; i < 4; ++i) {
#pragma unroll
        for (int j = 0; j < 4; ++j) epi(wm * 64 + i * 16 + fr, wn * 64 + j * 16 + fq * 4, acc[i][j]);
        epi.row_done(i);
    }
    epi.finish();
}
template <class Epi> __device__ __forceinline__ void gemm_tile(const bf16_t* __restrict__ A, int lda, const bf16_t* __restrict__ Bt, int ldb, int K, const Epi& epi, unsigned char* smem, int akstride = 64) {
    const bf16_t* ap[4]; const int tix = ptid();
#pragma unroll
    for (int i = 0; i < 4; ++i) ap[i] = A + (size_t)((tix >> 3) + 64 * i) * lda + (tix & 7) * 8;
    gemm_tile_rows(ap, Bt, ldb, K, epi, smem, akstride);
}

struct EpiBase { __device__ __forceinline__ void start(int, int, int, int) {} __device__ __forceinline__ void row_done(int) {} __device__ __forceinline__ void finish() {} };
struct EpiBf16 : EpiBase { bf16_t* C; int ldc;
    __device__ __forceinline__ void operator()(int m, int n, f32x4 v) const { *(uint2*)(C + (size_t)m * ldc + n) = make_uint2(pack2(v[0], v[1]), pack2(v[2], v[3])); } };
struct EpiF32 : EpiBase { float* C; int ldc;
    __device__ __forceinline__ void operator()(int m, int n, f32x4 v) const { *(float4*)(C + (size_t)m * ldc + n) = make_float4(v[0], v[1], v[2], v[3]); } };
struct EpiSwiglu : EpiBase { bf16_t* C; int ldc;
    __device__ __forceinline__ void operator()(int m, int n, f32x4 v) const {
        const float a0 = v[0] / (1.f + __expf(-v[0])) * v[1], a1 = v[2] / (1.f + __expf(-v[2])) * v[3];
        *(unsigned*)(C + (size_t)m * ldc + (n >> 1)) = pack2(a0, a1); } };

namespace pg8 {
#define PG8_LAS __attribute__((address_space(3)))
typedef unsigned short bf16_t;
typedef short bf16x8 __attribute__((ext_vector_type(8)));
typedef float f32x4 __attribute__((ext_vector_type(4)));
typedef unsigned u32x4 __attribute__((ext_vector_type(4)));
constexpr int BM = 256, BK = 64, HALF = 128, HTB = HALF * BK * 2  , STAGE_BYTES = 8 * HTB, NXCD = 8, WGM = 8;

__host__ __device__ __forceinline__ int lds_byte(int r, int c) { const int st = (r >> 4) * 2 + (c >> 5), rr = r & 15, cc = c & 31, ob = rr * 64 + cc * 2; return st * 1024 + (ob ^ (((ob >> 9) & 1) << 5)); }
__host__ __device__ __forceinline__ void stage_rc(int b, int& R, int& C) { const int st = b / 1024, sb = b % 1024, swz = sb ^ (((sb >> 9) & 1) << 5); R = (st >> 1) * 16 + swz / 64; C = (st & 1) * 32 + (swz % 64) / 2; }
__host__ __device__ __forceinline__ int perm32(int rho) { const int n = rho >> 4, i = rho & 15; return 8 * (i >> 2) + 4 * n + (i & 3); }

struct Unit { int pm, pn; };
struct Gemm { const bf16_t* A; const bf16_t* Bt; int M, N, K; };

struct StaticOrder {
    int nM, nN, nwg, G, c;
    __host__ __device__ void init(int M, int N, int G_, int c_) { nM = M / BM; nN = N / BM; nwg = nM * nN; G = G_; c = c_; }
    __host__ __device__ bool next(int i, Unit& u) const {
        const long L = (long)i * G + c; if (L >= nwg) return false;
        int wgid = (int)L; { const int q = nwg / NXCD, r = nwg % NXCD, xcd = wgid % NXCD, off = wgid / NXCD; wgid = (xcd < r ? xcd * (q + 1) : r * (q + 1) + (xcd - r) * q) + off; }
        const int nig = WGM * nN, gid = wgid / nig, fm = gid * WGM, gsz = (nM - fm) < WGM ? (nM - fm) : WGM;
        u.pm = fm + ((wgid % nig) % gsz); u.pn = (wgid % nig) / gsz; return true;
    }
    __device__ __forceinline__ void a_ready(const Unit&) const {}
    __device__ __forceinline__ void done(const Unit&) const {}
};


template <class Epi, class Sched, bool ALIGN_EPI = false, bool SP2 = false, bool GATHER = false>
__device__ __forceinline__ void gemm_phase(PG8_LAS unsigned char* lds, const Gemm g, const Sched& S, const Epi& E) {
    const int tid = ptid(), wid = __builtin_amdgcn_readfirstlane(tid >> 6), lane = tid & 63, wr = wid >> 2, wc = wid & 3, fr = lane & 15, fq = lane >> 4;
    const int K = g.K, nt = K / BK;
    unsigned voffA[2], voffB[2];
#pragma unroll
    for (int i = 0; i < 2; ++i) { int R, C; stage_rc(tid * 16 + i * 8192, R, C); const int Rb = Epi::PERM ? ((R & ~31) + perm32(R & 31)) : R;
        voffA[i] = (unsigned)(R * K + C) * 2u; voffB[i] = (unsigned)(Rb * K + C) * 2u; }
    const size_t kstep = (size_t)(BK * 2);
    const size_t hstep = (size_t)HALF * K * 2;
    const size_t tstep = 2 * hstep;
    const size_t hstepA = GATHER ? 0 : hstep, tstepA = GATHER ? 0 : tstep;
    int gR[2], gC[2];
#pragma unroll
    for (int i = 0; i < 2; ++i) stage_rc(tid * 16 + i * 8192, gR[i], gC[i]);
    unsigned vgc[2][2], vgn[2][2], vgs[2][2];
    auto gath = [&](const Unit& u, unsigned (&v)[2][2]) {
        if constexpr (GATHER) {
#pragma unroll
            for (int h = 0; h < 2; ++h)
#pragma unroll
                for (int i = 0; i < 2; ++i) v[h][i] = (unsigned)(S.rowidx(u, 128 * h + gR[i]) * K + gC[i]) * 2u;
        }
    };
    const unsigned ldsw = (unsigned)wid * 1024u;
    const int aoff = lds_byte(wr * 64 + fr, fq * 8), boff = lds_byte(wc * 32 + fr, fq * 8);
#define PG8_SA(b, h) (((b) * 2 + (h)) * HTB)
#define PG8_SB(b, h) ((4 + (b) * 2 + (h)) * HTB)
#define PG8_STAGE(bufoff, gbase, voff) do { _Pragma("unroll") for (int _i = 0; _i < 2; ++_i) \
        __builtin_amdgcn_global_load_lds((const unsigned*)((const char*)(gbase) + (voff)[_i]), (PG8_LAS unsigned*)(lds + (bufoff) + ldsw + _i * 8192), 16, 0, 0); } while (0)
#define PG8_STAGE_A(bufoff, gbase, VG, h) do { if constexpr (GATHER) PG8_STAGE(bufoff, gbase, (VG)[h]); else PG8_STAGE(bufoff, gbase, voffA); } while (0)
#define PG8_LDA(dst, b, h) do { _Pragma("unroll") for (int m = 0; m < 4; ++m) _Pragma("unroll") for (int k = 0; k < 2; ++k) dst[m][k] = *(const PG8_LAS bf16x8*)(lds + PG8_SA(b, h) + aoff + m * 2048 + k * 1024); } while (0)
#define PG8_LDB(dst, b, h) do { _Pragma("unroll") for (int n = 0; n < 2; ++n) _Pragma("unroll") for (int k = 0; k < 2; ++k) dst[n][k] = *(const PG8_LAS bf16x8*)(lds + PG8_SB(b, h) + boff + n * 2048 + k * 1024); } while (0)
#define PG8_MMA(ai, bj, At, Bt) do { __builtin_amdgcn_s_setprio(1); _Pragma("unroll") for (int m = 0; m < 4; ++m) _Pragma("unroll") for (int n = 0; n < 2; ++n) _Pragma("unroll") for (int k = 0; k < 2; ++k) \
        acc[ai][bj][m][n] = __builtin_amdgcn_mfma_f32_16x16x32_bf16(Bt[n][k], At[m][k], acc[ai][bj][m][n], 0, 0, 0); __builtin_amdgcn_s_setprio(0); } while (0)
#define PG8_WAIT_V(n) asm volatile("s_waitcnt vmcnt(" #n ")" ::: "memory")
#define PG8_WAIT_L(n) asm volatile("s_waitcnt lgkmcnt(" #n ")" ::: "memory")
#define PG8_BAR __builtin_amdgcn_s_barrier()
#define PG8_SCHED __builtin_amdgcn_sched_barrier(0)
    Unit cur, nxt; int ui = 0;
    if (!S.next(0, cur)) return;
    f32x4 acc[2][2][4][2];
#pragma unroll
    for (int a = 0; a < 2; ++a)
#pragma unroll
        for (int b = 0; b < 2; ++b)
#pragma unroll
            for (int m = 0; m < 4; ++m)
#pragma unroll
                for (int n = 0; n < 2; ++n) acc[a][b][m][n] = (f32x4){0.f, 0.f, 0.f, 0.f};
    bf16x8 At[4][2], B0[2][2], B1[2][2];
    const char* cA = (const char*)g.A + (size_t)cur.pm * tstepA; gath(cur, vgc); const char* cB = (const char*)g.Bt + (size_t)cur.pn * tstep;
    S.a_ready(cur);
    if constexpr (SP2) {
        PG8_STAGE(PG8_SB(0, 0), cB, voffB); PG8_STAGE(PG8_SB(0, 1), cB + hstep, voffB); PG8_STAGE_A(PG8_SA(0, 0), cA, vgc, 0); PG8_STAGE_A(PG8_SA(0, 1), cA + hstepA, vgc, 1);
        if (wr == 1) PG8_BAR;
        PG8_WAIT_V(2); PG8_BAR;
        PG8_STAGE(PG8_SB(1, 0), cB + kstep, voffB); PG8_STAGE_A(PG8_SA(1, 0), cA + kstep, vgc, 0); PG8_STAGE(PG8_SB(1, 1), cB + hstep + kstep, voffB);
        PG8_WAIT_V(6); PG8_BAR;
    } else {
        PG8_STAGE(PG8_SB(0, 0), cB, voffB); PG8_STAGE_A(PG8_SA(0, 0), cA, vgc, 0); PG8_STAGE(PG8_SB(0, 1), cB + hstep, voffB); PG8_STAGE_A(PG8_SA(0, 1), cA + hstepA, vgc, 1);
        if (wr == 1) PG8_BAR;
        PG8_WAIT_V(4); PG8_BAR;
        PG8_STAGE(PG8_SB(1, 0), cB + kstep, voffB); PG8_STAGE_A(PG8_SA(1, 0), cA + kstep, vgc, 0); PG8_STAGE(PG8_SB(1, 1), cB + hstep + kstep, voffB);
        PG8_WAIT_V(6); PG8_BAR;
    }
    for (;;) {
        const bool has_next = S.next(ui + 1, nxt);
        const char* nA = has_next ? (const char*)g.A + (size_t)nxt.pm * tstepA : cA;
        if constexpr (GATHER) { if (has_next) gath(nxt, vgn); else {
#pragma unroll
            for (int h = 0; h < 2; ++h) { vgn[h][0] = vgc[h][0]; vgn[h][1] = vgc[h][1]; } } } const char* nB = has_next ? (const char*)g.Bt + (size_t)nxt.pn * tstep : cB;
        for (int t = 0; t < nt; t += 2) {
            const bool last = (t == nt - 2);
            const char* a1 = cA + (size_t)(t + 1) * kstep;
            const char* a2 = last ? nA : cA + (size_t)(t + 2) * kstep; const char* b2 = last ? nB : cB + (size_t)(t + 2) * kstep;
            const char* a3 = a2 + kstep; const char* b3 = b2 + kstep;
            if (last && has_next) S.a_ready(nxt);
            if constexpr (GATHER) {
#pragma unroll
                for (int h = 0; h < 2; ++h) { vgs[h][0] = last ? vgn[h][0] : vgc[h][0]; vgs[h][1] = last ? vgn[h][1] : vgc[h][1]; } }
            if constexpr (SP2) {
            PG8_LDB(B0, 0, 0); PG8_LDB(B1, 0, 1); PG8_SCHED; PG8_LDA(At, 0, 0); PG8_STAGE_A(PG8_SA(1, 1), a1 + hstepA, vgc, 1);
            PG8_WAIT_V(8); PG8_WAIT_L(0); PG8_BAR; PG8_MMA(0, 0, At, B0); PG8_MMA(0, 1, At, B1); PG8_BAR; PG8_SCHED;
            PG8_LDA(At, 0, 1); PG8_STAGE(PG8_SB(0, 0), b2, voffB); PG8_STAGE(PG8_SB(0, 1), b2 + hstep, voffB); PG8_STAGE_A(PG8_SA(0, 0), a2, vgs, 0);
            PG8_WAIT_V(8); PG8_WAIT_L(0); PG8_BAR; PG8_MMA(1, 0, At, B0); PG8_MMA(1, 1, At, B1); PG8_BAR; PG8_SCHED;
            PG8_LDB(B0, 1, 0); PG8_LDB(B1, 1, 1); PG8_SCHED; PG8_LDA(At, 1, 0); PG8_STAGE_A(PG8_SA(0, 1), a2 + hstepA, vgs, 1);
            PG8_WAIT_V(8); PG8_WAIT_L(0); PG8_BAR; PG8_MMA(0, 0, At, B0); PG8_MMA(0, 1, At, B1); PG8_BAR; PG8_SCHED;
            PG8_LDA(At, 1, 1); PG8_STAGE(PG8_SB(1, 0), b3, voffB); PG8_STAGE(PG8_SB(1, 1), b3 + hstep, voffB); PG8_STAGE_A(PG8_SA(1, 0), a3, vgs, 0);
            PG8_WAIT_V(8); PG8_WAIT_L(0); PG8_BAR; PG8_MMA(1, 0, At, B0); PG8_MMA(1, 1, At, B1); PG8_BAR; PG8_SCHED;
            } else {
            PG8_LDB(B0, 0, 0); PG8_SCHED; PG8_LDA(At, 0, 0); PG8_STAGE_A(PG8_SA(1, 1), a1 + hstepA, vgc, 1);
            PG8_WAIT_L(8); PG8_BAR; PG8_WAIT_L(0); PG8_MMA(0, 0, At, B0); PG8_BAR; PG8_SCHED;
            PG8_LDB(B1, 0, 1); PG8_STAGE(PG8_SB(0, 0), b2, voffB);
            PG8_BAR; PG8_WAIT_L(0); PG8_MMA(0, 1, At, B1); PG8_BAR;
            PG8_LDA(At, 0, 1); PG8_STAGE_A(PG8_SA(0, 0), a2, vgs, 0);
            PG8_BAR; PG8_WAIT_L(0); PG8_MMA(1, 0, At, B0); PG8_BAR; PG8_SCHED;
            PG8_STAGE(PG8_SB(0, 1), b2 + hstep, voffB);
            PG8_WAIT_V(6); PG8_BAR; PG8_MMA(1, 1, At, B1); PG8_BAR;
            PG8_LDB(B0, 1, 0); PG8_SCHED; PG8_LDA(At, 1, 0); PG8_STAGE_A(PG8_SA(0, 1), a2 + hstepA, vgs, 1);
            PG8_WAIT_L(8); PG8_BAR; PG8_WAIT_L(0); PG8_MMA(0, 0, At, B0); PG8_BAR; PG8_SCHED;
            PG8_LDB(B1, 1, 1); PG8_STAGE(PG8_SB(1, 0), b3, voffB);
            PG8_BAR; PG8_WAIT_L(0); PG8_MMA(0, 1, At, B1); PG8_BAR;
            PG8_LDA(At, 1, 1); PG8_STAGE_A(PG8_SA(1, 0), a3, vgs, 0);
            PG8_BAR; PG8_WAIT_L(0); PG8_MMA(1, 0, At, B0); PG8_BAR; PG8_SCHED;
            PG8_STAGE(PG8_SB(1, 1), b3 + hstep, voffB);
            PG8_WAIT_V(6); PG8_BAR; PG8_MMA(1, 1, At, B1); PG8_BAR;
            }
        }
        if constexpr (ALIGN_EPI) { if (wr == 0) PG8_BAR; }
        if constexpr (!Epi::AFTER_DRAIN) { E(acc, cur, wr, wc, fr, fq); S.done(cur); }
        if (!has_next) break;
#pragma unroll
        for (int a = 0; a < 2; ++a)
#pragma unroll
            for (int b = 0; b < 2; ++b)
#pragma unroll
                for (int m = 0; m < 4; ++m)
#pragma unroll
                    for (int n = 0; n < 2; ++n) acc[a][b][m][n] = (f32x4){0.f, 0.f, 0.f, 0.f};
        cur = nxt; cA = nA; cB = nB; ++ui;
        if constexpr (GATHER) {
#pragma unroll
            for (int h = 0; h < 2; ++h) { vgc[h][0] = vgn[h][0]; vgc[h][1] = vgn[h][1]; } }
        if constexpr (ALIGN_EPI) { if (wr == 1) PG8_BAR; }
    }
    PG8_WAIT_V(0);
    if constexpr (!ALIGN_EPI) { if (wr == 0) PG8_BAR; }
    PG8_BAR;
    if constexpr (Epi::AFTER_DRAIN) { E.fused(acc, cur, wr, wc, fr, fq, lds, wid, lane); S.done(cur); }
#undef PG8_SA
#undef PG8_SB
#undef PG8_STAGE
#undef PG8_LDA
#undef PG8_LDB
#undef PG8_MMA
#undef PG8_WAIT_V
#undef PG8_WAIT_L
#undef PG8_BAR
#undef PG8_SCHED
#undef PG8_STAGE_A
}
struct EpiF32P { static constexpr bool PERM = false, AFTER_DRAIN = false; float* C; int ldc;
    __device__ __forceinline__ void operator()(const f32x4 (&acc)[2][2][4][2], const Unit& u, int wr, int wc, int fr, int fq) const {
#pragma unroll
        for (int ai = 0; ai < 2; ++ai)
#pragma unroll
            for (int m = 0; m < 4; ++m) { float* rp = C + (size_t)(u.pm * 256 + ai * 128 + wr * 64 + m * 16 + fr) * ldc + u.pn * 256 + wc * 32 + 4 * fq;
#pragma unroll
                for (int bj = 0; bj < 2; ++bj)
#pragma unroll
                    for (int n = 0; n < 2; ++n) *(f32x4*)(rp + bj * 128 + n * 16) = acc[ai][bj][m][n]; } } };
struct EpiBf16P { static constexpr bool PERM = false, AFTER_DRAIN = false; ::bf16_t* C; int ldc; int pnmask;
    __device__ __forceinline__ void operator()(const f32x4 (&acc)[2][2][4][2], const Unit& u, int wr, int wc, int fr, int fq) const {
#pragma unroll
        for (int ai = 0; ai < 2; ++ai)
#pragma unroll
            for (int m = 0; m < 4; ++m) { ::bf16_t* rp = C + (size_t)(u.pm * 256 + ai * 128 + wr * 64 + m * 16 + fr) * ldc + (u.pn & pnmask) * 256 + wc * 32 + 4 * fq;
#pragma unroll
                for (int bj = 0; bj < 2; ++bj)
#pragma unroll
                    for (int n = 0; n < 2; ++n) { const f32x4 v = acc[ai][bj][m][n]; *(::u32x2*)(rp + bj * 128 + n * 16) = (::u32x2){pack2(v[0], v[1]), pack2(v[2], v[3])}; } } } };
struct EpiRetInP { static constexpr bool PERM = false, AFTER_DRAIN = false; const Params* p;
    __device__ __forceinline__ void operator()(const f32x4 (&acc)[2][2][4][2], const Unit& u, int wr, int wc, int fr, int fq) const {
        const int pn = u.pn;
        if (pn < 8) {
            const int head = pn & 3, isk = pn >> 2; const float lg = log2f(1.f - exp2f(-5.f - (float)head));
            ::bf16_t* base = (::bf16_t*)(p->ws + (isk ? KB : QB)) + head * 256;
#pragma unroll
            for (int ai = 0; ai < 2; ++ai)
#pragma unroll
                for (int m = 0; m < 4; ++m) {
                    const int row = u.pm * 256 + ai * 128 + wr * 64 + m * 16 + fr, t = row & (S_ - 1);
                    const float sc = isk ? 0.0625f * exp2f((float)(127 - (t & 127)) * lg) : 1.f;
                    const float* rt = (const float*)(p->ws + ROPE_RT) + (size_t)t * 256;
#pragma unroll
                    for (int bj = 0; bj < 2; ++bj)
#pragma unroll
                        for (int n = 0; n < 2; ++n) {
                            const int c = bj * 128 + wc * 32 + n * 16 + 4 * fq, d = c >> 1; const f32x4 v = acc[ai][bj][m][n]; const f32x4 cs = *(const f32x4*)(rt + d * 2);
                            const float a0 = (v[0] * cs[0] - v[1] * cs[1]) * sc, b0 = (v[1] * cs[0] + v[0] * cs[1]) * sc, a1 = (v[2] * cs[2] - v[3] * cs[3]) * sc, b1 = (v[3] * cs[2] + v[2] * cs[3]) * sc;
                            ::bf16_t* dst = base + (size_t)row * 1024 + d; *(unsigned*)dst = pack2(a0, a1); *(unsigned*)(dst + 128) = pack2(b0, b1);
                        }
                }
        } else {
            ::bf16_t* base = (::bf16_t*)(p->ws + (pn < 16 ? VB : GB)) + ((pn - 8) & 7) * 256 + wc * 32 + 4 * fq;
#pragma unroll
            for (int ai = 0; ai < 2; ++ai)
#pragma unroll
                for (int m = 0; m < 4; ++m) { ::bf16_t* rp = base + (size_t)(u.pm * 256 + ai * 128 + wr * 64 + m * 16 + fr) * 2048;
#pragma unroll
                    for (int bj = 0; bj < 2; ++bj)
#pragma unroll
                        for (int n = 0; n < 2; ++n) { const f32x4 v = acc[ai][bj][m][n]; *(::u32x2*)(rp + bj * 128 + n * 16) = (::u32x2){pack2(v[0], v[1]), pack2(v[2], v[3])}; } }
        }
    }
};
struct EpiKvqP { static constexpr bool PERM = false, AFTER_DRAIN = false; const Params* p;
    __device__ __forceinline__ void operator()(const f32x4 (&acc)[2][2][4][2], const Unit& u, int wr, int wc, int fr, int fq) const {
        const int pn = u.pn; ::bf16_t* kvq = (::bf16_t*)(p->ws + KVQ);
        if (pn == 1 || pn == 3 || pn == 5) {
#pragma unroll
            for (int ai = 0; ai < 2; ++ai)
#pragma unroll
                for (int m = 0; m < 4; ++m) { ::bf16_t* rp = kvq + (size_t)(u.pm * 256 + ai * 128 + wr * 64 + m * 16 + fr) * KVQ_LD + pn * 256 + wc * 32 + 4 * fq;
#pragma unroll
                    for (int bj = 0; bj < 2; ++bj)
#pragma unroll
                        for (int n = 0; n < 2; ++n) { const f32x4 v = acc[ai][bj][m][n]; *(::u32x2*)(rp + bj * 128 + n * 16) = (::u32x2){pack2(v[0], v[1]), pack2(v[2], v[3])}; } }
        } else if (pn < 10) {
            const float sc = pn >= 6 ? 0.125f : 1.f; float mx[2] = {0.f, 0.f};
#pragma unroll
            for (int ai = 0; ai < 2; ++ai)
#pragma unroll
                for (int m = 0; m < 4; ++m) {
                    const int row = u.pm * 256 + ai * 128 + wr * 64 + m * 16 + fr, t = row & (S_ - 1);
                    const float* nt = (const float*)(p->ws + ROPE_NT) + (size_t)t * 64;
#pragma unroll
                    for (int bj = 0; bj < 2; ++bj) {
                        float nrm = 0.f;
#pragma unroll
                        for (int n = 0; n < 2; ++n) {
                            const int c = bj * 128 + wc * 32 + n * 16 + 4 * fq, d = (c & 63) >> 1; const f32x4 v = acc[ai][bj][m][n]; const f32x4 cs = *(const f32x4*)(nt + d * 2);
                            const float a0 = (v[0] * cs[0] - v[1] * cs[1]) * sc, b0 = (v[1] * cs[0] + v[0] * cs[1]) * sc, a1 = (v[2] * cs[2] - v[3] * cs[3]) * sc, b1 = (v[3] * cs[2] + v[2] * cs[3]) * sc;
                            ::bf16_t* dst = kvq + (size_t)row * KVQ_LD + pn * 256 + (c & ~63) + d; *(unsigned*)dst = pack2(a0, a1); *(unsigned*)(dst + 32) = pack2(b0, b1);
                            nrm += a0 * a0 + b0 * b0 + a1 * a1 + b1 * b1;
                        }
                        nrm += __shfl_xor(nrm, 16); nrm += __shfl_xor(nrm, 32);
                        mx[bj] = fmaxf(mx[bj], nrm);
                    }
                }
            if (pn < 6) {
#pragma unroll
                for (int bj = 0; bj < 2; ++bj) { const float mm = wave_max(mx[bj]); if ((ptid() & 63) == 0) atomicMax((int*)(p->ws + MISC) + MI_KMAX + ((((pn >> 1) * 2 + (u.pm >> 5)) * 4 + 2 * bj + (wc >> 1)) << 1) + (wc & 1), __float_as_int(mm)); }
            }
        } else if (pn == 10) {
#pragma unroll
            for (int ai = 0; ai < 2; ++ai)
#pragma unroll
                for (int m = 0; m < 4; ++m) { float* gt = (float*)(p->ws + GATES) + (size_t)(u.pm * 256 + ai * 128 + wr * 64 + m * 16 + fr) * 48;
#pragma unroll
                    for (int n = 0; n < 2; ++n) { const int c = wc * 32 + n * 16 + 4 * fq; const f32x4 v = acc[ai][0][m][n];
                        if (c < 48) *(f32x4*)(gt + c) = (f32x4){1.f / (1.f + __expf(-v[0])), 1.f / (1.f + __expf(-v[1])), 1.f / (1.f + __expf(-v[2])), 1.f / (1.f + __expf(-v[3]))}; } }
        }
    }
};
struct EpiSwigluP { static constexpr bool PERM = false, AFTER_DRAIN = false; ::bf16_t* C;
    __device__ __forceinline__ void operator()(const f32x4 (&acc)[2][2][4][2], const Unit& u, int wr, int wc, int fr, int fq) const {
#pragma unroll
        for (int ai = 0; ai < 2; ++ai)
#pragma unroll
            for (int m = 0; m < 4; ++m) { ::bf16_t* rp = C + (size_t)(u.pm * 256 + ai * 128 + wr * 64 + m * 16 + fr) * 512 + (u.pn & 3) * 128 + wc * 16 + 2 * fq;
#pragma unroll
                for (int bj = 0; bj < 2; ++bj)
#pragma unroll
                    for (int n = 0; n < 2; ++n) { const f32x4 v = acc[ai][bj][m][n];
                        *(unsigned*)(rp + bj * 64 + n * 8) = pack2(v[0] / (1.f + __expf(-v[0])) * v[1], v[2] / (1.f + __expf(-v[2])) * v[3]); } } } };
struct GroupedGatherOrder { const int* eoff; const int* cnt; const int* inv; int nunits, G, c;
    __device__ __forceinline__ bool next(int i, Unit& u) const {
        const int x = c & 7, q = i * (G >> 3) + (c >> 3), mt = (q >> 2) * 8 + x; if (mt >= (nunits >> 2)) return false;
        int e = 0; while (e < 15 && (mt << 8) >= eoff[e + 1]) ++e;
        u.pm = mt; u.pn = e * 4 + (q & 3); return true; }
    __device__ __forceinline__ int rowidx(const Unit& u, int r) const { const int e = u.pn >> 2, ix = (u.pm << 8) - eoff[e] + r; return inv[e * 16384 + (ix < cnt[e * 64] ? ix : 0)]; }
    __device__ __forceinline__ void a_ready(const Unit&) const {}
    __device__ __forceinline__ void done(const Unit&) const {}
};
struct GroupedOrder { const int* eoff; int nunits, G, c;
    __device__ __forceinline__ bool next(int i, Unit& u) const {
        const int x = c & 7, q = i * (G >> 3) + (c >> 3), mt = (q >> 2) * 8 + x; if (mt >= (nunits >> 2)) return false;
        int e = 0; while (e < 15 && (mt << 8) >= eoff[e + 1]) ++e;
        u.pm = mt; u.pn = e * 4 + (q & 3); return true; }
    __device__ __forceinline__ void a_ready(const Unit&) const {}
    __device__ __forceinline__ void done(const Unit&) const {}
};
}

__device__ __forceinline__ void ph_prep0(const Params& p, unsigned char* smem) {
    { const int tix = ptid(); if (blockIdx.x == 0 && tix < 128) ((int*)(p.ws + MISC))[tix] = 0; }
    {   const float4* x4 = (const float4*)p.x; uint2* xb = (uint2*)(p.ws + XB);
        const int n4 = T_ * D_ / 4, gt = gthreads();
        for (int i0 = gtid(); i0 < n4; i0 += 8 * gt) {
            f32x4 v[8];
#pragma unroll
            for (int j = 0; j < 8; ++j) { const int i = i0 + j * gt; v[j] = *(const f32x4*)(x4 + (i < n4 ? i : i0)); }
#pragma unroll
            for (int j = 0; j < 8; ++j) { const int i = i0 + j * gt; if (i < n4) xb[i] = make_uint2(pack2(v[j][0], v[j][1]), pack2(v[j][2], v[j][3])); }
        } }
    float* tile = (float*)smem;
    {   float* rt = (float*)(p.ws + ROPE_RT);
        const float inv = (float)pow(10000.0, (double)(-(float)(2 * (gtid() & 127)) / 256.0f));
        for (int it = gtid(); it < S_ * 128; it += gthreads()) { const int t = it >> 7; const float ang = (float)t * inv; float sn, cs; sincosf(ang, &sn, &cs); *(float2*)(rt + it * 2) = make_float2(cs, sn); } }
    { const float* w = p.ret_w_in; transpose_conv([w](int k, int n) { const int c = n < 2048 ? (n & ~255) + ((n & 1) << 7) + ((n & 255) >> 1) : n; return w[(size_t)k * 6144 + c]; }, (bf16_t*)(p.ws + WT_IN), 1024, 6144, tile); }
    { const float* w = p.ret_w_out; transpose_conv([w](int k, int n) { return w[(size_t)k * 1024 + n]; }, (bf16_t*)(p.ws + WT_OUT), 2048, 1024, tile); }
}
constexpr int MOEW_TILES_GU = 4096, MOEW_TILES = 6144;
__device__ __forceinline__ void moe_weights_range(const Params& p, int l, unsigned char* smem, int tb, int te, int rank, int nranks) {
    float* tile = (float*)smem;
    if (tb < MOEW_TILES_GU) { const float* wg = p.moe_wg + (size_t)l * 16 * 1024 * 512; const float* wu = p.moe_wu + (size_t)l * 16 * 1024 * 512;
      const ptrdiff_t du = wu - wg;
      transpose_conv_tiles([wg, du](int k, int n) { const int e = n >> 10, c = n & 1023; return wg[(ptrdiff_t)(c & 1) * du + ((size_t)e * 1024 + k) * 512 + (c >> 1)]; },
                           (bf16_t*)(p.ws + (l ? MOEW1_GU : MOEW_GU)), 1024, tile, tb, te < MOEW_TILES_GU ? te : MOEW_TILES_GU, rank, nranks); }
    if (te > MOEW_TILES_GU) { const float* wd = p.moe_wd + (size_t)l * 16 * 512 * 1024;
      transpose_conv_tiles([wd](int k, int n) { const int e = n >> 10, c = n & 1023; return wd[((size_t)e * 512 + k) * 1024 + c]; }, (bf16_t*)(p.ws + (l ? MOEW1_D : MOEW_D)), 512, tile,
                           (tb > MOEW_TILES_GU ? tb : MOEW_TILES_GU) - MOEW_TILES_GU, te - MOEW_TILES_GU, rank, nranks); }
}
__device__ __forceinline__ void ph_moe_weights(const Params& p, int l, unsigned char* smem) {
    float* tile = (float*)smem;
    { const float* wg = p.moe_wg + (size_t)l * 16 * 1024 * 512; const float* wu = p.moe_wu + (size_t)l * 16 * 1024 * 512;
      const ptrdiff_t du = wu - wg;
      transpose_conv([wg, du](int k, int n) { const int e = n >> 10, c = n & 1023; return wg[(ptrdiff_t)(c & 1) * du + ((size_t)e * 1024 + k) * 512 + (c >> 1)]; },
                     (bf16_t*)(p.ws + MOEW_GU), 1024, 16 * 1024, tile); }
    { const float* wd = p.moe_wd + (size_t)l * 16 * 512 * 1024;
      transpose_conv([wd](int k, int n) { const int e = n >> 10, c = n & 1023; return wd[((size_t)e * 512 + k) * 1024 + c]; }, (bf16_t*)(p.ws + MOEW_D), 512, 16 * 1024, tile); }
}
__device__ __forceinline__ void ph_prep1(const Params& p, unsigned char* smem) {
    float* tile = (float*)smem;
    { const float* wkv = p.nsa_w_kv; const float* win = p.nsa_w_in;
      transpose_conv([wkv, win](int k, int n) { const int sec = n >> 8; const bool rot = (sec == 0 || sec == 2 || sec == 4 || (sec >= 6 && sec < 10));
                         const int c = rot ? (n & ~63) + ((n & 1) << 5) + ((n & 63) >> 1) : n;
                         return c < 1536 ? wkv[(size_t)k * 1536 + c] : (c < 2608 ? win[(size_t)k * 1072 + (c - 1536)] : 0.f); },
                     (bf16_t*)(p.ws + WT_KVQ), 1024, KVQ_N, tile); }
    { const float* wk = p.ck_w2; const ptrdiff_t dv = p.cv_w2 - p.ck_w2; transpose_conv([wk, dv](int k, int n) { return (n & 127) < 64 ? wk[(ptrdiff_t)(n >> 7) * dv + (size_t)k * 64 + (n & 127)] : 0.f; }, (bf16_t*)(p.ws + WT_CW2), 256, 256, tile); }
    {   float* nt = (float*)(p.ws + ROPE_NT);
        const float inv = (float)pow(10000.0, (double)(-(float)(2 * (gtid() & 31)) / 64.0f));
        for (int it = gtid(); it < S_ * 32; it += gthreads()) { const int t = it >> 5; const float ang = (float)t * inv; float sn, cs; sincosf(ang, &sn, &cs); *(float2*)(nt + it * 2) = make_float2(cs, sn); } }
    {
        const int lane = ptid() & 63;
        for (int o = gwave(); o < 512; o += gwaves()) {
            const int kv = o >> 8, j = o & 255; const float* w1 = kv ? p.cv_w1 : p.ck_w1; const float* pe = kv ? p.pe_v : p.pe_k;
            float a = 0.f;
            for (int k = lane; k < 2048; k += 64) a += pe[k] * w1[(size_t)k * 256 + j];
            a = wave_sum(a);
            if (lane == 0) ((float*)(p.ws + MISC))[MI_PEW + o] = a;
        } }
    { const float* w = p.nsa_w_out; transpose_conv([w](int k, int n) { return w[(size_t)k * 1024 + n]; }, (bf16_t*)(p.ws + WT_NSAOUT), 1024, 1024, tile); }
    { const float* wk = p.ck_w1; const ptrdiff_t dv = p.cv_w1 - p.ck_w1; transpose_conv([wk, dv](int k, int n) { return wk[(ptrdiff_t)(n >> 8) * dv + (size_t)k * 256 + (n & 255)]; }, (bf16_t*)(p.ws + WT_CW1), 2048, 512, tile); }
}

struct EpiRetIn : EpiBase { const Params* p; int m0, n0; float lg; int head, sec; float kd[4]; int wm_, fr_;
    __device__ __forceinline__ void start(int wm, int wn, int fr, int) {
        wm_ = wm; fr_ = fr; sec = n0 >> 10; head = ((n0 + wn * 64) >> 8) & 3;
        lg = log2f(1.f - exp2f(-5.f - (float)head));
#pragma unroll
        for (int i = 0; i < 4; ++i) { const int t = (m0 + wm * 64 + i * 16 + fr) & (S_ - 1); kd[i] = sec == 1 ? 0.0625f * exp2f((float)(127 - (t & 127)) * lg) : 1.f; }
    }
    __device__ __forceinline__ void operator()(int m, int n, f32x4 v) const {
        const size_t tok = (size_t)(m0 + m); const int c = n0 + n;
        if (n0 < 2048) {
            const int d = (c & 255) >> 1, t = (int)tok & (S_ - 1), i = (m - wm_ * 64 - fr_) >> 4;
            const f32x4 cs = *(const f32x4*)((const float*)(p->ws + ROPE_RT) + ((size_t)t * 128 + d) * 2);
            const float sc = i == 0 ? kd[0] : (i == 1 ? kd[1] : (i == 2 ? kd[2] : kd[3]));
            const float a0 = (v[0] * cs[0] - v[1] * cs[1]) * sc, b0 = (v[1] * cs[0] + v[0] * cs[1]) * sc, a1 = (v[2] * cs[2] - v[3] * cs[3]) * sc, b1 = (v[3] * cs[2] + v[2] * cs[3]) * sc;
            bf16_t* dst = (bf16_t*)(p->ws + (sec ? KB : QB)) + tok * 1024 + head * 256 + d;
            *(unsigned*)dst = pack2(a0, a1); *(unsigned*)(dst + 128) = pack2(b0, b1);
        } else {
            bf16_t* dst = (n0 < 4096 ? (bf16_t*)(p->ws + VB) + (c - 2048) : (bf16_t*)(p->ws + GB) + (c - 4096)) + tok * 2048;
            *(u32x2*)dst = (u32x2){pack2(v[0], v[1]), pack2(v[2], v[3])};
        }
    }
};
__device__ __forceinline__ void ph_gemm_retin(const Params& p, unsigned char* smem) {
    const bf16_t* A = (const bf16_t*)(p.ws + XB); const bf16_t* Bt = (const bf16_t*)(p.ws + WT_IN);
    for (int t = blockIdx.x; t < 64 * 48; t += gridDim.x) {
        const int mt = t / 48, nt = t % 48, n0 = nt * 128;
        EpiRetIn e{}; e.p = &p; e.m0 = mt * 256; e.n0 = n0;
        gemm_tile(A + (size_t)mt * 256 * 1024, 1024, Bt + (size_t)n0 * 1024, 1024, 1024, e, smem);
    }
}
__device__ __forceinline__ void ph_gemm_f32(const bf16_t* A, const bf16_t* Bt, float* C, int Mt, int Nt, int K, int N, unsigned char* smem) {
    for (int t = blockIdx.x; t < Mt * Nt; t += gridDim.x) {
        const int mt = t / Nt, nt = t % Nt;
        gemm_tile(A + (size_t)mt * 256 * K, K, Bt + (size_t)nt * 128 * K, K, K, EpiF32{{}, C + (size_t)mt * 256 * N + nt * 128, N}, smem);
    }
}
__device__ __forceinline__ void ph_gemm_bf16(const bf16_t* A, const bf16_t* Bt, bf16_t* C, int Mt, int Nt, int K, int N, unsigned char* smem) {
    for (int t = blockIdx.x; t < Mt * Nt; t += gridDim.x) {
        const int mt = t / Nt, nt = t % Nt;
        gemm_tile(A + (size_t)mt * 256 * K, K, Bt + (size_t)nt * 128 * K, K, K, EpiBf16{{}, C + (size_t)mt * 256 * N + nt * 128, N}, smem);
    }
}

typedef short s16x4 __attribute__((ext_vector_type(4)));
#define LDSP(T, ptr) ((__attribute__((address_space(3))) T*)(ptr))
__device__ __forceinline__ bf16x8 tr_frag(const bf16_t* tile, int ld, int row0, int col0, int lane) {
    const int g = lane >> 4, q = (lane & 15) >> 2, pp = lane & 3;
    const bf16_t* a = tile + (row0 + 8 * g + q) * ld + col0 + 4 * pp;
    const s16x4 lo = __builtin_amdgcn_ds_read_tr16_b64_v4i16(LDSP(s16x4, a));
    const s16x4 hi = __builtin_amdgcn_ds_read_tr16_b64_v4i16(LDSP(s16x4, a + 4 * ld));
    return (bf16x8){lo[0], lo[1], lo[2], lo[3], hi[0], hi[1], hi[2], hi[3]};
}
__device__ __forceinline__ bf16x8 pack_frag(f32x4 a, f32x4 b) {
    u32x4 u = {pack2(a[0], a[1]), pack2(a[2], a[3]), pack2(b[0], b[1]), pack2(b[2], b[3])};
    return __builtin_bit_cast(bf16x8, u);
}
constexpr int RQ_LD = 264, RK_LD = 136;
template <int NCH> __device__ __forceinline__ void stage_tile(const bf16_t* g, int gld, bf16_t* l, int lld) {
    const int tix = ptid(), row = tix / NCH, ch = tix % NCH, goff = row * gld + ch * 8, loff = row * lld + ch * 8;
#pragma unroll
    for (int i = 0; i < (128 * NCH) / NT; ++i) { *(u32x4*)(l + loff + i * (NT / NCH) * lld) = *(const u32x4*)(g + (size_t)i * (NT / NCH) * gld + goff); if ((i & 3) == 3) asm volatile("" ::: "memory"); }
}
__device__ __forceinline__ void ph_ret_state(const Params& p, unsigned char* smem) {
    const bf16_t* K = (const bf16_t*)(p.ws + KB); const bf16_t* V = (const bf16_t*)(p.ws + VB); float* L = (float*)(p.ws + RET_L);
    bf16_t* Ks = (bf16_t*)smem; bf16_t* Vs = Ks + 128 * RQ_LD;
    const int tix = ptid(), lane = tix & 63, w = __builtin_amdgcn_readfirstlane(tix >> 6), g = lane >> 4, i16 = lane & 15;
    for (int unit = blockIdx.x; unit < 224; unit += gridDim.x) {
        const int slice = unit & 3, seg = (unit >> 2) % 7, bh = unit / 28, b = bh >> 2, h = bh & 3;
        const float lg = log2f(1.f - exp2f(-5.f - (float)h)), g128 = exp2f(128.f * lg);
        f32x4 S[16];
#pragma unroll
        for (int dt = 0; dt < 16; ++dt) S[dt] = (f32x4){0.f, 0.f, 0.f, 0.f};
        u32x4 pk[8], pv[4];
        const int kg = (tix >> 5) * 1024 + (tix & 31) * 8, kl = (tix >> 5) * RQ_LD + (tix & 31) * 8, vg = (tix >> 4) * 2048 + (tix & 15) * 8, vl = (tix >> 4) * RK_LD + (tix & 15) * 8;
        {   const size_t t0 = (size_t)b * S_ + seg * 1024;
#pragma unroll
            for (int i = 0; i < 8; ++i) pk[i] = *(const u32x4*)(K + t0 * 1024 + h * 256 + (size_t)i * 16 * 1024 + kg);
#pragma unroll
            for (int i = 0; i < 4; ++i) pv[i] = *(const u32x4*)(V + t0 * 2048 + h * 512 + slice * 128 + (size_t)i * 32 * 2048 + vg); }
        for (int ch = 0; ch < 8; ++ch) {
            __syncthreads();
#pragma unroll
            for (int i = 0; i < 8; ++i) *(u32x4*)(Ks + kl + i * 16 * RQ_LD) = pk[i];
#pragma unroll
            for (int i = 0; i < 4; ++i) *(u32x4*)(Vs + vl + i * 32 * RK_LD) = pv[i];
            __syncthreads();
            {   const size_t t1 = (size_t)b * S_ + seg * 1024 + (ch < 7 ? ch + 1 : ch) * 128;
#pragma unroll
                for (int i = 0; i < 8; ++i) pk[i] = *(const u32x4*)(K + t1 * 1024 + h * 256 + (size_t)i * 16 * 1024 + kg);
#pragma unroll
                for (int i = 0; i < 4; ++i) pv[i] = *(const u32x4*)(V + t1 * 2048 + h * 512 + slice * 128 + (size_t)i * 32 * 2048 + vg); }
            bf16x8 Vf[4];
#pragma unroll
            for (int ks = 0; ks < 4; ++ks) Vf[ks] = tr_frag(Vs, RK_LD, 32 * ks, 16 * w, lane);
#pragma unroll
            for (int dt = 0; dt < 16; ++dt) {
                S[dt] = S[dt] * g128;
#pragma unroll
                for (int ks = 0; ks < 4; ++ks) S[dt] = __builtin_amdgcn_mfma_f32_16x16x32_bf16(tr_frag(Ks, RQ_LD, 32 * ks, 16 * dt, lane), Vf[ks], S[dt], 0, 0, 0);
            }
        }
        float* Lu = L + (size_t)((bh * 8 + seg) * 4 + slice) * (256 * 128) + tix * 64;
#pragma unroll
        for (int dt = 0; dt < 16; ++dt) *(f32x4*)(Lu + dt * 4) = S[dt];
    }
}
__device__ __forceinline__ void ph_ret_scan(const Params& p, unsigned char* smem) {
    const bf16_t* Q = (const bf16_t*)(p.ws + QB); const bf16_t* K = (const bf16_t*)(p.ws + KB); const bf16_t* V = (const bf16_t*)(p.ws + VB);
    const float* L = (const float*)(p.ws + RET_L); bf16_t* O = (bf16_t*)p.out;
    bf16_t* Qs = (bf16_t*)smem; bf16_t* Ks = Qs + 128 * RK_LD; bf16_t* Vs = Ks + 128 * RK_LD; bf16_t* Ps = Vs + 128 * RK_LD;
    const int tix = ptid(), lane = tix & 63, w = __builtin_amdgcn_readfirstlane(tix >> 6), g = lane >> 4, i16 = lane & 15;
    for (int unit = blockIdx.x; unit < 256; unit += gridDim.x) {
        const int slice = unit & 3, seg = (unit >> 2) & 7, bh = unit >> 5, b = bh >> 2, h = bh & 3;
        const float lg = log2f(1.f - exp2f(-5.f - (float)h)), g128 = exp2f(128.f * lg), g1024 = exp2f(1024.f * lg), gm128 = exp2f(-128.f * lg);
        f32x4 S[16];
#pragma unroll
        for (int dt = 0; dt < 16; ++dt) S[dt] = (f32x4){0.f, 0.f, 0.f, 0.f};
        for (int j = 0; j < seg; ++j) {
            const float* Lu = L + (size_t)((bh * 8 + j) * 4 + slice) * (256 * 128) + tix * 64;
#pragma unroll
            for (int dt = 0; dt < 16; ++dt) { S[dt] = S[dt] * g1024 + *(const f32x4*)(Lu + dt * 4); if ((dt & 3) == 3) asm volatile("" ::: "memory"); }
        }
        u32x4 pfq[4], pfk[4]; const int pfg = (tix >> 4) * 1024 + (tix & 15) * 8, pfl = (tix >> 4) * RK_LD + (tix & 15) * 8;
        {   const bf16_t* q0 = Q + ((size_t)b * S_ + seg * 1024) * 1024 + h * 256; const bf16_t* k0_ = K + ((size_t)b * S_ + seg * 1024) * 1024 + h * 256;
#pragma unroll
            for (int i = 0; i < 4; ++i) { pfq[i] = *(const u32x4*)(q0 + (size_t)i * 32 * 1024 + pfg); pfk[i] = *(const u32x4*)(k0_ + (size_t)i * 32 * 1024 + pfg); } }
        for (int ch = 0; ch < 8; ++ch) {
            const size_t tok0 = (size_t)b * S_ + seg * 1024 + ch * 128;
            f32x4 Oa[8], P[8];
#pragma unroll
            for (int i = 0; i < 8; ++i) { Oa[i] = (f32x4){0.f, 0.f, 0.f, 0.f}; P[i] = (f32x4){0.f, 0.f, 0.f, 0.f}; }
#pragma unroll
            for (int hf = 0; hf < 2; ++hf) {
                __syncthreads();
#pragma unroll
                for (int i = 0; i < 4; ++i) { *(u32x4*)(Qs + pfl + i * 32 * RK_LD) = pfq[i]; *(u32x4*)(Ks + pfl + i * 32 * RK_LD) = pfk[i]; }
                if (hf == 0) stage_tile<16>(V + tok0 * 2048 + h * 512 + slice * 128, 2048, Vs, RK_LD);
                __syncthreads();
                {
                    const int nch = hf == 0 ? ch : (ch < 7 ? ch + 1 : ch), nhf = hf == 0 ? 1 : (ch < 7 ? 0 : 1);
                    const bf16_t* qn_ = Q + ((size_t)b * S_ + seg * 1024 + nch * 128) * 1024 + h * 256 + nhf * 128; const bf16_t* kn_ = K + ((size_t)b * S_ + seg * 1024 + nch * 128) * 1024 + h * 256 + nhf * 128;
#pragma unroll
                    for (int i = 0; i < 4; ++i) { pfq[i] = *(const u32x4*)(qn_ + (size_t)i * 32 * 1024 + pfg); pfk[i] = *(const u32x4*)(kn_ + (size_t)i * 32 * 1024 + pfg); }
                }
                {
                    bf16x8 Sf[4];
#pragma unroll
                    for (int ks = 0; ks < 4; ++ks) Sf[ks] = pack_frag(S[8 * hf + 2 * ks], S[8 * hf + 2 * ks + 1]);
#pragma unroll
                    for (int ct = 0; ct < 8; ++ct) {
#pragma unroll
                        for (int ks = 0; ks < 4; ++ks) {
                            const bf16_t* qa = Qs + (16 * ct + i16) * RK_LD + 32 * ks + 4 * g;
                            const u32x2 lo = *(const u32x2*)qa, hi = *(const u32x2*)(qa + 16);
                            const u32x4 qq = {lo[0], lo[1], hi[0], hi[1]};
                            Oa[ct] = __builtin_amdgcn_mfma_f32_16x16x32_bf16(Sf[ks], __builtin_bit_cast(bf16x8, qq), Oa[ct], 0, 0, 0);
                        }
                        if (ct & 1) __builtin_amdgcn_sched_barrier(0);
                    }
                }
#pragma unroll
                for (int ks = 0; ks < 4; ++ks) {
                    const bf16x8 Qf = *(const bf16x8*)(Qs + (16 * w + i16) * RK_LD + 32 * ks + 8 * g);
#pragma unroll
                    for (int mt = 0; mt < 8; ++mt) if (mt <= w) P[mt] = __builtin_amdgcn_mfma_f32_16x16x32_bf16(*(const bf16x8*)(Ks + (16 * mt + i16) * RK_LD + 32 * ks + 8 * g), Qf, P[mt], 0, 0, 0);
                }
                __builtin_amdgcn_sched_barrier(0);
                if (hf == 1) {
                    const int c = 16 * w + i16;
#pragma unroll
                    for (int mt = 0; mt < 8; ++mt) {
                        float v[4];
#pragma unroll
                        for (int r = 0; r < 4; ++r) { const int m = 16 * mt + 4 * g + r; v[r] = (mt <= w && m <= c) ? P[mt][r] * gm128 : 0.f; }
                        *(u32x2*)(Ps + c * RK_LD + 16 * mt + 4 * g) = (u32x2){pack2(v[0], v[1]), pack2(v[2], v[3])};
                    }
                }
                {
                    bf16x8 Vf[4];
#pragma unroll
                    for (int ks = 0; ks < 4; ++ks) Vf[ks] = tr_frag(Vs, RK_LD, 32 * ks, 16 * w, lane);
#pragma unroll
                    for (int dt = 0; dt < 8; ++dt) {
                        S[8 * hf + dt] = S[8 * hf + dt] * g128;
#pragma unroll
                        for (int ks = 0; ks < 4; ++ks) S[8 * hf + dt] = __builtin_amdgcn_mfma_f32_16x16x32_bf16(tr_frag(Ks, RK_LD, 32 * ks, 16 * dt, lane), Vf[ks], S[8 * hf + dt], 0, 0, 0);
                        if (dt & 1) __builtin_amdgcn_sched_barrier(0);
                    }
                }
            }
            __syncthreads();
            {
                bf16x8 Vf[4];
#pragma unroll
                for (int ks = 0; ks < 4; ++ks) Vf[ks] = tr_frag(Vs, RK_LD, 32 * ks, 16 * w, lane);
#pragma unroll
                for (int ct = 0; ct < 8; ++ct)
#pragma unroll
                    for (int ks = 0; ks < 4; ++ks) if (ks <= ct / 2) Oa[ct] = __builtin_amdgcn_mfma_f32_16x16x32_bf16(Vf[ks], *(const bf16x8*)(Ps + (16 * ct + i16) * RK_LD + 32 * ks + 8 * g), Oa[ct], 0, 0, 0);
            }
            {
                bf16_t* ob = O + tok0 * 2048 + h * 512 + slice * 128 + 16 * w; const int ooff = i16 * 2048 + 4 * g;
#pragma unroll
                for (int ct = 0; ct < 8; ++ct) { const float sc = exp2f((float)(16 * ct + i16 + 1) * lg); *(u32x2*)(ob + (size_t)ct * 16 * 2048 + ooff) = (u32x2){pack2(Oa[ct][0] * sc, Oa[ct][1] * sc), pack2(Oa[ct][2] * sc, Oa[ct][3] * sc)}; }
            }
        }
    }
}
__device__ __forceinline__ void ph_gnorm_gate(const Params& p) {
    bf16_t* O = (bf16_t*)p.out; const bf16_t* G = (const bf16_t*)(p.ws + GB);
    const int lane = ptid() & 63, gw = gwaves();
    for (int it0 = gwave(); it0 < T_ * 4; it0 += 4 * gw) {
        u32x4 xr[4], gr[4];
#pragma unroll
        for (int u = 0; u < 4; ++u) { const int it = it0 + u * gw < T_ * 4 ? it0 + u * gw : it0; const size_t off = (size_t)it * 512 + lane * 8; xr[u] = *(const u32x4*)(O + off); gr[u] = *(const u32x4*)(G + off); }
#pragma unroll
        for (int u = 0; u < 4; ++u) {
            const int it = it0 + u * gw; if (it >= T_ * 4) break;
            const size_t off = (size_t)it * 512 + lane * 8;
            float x[8], g[8]; unpack8(xr[u], x); unpack8(gr[u], g);
            float s = 0.f;
#pragma unroll
            for (int j = 0; j < 8; ++j) s += x[j];
            const float mean = wave_sum(s) * (1.f / 512.f);
            float q = 0.f;
#pragma unroll
            for (int j = 0; j < 8; ++j) { x[j] -= mean; q += x[j] * x[j]; }
            const float rstd = rsqrtf(wave_sum(q) * (1.f / 512.f) + 1e-5f);
            float r[8];
#pragma unroll
            for (int j = 0; j < 8; ++j) r[j] = x[j] * rstd * (g[j] / (1.f + __expf(-g[j])));
            *(u32x4*)(O + off) = (u32x4){pack2(r[0], r[1]), pack2(r[2], r[3]), pack2(r[4], r[5]), pack2(r[6], r[7])};
        }
    }
}

template <bool COMBINE, bool ROUTER, bool FINAL, bool BASEBF> __forceinline__
__device__ __forceinline__ void ph_ln(const Params& p, const float* base, const float* mix, float* hout, bf16_t* hb, const float* lng, const float* lnb, int layer, unsigned char* smem) {
    const int tix = ptid(), lane = tix & 63;
    int* misc = (int*)(p.ws + MISC);
    const bf16_t* yexp = (const bf16_t*)(p.ws + YEXP);
    float* rwl = (float*)smem;
    int* eoffs = (int*)(smem + 65536);
    int* lcnt = (int*)(smem + 65536 + 256);
    int* lbase = lcnt + 16; int* llist = lcnt + 32; int nloc = 0;
    if (ROUTER) {
        for (int i0 = 0; i0 < 1024 * 16; i0 += 8 * NT) {
            float rv[8];
#pragma unroll
            for (int j = 0; j < 8; ++j) rv[j] = p.router_w[i0 + j * NT + tix];
#pragma unroll
            for (int j = 0; j < 8; ++j) { const int idx = i0 + j * NT + tix, d = idx >> 4, e = idx & 15; rwl[((((d >> 8) * 4 + (d & 3)) * 64 + ((d & 255) >> 2)) << 4) + e] = rv[j]; }
        }
        if (tix < 16) lcnt[tix] = 0;
        __syncthreads();
    }
    if (COMBINE) {
        if (tix == 0) { const int* cnt = (const int*)(p.ws + CNT_OFF) + layer * 1024; int o = 0; for (int e = 0; e < 16; ++e) { eoffs[e] = o; o += (cnt[e * 64] + 255) & ~255; } }
        __syncthreads();
    }
    struct LnIn { f32x4 a[4], m[4]; u32x2 ab[4], y0[4], y1[4]; float w0, w1; };
    int pr0 = 0, pr1 = 0; float pw0 = 0.f, pw1 = 0.f;
    auto ln_load = [&](int tok, int ix, LnIn& in) {
        int r0 = 0, r1 = 0;
        if (COMBINE) { in.w0 = __shfl(pw0, ix); in.w1 = __shfl(pw1, ix); r0 = __shfl(pr0, ix); r1 = __shfl(pr1, ix); }
#pragma unroll
        for (int i = 0; i < 4; ++i) {
            if (BASEBF) in.ab[i] = *(const u32x2*)((const bf16_t*)base + (size_t)tok * 1024 + i * 256 + lane * 4); else in.a[i] = *(const f32x4*)(base + (size_t)tok * 1024 + i * 256 + lane * 4);
            if (COMBINE) { in.y0[i] = *(const u32x2*)(yexp + (size_t)r0 * 1024 + i * 256 + lane * 4); in.y1[i] = *(const u32x2*)(yexp + (size_t)r1 * 1024 + i * 256 + lane * 4); }
            else in.m[i] = *(const f32x4*)(mix + (size_t)tok * 1024 + i * 256 + lane * 4);
        }
    };
    auto ln_token = [&](int tok, const LnIn& in) {
        float v[16];
#pragma unroll
        for (int i = 0; i < 4; ++i) {
            f32x4 m;
            if (COMBINE) { m[0] = in.w0 * lo2f(in.y0[i][0]) + in.w1 * lo2f(in.y1[i][0]); m[1] = in.w0 * hi2f(in.y0[i][0]) + in.w1 * hi2f(in.y1[i][0]); m[2] = in.w0 * lo2f(in.y0[i][1]) + in.w1 * lo2f(in.y1[i][1]); m[3] = in.w0 * hi2f(in.y0[i][1]) + in.w1 * hi2f(in.y1[i][1]); }
            else m = in.m[i];
            const f32x4 av = BASEBF ? (f32x4){lo2f(in.ab[i][0]), hi2f(in.ab[i][0]), lo2f(in.ab[i][1]), hi2f(in.ab[i][1])} : in.a[i];
            v[i * 4 + 0] = 1.41421356237f * av[0] + m[0]; v[i * 4 + 1] = 1.41421356237f * av[1] + m[1]; v[i * 4 + 2] = 1.41421356237f * av[2] + m[2]; v[i * 4 + 3] = 1.41421356237f * av[3] + m[3];
        }
        float s = 0.f;
#pragma unroll
        for (int i = 0; i < 16; ++i) s += v[i];
        const float mean = wave_sum(s) * (1.f / 1024.f);
        float q = 0.f;
#pragma unroll
        for (int i = 0; i < 16; ++i) { v[i] -= mean; q += v[i] * v[i]; }
        const float rstd = rsqrtf(wave_sum(q) * (1.f / 1024.f) + 1e-5f);
#pragma unroll
        for (int i = 0; i < 4; ++i) {
            const float4 g = *(const float4*)(lng + i * 256 + lane * 4), bb = *(const float4*)(lnb + i * 256 + lane * 4);
            v[i * 4 + 0] = v[i * 4 + 0] * rstd * g.x + bb.x; v[i * 4 + 1] = v[i * 4 + 1] * rstd * g.y + bb.y; v[i * 4 + 2] = v[i * 4 + 2] * rstd * g.z + bb.z; v[i * 4 + 3] = v[i * 4 + 3] * rstd * g.w + bb.w;
            if (FINAL) *(float4*)(hout + (size_t)tok * 1024 + i * 256 + lane * 4) = make_float4(v[i * 4 + 0], v[i * 4 + 1], v[i * 4 + 2], v[i * 4 + 3]);
            if (!FINAL) *(uint2*)(hb + (size_t)tok * 1024 + i * 256 + lane * 4) = make_uint2(pack2(v[i * 4 + 0], v[i * 4 + 1]), pack2(v[i * 4 + 2], v[i * 4 + 3]));
        }
        if (ROUTER) {
            __builtin_amdgcn_sched_barrier(0);
            float lg[16];
#pragma unroll
            for (int e = 0; e < 16; ++e) lg[e] = 0.f;
#pragma unroll
            for (int i = 0; i < 4; ++i)
#pragma unroll
                for (int j = 0; j < 4; ++j) {
                    const f32x4* rw = (const f32x4*)(rwl + (((i * 4 + j) * 64 + lane) << 4));
                    const float hv = v[i * 4 + j];
#pragma unroll
                    for (int e4 = 0; e4 < 4; ++e4) { const f32x4 r = rw[e4]; lg[e4 * 4 + 0] += hv * r[0]; lg[e4 * 4 + 1] += hv * r[1]; lg[e4 * 4 + 2] += hv * r[2]; lg[e4 * 4 + 3] += hv * r[3]; }
                    if (j & 1) asm volatile("" ::: "memory");
                }
            __builtin_amdgcn_sched_barrier(0);
            float r8[8], r4[4], r2[2], r1;
#pragma unroll
            for (int e = 0; e < 8; ++e) { const bool hi = lane & 32; const float keep = hi ? lg[e + 8] : lg[e], send = hi ? lg[e] : lg[e + 8]; r8[e] = keep + __shfl_xor(send, 32); }
#pragma unroll
            for (int e = 0; e < 4; ++e) { const bool hi = lane & 16; const float keep = hi ? r8[e + 4] : r8[e], send = hi ? r8[e] : r8[e + 4]; r4[e] = keep + __shfl_xor(send, 16); }
#pragma unroll
            for (int e = 0; e < 2; ++e) { const bool hi = lane & 8; const float keep = hi ? r4[e + 2] : r4[e], send = hi ? r4[e] : r4[e + 2]; r2[e] = keep + __shfl_xor(send, 8); }
            { const bool hi = lane & 4; const float keep = hi ? r2[1] : r2[0], send = hi ? r2[0] : r2[1]; r1 = keep + __shfl_xor(send, 4); }
            r1 += __shfl_xor(r1, 1); r1 += __shfl_xor(r1, 2);
            float aff[16], sel[16];
#pragma unroll
            for (int e = 0; e < 16; ++e) { const int src = ((e >> 3) & 1) * 32 + ((e >> 2) & 1) * 16 + ((e >> 1) & 1) * 8 + (e & 1) * 4; const float l = __shfl(r1, src); aff[e] = 1.f / (1.f + expf(-l)); sel[e] = aff[e] + p.router_b[e]; }
            float best = -3.0e38f; int bg = 0; float b0 = 0, b1 = 0, b2 = 0, b3 = 0, a0 = 0, a1 = 0, a2 = 0, a3 = 0;
#pragma unroll
            for (int g = 0; g < 4; ++g) {
                const float x0 = sel[4 * g], x1 = sel[4 * g + 1], x2 = sel[4 * g + 2], x3 = sel[4 * g + 3];
                const float mx = fmaxf(fmaxf(x0, x1), fmaxf(x2, x3));
                const float m2 = fmaxf(fmaxf(fminf(x0, x1), fminf(x2, x3)), fminf(fmaxf(x0, x1), fmaxf(x2, x3)));
                const float gs = mx + m2;
                if (gs > best) { best = gs; bg = g; b0 = x0; b1 = x1; b2 = x2; b3 = x3; a0 = aff[4 * g]; a1 = aff[4 * g + 1]; a2 = aff[4 * g + 2]; a3 = aff[4 * g + 3]; }
            }
            int i1 = 0; float m = b0, wa = a0;
            if (b1 > m) { m = b1; i1 = 1; wa = a1; } if (b2 > m) { m = b2; i1 = 2; wa = a2; } if (b3 > m) { m = b3; i1 = 3; wa = a3; }
            int i2 = -1; float m2 = -3.0e38f, wb = 0.f;
            if (i1 != 0 && b0 > m2) { m2 = b0; i2 = 0; wb = a0; } if (i1 != 1 && b1 > m2) { m2 = b1; i2 = 1; wb = a1; }
            if (i1 != 2 && b2 > m2) { m2 = b2; i2 = 2; wb = a2; } if (i1 != 3 && b3 > m2) { m2 = b3; i2 = 3; wb = a3; }
            const float nrm = wa + wb;
            if (lane == 0) {
                const int e1 = bg * 4 + i1, e2 = bg * 4 + i2;
                misc[MI_TE + tok * 2] = e1; misc[MI_TE + tok * 2 + 1] = e2;
                misc[MI_TW + tok * 2] = __float_as_int(wa / nrm); misc[MI_TW + tok * 2 + 1] = __float_as_int(wb / nrm);
                const int li1 = atomicAdd(&lcnt[e1], 1), li2 = atomicAdd(&lcnt[e2], 1);
                int* ent = llist + ((tix >> 6) * 16 + nloc) * 5; ent[0] = tok; ent[1] = e1; ent[2] = e2; ent[3] = li1; ent[4] = li2;
            }
            ++nloc;
        }
    };
    {
        const int t00 = gwave(), step = gwaves(), ntk_all = (T_ - t00 + step - 1) / step;
        for (int c0 = 0; c0 < ntk_all; c0 += 64) {
            const int t0 = t00 + c0 * step, ntk = ntk_all - c0 < 64 ? ntk_all - c0 : 64;
            if (COMBINE) { const int tl = t0 + (lane < ntk ? lane : 0) * step;
                pw0 = __int_as_float(misc[MI_TW + tl * 2]); pw1 = __int_as_float(misc[MI_TW + tl * 2 + 1]); pr0 = eoffs[misc[MI_TE + tl * 2]] + misc[MI_TI + tl * 2]; pr1 = eoffs[misc[MI_TE + tl * 2 + 1]] + misc[MI_TI + tl * 2 + 1]; }
            if constexpr (!ROUTER) {
                LnIn in0, in1, in2;
                auto cl = [&](int i) { return i < ntk ? i : ntk - 1; };
                ln_load(t0, 0, in0); ln_load(t0 + cl(1) * step, cl(1), in1);
                for (int it = 0; it < ntk; it += 3) {
                    ln_load(t0 + cl(it + 2) * step, cl(it + 2), in2); ln_token(t0 + it * step, in0); if (it + 1 >= ntk) break;
                    ln_load(t0 + cl(it + 3) * step, cl(it + 3), in0); ln_token(t0 + (it + 1) * step, in1); if (it + 2 >= ntk) break;
                    ln_load(t0 + cl(it + 4) * step, cl(it + 4), in1); ln_token(t0 + (it + 2) * step, in2);
                }
                continue;
            }
            LnIn inA, inB;
            ln_load(t0, 0, inA);
            for (int it = 0; it < ntk; it += 2) {
                const int tk = t0 + it * step, tk1 = tk + step, tk2 = tk + 2 * step;
                ln_load(it + 1 < ntk ? tk1 : tk, it + 1 < ntk ? it + 1 : it, inB);
                ln_token(tk, inA);
                if (it + 1 >= ntk) break;
                ln_load(it + 2 < ntk ? tk2 : tk1, it + 2 < ntk ? it + 2 : it + 1, inA);
                ln_token(tk1, inB);
            }
        }
    }
    if (ROUTER) {
        __syncthreads();
        int* cnt = (int*)(p.ws + CNT_OFF) + layer * 1024;
        if (tix < 16) lbase[tix] = lcnt[tix] ? atomicAdd(&cnt[tix * 64], lcnt[tix]) : 0;
        __syncthreads();
        int* inv = (int*)(p.ws + MOE_INV);
        const int wv = tix >> 6, k = tix & 63;
        if (k < nloc) { const int* ent = llist + (wv * 16 + k) * 5; const int tok = ent[0], e1 = ent[1], e2 = ent[2], i1x = lbase[e1] + ent[3], i2x = lbase[e2] + ent[4];
            misc[MI_TI + tok * 2] = i1x; misc[MI_TI + tok * 2 + 1] = i2x; inv[e1 * 16384 + i1x] = tok; inv[e2 * 16384 + i2x] = tok; }
    }
}

template <int WHICH> __device__ __forceinline__ void ph_moe_gemm(const Params& p, int layer, unsigned char* smem) {
    const int* cnt = (const int*)(p.ws + CNT_OFF) + layer * 1024;
    __shared__ int eoff[17]; const int tix = ptid();
    if (tix == 0) { int o = 0; for (int e = 0; e < 16; ++e) { eoff[e] = o; o += (cnt[e * 64] + 255) & ~255; } eoff[16] = o; }
    __syncthreads();
    const int Mt = eoff[16] >> 8;
    for (int t = blockIdx.x; t < Mt * 8; t += gridDim.x) {
        const int mt = t >> 3, nt = t & 7, row0 = mt << 8;
        int e = 0;
        while (e < 15 && row0 >= eoff[e + 1]) ++e;
        if (WHICH == 0) {
            const int* inv = (const int*)(p.ws + MOE_INV) + e * 16384; const int ne = cnt[e * 64], i0 = row0 - eoff[e] + (tix >> 3);
            const bf16_t* ap[4];
#pragma unroll
            for (int i = 0; i < 4; ++i) { const int ix = i0 + 64 * i; ap[i] = (const bf16_t*)(p.ws + H_BF) + (size_t)inv[ix < ne ? ix : 0] * 1024 + (tix & 7) * 8; }
            const bf16_t* Bt = (const bf16_t*)(p.ws + MOEW_GU) + ((size_t)e * 1024 + nt * 128) * 1024;
            gemm_tile_rows(ap, Bt, 1024, 1024, EpiSwiglu{{}, (bf16_t*)p.out + (size_t)row0 * 512 + nt * 64, 512}, smem);
        } else {
            const bf16_t* A = (const bf16_t*)p.out + (size_t)row0 * 512;
            const bf16_t* Bt = (const bf16_t*)(p.ws + MOEW_D) + ((size_t)e * 1024 + nt * 128) * 512;
            gemm_tile(A, 512, Bt, 512, 512, EpiBf16{{}, (bf16_t*)(p.ws + YEXP) + (size_t)row0 * 1024 + nt * 128, 1024}, smem);
        }
    }
}

struct EpiKvq : EpiBase { const Params* p; int m0, n0; int wm_, fr_, hbase; bool isk; float nrm, mx;
    __device__ __forceinline__ void start(int wm, int wn, int fr, int) { wm_ = wm; fr_ = fr; hbase = n0 + wn * 64; const int sec = n0 >> 8; isk = sec == 0 || sec == 2 || sec == 4; nrm = 0.f; mx = 0.f; }
    __device__ __forceinline__ void operator()(int m, int n, f32x4 v) {
        const size_t tok = (size_t)(m0 + m); const int c = n0 + n, sec = n0 >> 8;
        bf16_t* row = (bf16_t*)(p->ws + KVQ) + tok * KVQ_LD;
        if (sec == 1 || sec == 3 || sec == 5) { *(u32x2*)(row + c) = (u32x2){pack2(v[0], v[1]), pack2(v[2], v[3])}; }
        else if (sec < 10) {
            const int d = (c & 63) >> 1, t = (int)tok & (S_ - 1);
            const f32x4 cs = *(const f32x4*)((const float*)(p->ws + ROPE_NT) + ((size_t)t * 32 + d) * 2);
            const float sc = sec >= 6 ? 0.125f : 1.f;
            const float a0 = (v[0] * cs[0] - v[1] * cs[1]) * sc, b0 = (v[1] * cs[0] + v[0] * cs[1]) * sc, a1 = (v[2] * cs[2] - v[3] * cs[3]) * sc, b1 = (v[3] * cs[2] + v[2] * cs[3]) * sc;
            bf16_t* dst = row + (c & ~63) + d;
            *(unsigned*)dst = pack2(a0, a1); *(unsigned*)(dst + 32) = pack2(b0, b1);
            nrm += a0 * a0 + b0 * b0 + a1 * a1 + b1 * b1;
        } else if (c < 2608) {
            float* gt = (float*)(p->ws + GATES) + tok * 48 + (c - 2560);
            *(f32x4*)gt = (f32x4){1.f / (1.f + __expf(-v[0])), 1.f / (1.f + __expf(-v[1])), 1.f / (1.f + __expf(-v[2])), 1.f / (1.f + __expf(-v[3]))};
        }
    }
    __device__ __forceinline__ void row_done(int) { float r = nrm; r += __shfl_xor(r, 16); r += __shfl_xor(r, 32); mx = fmaxf(mx, r); nrm = 0.f; }
    __device__ __forceinline__ void finish() {
        if (isk) { const float m = wave_max(mx); if ((ptid() & 63) == 0) atomicMax((int*)(p->ws + MISC) + MI_KMAX + ((n0 >> 9) * 2 + (m0 >> 13)) * 4 + ((hbase & 255) >> 6), __float_as_int(sqrtf(m) * 1.01f + 1e-6f)); }
    }
};
__device__ __forceinline__ void ph_gemm_kvq(const Params& p, unsigned char* smem) {
    const bf16_t* A = (const bf16_t*)(p.ws + H_BF); const bf16_t* Bt = (const bf16_t*)(p.ws + WT_KVQ);
    for (int t = blockIdx.x; t < 64 * (KVQ_LD / 128); t += gridDim.x) {
        const int mt = t / (KVQ_LD / 128), nt = t % (KVQ_LD / 128);
        EpiKvq e{}; e.p = &p; e.m0 = mt * 256; e.n0 = nt * 128;
        gemm_tile(A + (size_t)mt * 256 * 1024, 1024, Bt + (size_t)nt * 128 * 1024, 1024, 1024, e, smem);
    }
}

#define PG8_LDS(ptr) ((PG8_LAS unsigned char*)(ptr))
__device__ __forceinline__ void ph_gemm_retin8(const Params& p, unsigned char* smem) {
    const pg8::Gemm g{(const bf16_t*)(p.ws + XB), (const bf16_t*)(p.ws + WT_IN), T_, 6144, 1024}; pg8::StaticOrder S; S.init(T_, 6144, (int)gridDim.x, (int)blockIdx.x);
    const pg8::EpiRetInP E{&p};
    pg8::gemm_phase<pg8::EpiRetInP, pg8::StaticOrder, true, true>(PG8_LDS(smem), g, S, E);
}
__device__ __forceinline__ void ph_gemm_f32_8(const bf16_t* A, const bf16_t* Bt, float* C, int N, int K, unsigned char* smem) {
    const pg8::Gemm g{A, Bt, T_, N, K}; pg8::StaticOrder S; S.init(T_, N, (int)gridDim.x, (int)blockIdx.x);
    const pg8::EpiF32P E{C, N};
    pg8::gemm_phase<pg8::EpiF32P, pg8::StaticOrder, true, true>(PG8_LDS(smem), g, S, E);
}
__device__ __forceinline__ void ph_gemm_kvq8(const Params& p, unsigned char* smem) {
    const pg8::Gemm g{(const bf16_t*)(p.ws + H_BF), (const bf16_t*)(p.ws + WT_KVQ), T_, KVQ_N, 1024}; pg8::StaticOrder S; S.init(T_, KVQ_N, (int)gridDim.x, (int)blockIdx.x);
    const pg8::EpiKvqP E{&p};
    pg8::gemm_phase<pg8::EpiKvqP, pg8::StaticOrder, true, true>(PG8_LDS(smem), g, S, E);
}
__device__ __forceinline__ void ph_moe_up8(const Params& p, int layer, unsigned char* smem) {
    const int* cnt = (const int*)(p.ws + CNT_OFF) + layer * 1024;
    int* eoff = (int*)(smem + 131072 + 1024);
    if (ptid() == 0) { int o = 0; for (int e = 0; e < 16; ++e) { eoff[e] = o; o += (cnt[e * 64] + 255) & ~255; } eoff[16] = o; }
    __syncthreads();
    const pg8::Gemm g{(const bf16_t*)(p.ws + H_BF), (const bf16_t*)(p.ws + (layer ? MOEW1_GU : MOEW_GU)), eoff[16], 16 * 1024, 1024};
    const pg8::GroupedGatherOrder S{eoff, cnt, (const int*)(p.ws + MOE_INV), (eoff[16] >> 8) * 4, (int)gridDim.x, (int)blockIdx.x};
    const pg8::EpiSwigluP E{(bf16_t*)p.out};
    pg8::gemm_phase<pg8::EpiSwigluP, pg8::GroupedGatherOrder, true, true, true>(PG8_LDS(smem), g, S, E);
}
__device__ __forceinline__ void ph_moe_down8(const Params& p, int layer, unsigned char* smem) {
    const int* cnt = (const int*)(p.ws + CNT_OFF) + layer * 1024;
    int* eoff = (int*)(smem + 131072 + 1024);
    if (ptid() == 0) { int o = 0; for (int e = 0; e < 16; ++e) { eoff[e] = o; o += (cnt[e * 64] + 255) & ~255; } eoff[16] = o; }
    __syncthreads();
    const pg8::Gemm g{(const bf16_t*)p.out, (const bf16_t*)(p.ws + (layer ? MOEW1_D : MOEW_D)), eoff[16], 16 * 1024, 512};
    const pg8::GroupedOrder S{eoff, (eoff[16] >> 8) * 4, (int)gridDim.x, (int)blockIdx.x};
    const pg8::EpiBf16P E{(bf16_t*)(p.ws + YEXP), 1024, 3};
    pg8::gemm_phase<pg8::EpiBf16P, pg8::GroupedOrder, true, true>(PG8_LDS(smem), g, S, E);
}
__device__ __forceinline__ void moe_tail_convert(const Params& p, int layer, unsigned char* smem, int tb, int te) {
    const int* cnt = (const int*)(p.ws + CNT_OFF) + layer * 1024;
    int MT = 0; for (int e = 0; e < 16; ++e) MT += (cnt[e * 64] + 255) >> 8;
    const int G = (int)gridDim.x, c = (int)blockIdx.x;
    if (G != 256) { moe_weights_range(p, 1, smem, tb, te, c, G); return; }
    const int x = c & 7, pw = c >> 3;
    int before = 0, total = 0, mine = -1;
    for (int xx = 0; xx < 8; ++xx) { const int Ux = 4 * ((MT - xx + 7) >> 3), hv = Ux > 64 ? (Ux - 64 < 32 ? Ux - 64 : 32) : 0;
        if (xx == x) mine = pw >= hv ? total + (pw - hv) : -1; total += 32 - hv; (void)before; }
    if (total == 0) { moe_weights_range(p, 1, smem, tb, te, c, G); return; }
    if (mine >= 0) moe_weights_range(p, 1, smem, tb, te, mine, total);
}
__device__ __forceinline__ void ph_vt(const Params& p) {
    const bf16_t* kvq = (const bf16_t*)(p.ws + KVQ);
    const int tix = ptid(), lane = tix & 63;
    const bool split = gridDim.x > 128; if (split && blockIdx.x < 64) return;
    const int nbl = split ? (int)gridDim.x - 64 : (int)gridDim.x, bl = split ? (int)blockIdx.x - 64 : (int)blockIdx.x;
    for (int it = (tix >> 6) * nbl + bl; it < 2048; it += nbl * (NT / 64)) {
        const int part = it >> 10, bg = (it >> 7) & 7, blk = it & 127, b = bg >> 2, g = bg & 3;
        const bf16_t* src = kvq + ((size_t)b * S_ + blk * 64 + lane) * KVQ_LD + (part ? 1280 : 768) + g * 64;
        const int kpos = (lane & ~31) + 8 * ((lane & 15) >> 2) + 4 * ((lane & 31) >> 4) + (lane & 3);
        bf16_t* dst = (bf16_t*)(p.ws + (part ? VWT : VST)) + (size_t)(bg * 128 + blk) * 4096 + kpos;
        u32x4 v[8];
#pragma unroll
        for (int c = 0; c < 8; ++c) v[c] = *(const u32x4*)(src + c * 8);
#pragma unroll
        for (int c = 0; c < 8; ++c)
#pragma unroll
            for (int e = 0; e < 4; ++e) { dst[(c * 8 + e * 2) * 64] = (bf16_t)(v[c][e] & 0xffffu); dst[(c * 8 + e * 2 + 1) * 64] = (bf16_t)(v[c][e] >> 16); }
    }
}
struct EpiCmp2 : EpiBase { const Params* p; int kv, bg, mt; int wn_; float nrm, mx;
    __device__ __forceinline__ void start(int, int wn, int, int) { wn_ = wn; nrm = 0.f; mx = 0.f; }
    __device__ __forceinline__ void operator()(int m, int n, f32x4 v) {
        if (wn_ != 0) return;
        const int row = mt * 256 + m;
        if (row == 511) v = (f32x4){0.f, 0.f, 0.f, 0.f};
        if (kv == 0) { *(u32x2*)((bf16_t*)(p->ws + KCMPB) + (size_t)(bg * 512 + row) * 64 + n) = (u32x2){pack2(v[0], v[1]), pack2(v[2], v[3])}; nrm += v[0] * v[0] + v[1] * v[1] + v[2] * v[2] + v[3] * v[3]; }
        else { const int rp = (row & ~31) + 8 * ((row & 15) >> 2) + 4 * ((row & 31) >> 4) + (row & 3);
            bf16_t* vt = (bf16_t*)(p->ws + VCMPT) + (size_t)(bg * 64 + n) * 512 + rp; vt[0] = f2bf(v[0]); vt[512] = f2bf(v[1]); vt[1024] = f2bf(v[2]); vt[1536] = f2bf(v[3]); }
    }
    __device__ __forceinline__ void row_done(int) { float r = nrm; r += __shfl_xor(r, 16); r += __shfl_xor(r, 32); mx = fmaxf(mx, r); nrm = 0.f; }
    __device__ __forceinline__ void finish() { if (kv == 0 && wn_ == 0) { const float m = wave_max(mx); if ((ptid() & 63) == 0) atomicMax((int*)(p->ws + MISC) + MI_KMAXC + bg, __float_as_int(sqrtf(m) * 1.01f + 1e-6f)); } }
};
__device__ __forceinline__ void ph_cmp2(const Params& p, unsigned char* smem) {
    for (int t = blockIdx.x; t < 32; t += gridDim.x) {
        const int mt = t & 1, bg = (t >> 1) & 7, kv = t >> 4;
        EpiCmp2 e{}; e.p = &p; e.kv = kv; e.bg = bg; e.mt = mt;
        gemm_tile((const bf16_t*)(p.ws + HC) + (size_t)((kv * 8 + bg) * 512 + mt * 256) * 256, 256, (const bf16_t*)(p.ws + WT_CW2) + (size_t)kv * 128 * 256, 256, 256, e, smem);
    }
}
__device__ __forceinline__ float quad_xor1(float v) { return __int_as_float(__builtin_amdgcn_mov_dpp(__float_as_int(v), 0xB1, 0xF, 0xF, true)); }
__device__ __forceinline__ float quad_xor2(float v) { return __int_as_float(__builtin_amdgcn_mov_dpp(__float_as_int(v), 0x4E, 0xF, 0xF, true)); }
__device__ __forceinline__ void lds_barrier() { asm volatile("s_waitcnt lgkmcnt(0)" ::: "memory"); __builtin_amdgcn_s_barrier(); asm volatile("" ::: "memory"); }
constexpr int KT_LD = 80;
constexpr int A2_BUF = 0, A2_BUFSZ = 2 * 64 * KT_LD * 2, A2_IMP = 4 * A2_BUFSZ, A2_TM = A2_IMP + 32768, A2_OR = A2_TM + 1024, A2_END = A2_OR + 16;
static_assert(A2_END <= LDS_BYTES - 16, "attention LDS");
constexpr float LOG2E = 1.4426950408889634f;
struct BlkSrc { const bf16_t* K; int ldk; const bf16_t* VT; int ldv; };
__device__ __forceinline__ int next_bit128(const unsigned (&m)[4], int j) {
    for (int k = j + 1; k < 128; ++k) if ((m[k >> 5] >> (k & 31)) & 1u) return k;
    return 128;
}
template <int BR> __device__ __forceinline__ void attn_branch(const Params& p, unsigned char* smem, const unsigned (&orm)[4], int bg, int cur, const float (&mrow)[2],
                                                               const float (&invl)[2], f32x4 (&Lacc)[2], f32x4 (&Oacc)[2][4], const bf16x8 (&Qs)[2][2]) {
    const int tid = ptid(), lane = tid & 63, w = __builtin_amdgcn_readfirstlane(tid >> 6), g = lane >> 4, i16 = lane & 15;
    const int b = bg >> 2, g4 = bg & 3;
    const bf16_t* kvq = (const bf16_t*)(p.ws + KVQ);
    float* imp = (float*)(smem + A2_IMP);
    const unsigned onew = i16 == 0 ? 0x3f803f80u : 0u; const bf16x8 onesf = __builtin_bit_cast(bf16x8, (u32x4){onew, onew, onew, onew});
    const int srow = tid >> 3, sch = tid & 7;
    auto src = [&](int j) -> BlkSrc {
        if (BR <= 1) return BlkSrc{(const bf16_t*)(p.ws + KCMPB) + (size_t)(bg * 512 + j * 64) * 64, 64, (const bf16_t*)(p.ws + VCMPT) + (size_t)bg * 64 * 512 + j * 64, 512};
        if (BR == 2) return BlkSrc{kvq + ((size_t)b * S_ + j * 64) * KVQ_LD + 512 + g4 * 64, KVQ_LD, (const bf16_t*)(p.ws + VST) + (size_t)(bg * 128 + j) * 4096, 64};
        return BlkSrc{kvq + ((size_t)b * S_ + j * 64) * KVQ_LD + 1024 + g4 * 64, KVQ_LD, (const bf16_t*)(p.ws + VWT) + (size_t)(bg * 128 + j) * 4096, 64};
    };
    u32x4 rk[2], rv[2];
    auto ld = [&](u32x4& rk, u32x4& rv, int j) { const BlkSrc s = src(j); rk = *(const u32x4*)(s.K + (size_t)srow * s.ldk + sch * 8); if (BR != 1) rv = *(const u32x4*)(s.VT + (size_t)srow * s.ldv + sch * 8); };
    auto st = [&](const u32x4& rk, const u32x4& rv, int bi) {
        bf16_t* buf = (bf16_t*)(smem + A2_BUF + bi * A2_BUFSZ);
        *(u32x4*)(buf + srow * KT_LD + sch * 8) = rk;
        if (BR != 1) *(u32x4*)(buf + 64 * KT_LD + srow * KT_LD + sch * 8) = rv;
    };
    auto process = [&](int j, int bi) {
        const bf16_t* Kt = (const bf16_t*)(smem + A2_BUF + bi * A2_BUFSZ); const bf16_t* Vt = Kt + 64 * KT_LD;
        bool need[2]; unsigned selb[2];
#pragma unroll
        for (int bt = 0; bt < 2; ++bt) { selb[bt] = BR == 2 ? ((((const unsigned*)(smem + A2_TM))[(8 * w + 4 * bt + (i16 >> 2)) * 4 + (j >> 5)] >> (j & 31)) & 1u) : 1u; need[bt] = BR == 2 ? (__ballot(selb[bt] != 0u) != 0ull) : true; }
        if (need[0] || need[1]) {
            bf16x8 Kf[4][2];
#pragma unroll
            for (int mt = 0; mt < 4; ++mt) { Kf[mt][0] = *(const bf16x8*)(Kt + (16 * mt + i16) * KT_LD + 8 * g); Kf[mt][1] = *(const bf16x8*)(Kt + (16 * mt + i16) * KT_LD + 32 + 8 * g); }
#pragma unroll
            for (int bt = 0; bt < 2; ++bt) {
                if (!need[bt]) continue;
                const int tq = 8 * w + 4 * bt + (i16 >> 2);
                const bf16x8 Qf0 = Qs[bt][0], Qf1 = Qs[bt][1];
                const float msel = selb[bt] != 0u ? mrow[bt] : __builtin_inff();
                f32x4 St[4];
                const bool edge = BR <= 1 ? (64 * j + 63 > ((64 * cur + 8 * w - 31) >> 4)) : (j == cur || (BR == 3 && j == cur - 8));
                if (!edge) {
                    const f32x4 sinit = {-msel, -msel, -msel, -msel};
#pragma unroll
                    for (int mt = 0; mt < 4; ++mt) St[mt] = __builtin_amdgcn_mfma_f32_16x16x32_bf16(Kf[mt][0], Qf0, sinit, 0, 0, 0);
#pragma unroll
                    for (int mt = 0; mt < 4; ++mt) St[mt] = __builtin_amdgcn_mfma_f32_16x16x32_bf16(Kf[mt][1], Qf1, St[mt], 0, 0, 0);
                } else {
                    int lo = 0, hi = 63;
                    if (BR <= 1) hi = ((64 * cur + tq - 31) >> 4) - 64 * j;
                    if (BR >= 2 && j == cur) hi = tq;
                    if (BR == 3 && j == cur - 8) lo = tq + 1;
                    const int k0 = 4 * g - lo, k1 = hi - 4 * g;
#pragma unroll
                    for (int mt = 0; mt < 4; ++mt)
#pragma unroll
                        for (int r = 0; r < 4; ++r) St[mt][r] = (16 * mt + r + k0 >= 0 && 16 * mt + r <= k1) ? -msel : -__builtin_inff();
#pragma unroll
                    for (int mt = 0; mt < 4; ++mt) St[mt] = __builtin_amdgcn_mfma_f32_16x16x32_bf16(Kf[mt][0], Qf0, St[mt], 0, 0, 0);
#pragma unroll
                    for (int mt = 0; mt < 4; ++mt) St[mt] = __builtin_amdgcn_mfma_f32_16x16x32_bf16(Kf[mt][1], Qf1, St[mt], 0, 0, 0);
                }
#pragma unroll
                for (int mt = 0; mt < 4; ++mt)
#pragma unroll
                    for (int r = 0; r < 4; ++r) St[mt][r] = __builtin_amdgcn_exp2f(St[mt][r]);
                if (BR == 1) {
#pragma unroll
                    for (int mt = 0; mt < 4; ++mt) {
                        float s4 = (St[mt][0] + St[mt][1] + St[mt][2] + St[mt][3]) * invl[bt], p3 = St[mt][3] * invl[bt];
                        s4 += quad_xor1(s4); s4 += quad_xor2(s4); p3 += quad_xor1(p3); p3 += quad_xor2(p3);
                        const int sb = 16 * j + 4 * mt + g;
                        if ((i16 & 3) == 0) { atomicAdd(&imp[tq * 128 + sb], s4); if (sb + 1 < 128) atomicAdd(&imp[tq * 128 + sb + 1], p3); }
                    }
                } else {
                    bf16x8 Vf[4][2];
#pragma unroll
                    for (int dt = 0; dt < 4; ++dt) { Vf[dt][0] = *(const bf16x8*)(Vt + (16 * dt + i16) * KT_LD + 8 * g); Vf[dt][1] = *(const bf16x8*)(Vt + (16 * dt + i16) * KT_LD + 32 + 8 * g); }
                    const bf16x8 Pf0 = pack_frag(St[0], St[1]), Pf1 = pack_frag(St[2], St[3]);
#pragma unroll
                    for (int dt = 0; dt < 4; ++dt) Oacc[bt][dt] = __builtin_amdgcn_mfma_f32_16x16x32_bf16(Vf[dt][0], Pf0, Oacc[bt][dt], 0, 0, 0);
#pragma unroll
                    for (int dt = 0; dt < 4; ++dt) Oacc[bt][dt] = __builtin_amdgcn_mfma_f32_16x16x32_bf16(Vf[dt][1], Pf1, Oacc[bt][dt], 0, 0, 0);
                    Lacc[bt] = __builtin_amdgcn_mfma_f32_16x16x32_bf16(onesf, Pf0, Lacc[bt], 0, 0, 0);
                    Lacc[bt] = __builtin_amdgcn_mfma_f32_16x16x32_bf16(onesf, Pf1, Lacc[bt], 0, 0, 0);
                }
            }
        }
    };
    int a0 = next_bit128(orm, -1);
    if (a0 >= 128) return;
    const int jsafe = a0;
    int b0 = next_bit128(orm, a0), a1 = b0 < 128 ? next_bit128(orm, b0) : 128, b1 = a1 < 128 ? next_bit128(orm, a1) : 128;
    ld(rk[0], rv[0], a0); ld(rk[1], rv[1], b0 < 128 ? b0 : jsafe);
    lds_barrier();
    st(rk[0], rv[0], 0); st(rk[1], rv[1], 1);
    ld(rk[0], rv[0], a1 < 128 ? a1 : jsafe); ld(rk[1], rv[1], b1 < 128 ? b1 : jsafe);
    lds_barrier();
    int sg = 0;
    for (;;) {
        const int a2 = b1 < 128 ? next_bit128(orm, b1) : 128, b2 = a2 < 128 ? next_bit128(orm, a2) : 128;
        process(a0, 2 * sg);
        st(rk[0], rv[0], 2 * (sg ^ 1)); st(rk[1], rv[1], 2 * (sg ^ 1) + 1);
        ld(rk[0], rv[0], a2 < 128 ? a2 : jsafe); ld(rk[1], rv[1], b2 < 128 ? b2 : jsafe);
        if (b0 < 128) process(b0, 2 * sg + 1);
        lds_barrier();
        if (a1 >= 128) break;
        a0 = a1; b0 = b1; a1 = a2; b1 = b2; sg ^= 1;
    }
}
__device__ __forceinline__ void ph_attn(const Params& p, unsigned char* smem) {
    const bf16_t* kvq = (const bf16_t*)(p.ws + KVQ); const float* gates = (const float*)(p.ws + GATES); const int* misc = (const int*)(p.ws + MISC);
    bf16_t* ao = (bf16_t*)(p.ws + ATTN_OUT);
    float* imp = (float*)(smem + A2_IMP); unsigned* tmask = (unsigned*)(smem + A2_TM); unsigned* tor = (unsigned*)(smem + A2_OR);
    const int tid = ptid(), lane = tid & 63, w = __builtin_amdgcn_readfirstlane(tid >> 6), g = lane >> 4, i16 = lane & 15;
    if (w >= 4) __builtin_amdgcn_s_setprio(1);
    for (int u = blockIdx.x; u < 1024; u += gridDim.x) {
        const int bg = u & 7, c5 = (u >> 3) & 31, kq = u >> 8;
        const int cur = kq == 0 ? c5 : (kq == 1 ? 63 - c5 : (kq == 2 ? 64 + c5 : 127 - c5));
        const int b = bg >> 2, g4 = bg & 3; const size_t tok0 = (size_t)b * S_ + cur * 64;
        bf16x8 Qf[2][2]; float qn[2];
        const int head = g4 * 4 + (i16 & 3);
#pragma unroll
        for (int bt = 0; bt < 2; ++bt) {
            const size_t tok = tok0 + 8 * w + 4 * bt + (i16 >> 2);
            const bf16_t* qp = kvq + tok * KVQ_LD + 1536 + head * 64 + 8 * g;
            Qf[bt][0] = *(const bf16x8*)qp; Qf[bt][1] = *(const bf16x8*)(qp + 32);
            float f[16]; unpack8(__builtin_bit_cast(u32x4, Qf[bt][0]), f); unpack8(__builtin_bit_cast(u32x4, Qf[bt][1]), f + 8);
            float s = 0.f;
#pragma unroll
            for (int k = 0; k < 16; ++k) s += f[k] * f[k];
            s += __shfl_xor(s, 16); s += __shfl_xor(s, 32);
            qn[bt] = sqrtf(s) * 1.01f + 1e-6f;
        }
        __syncthreads();
#pragma unroll
        for (int bt = 0; bt < 2; ++bt) {
            float f[16]; unpack8(__builtin_bit_cast(u32x4, Qf[bt][0]), f); unpack8(__builtin_bit_cast(u32x4, Qf[bt][1]), f + 8);
            u32x4 q0, q1;
#pragma unroll
            for (int k = 0; k < 4; ++k) { q0[k] = pack2(f[2 * k] * LOG2E, f[2 * k + 1] * LOG2E); q1[k] = pack2(f[8 + 2 * k] * LOG2E, f[9 + 2 * k] * LOG2E); }
            Qf[bt][0] = __builtin_bit_cast(bf16x8, q0); Qf[bt][1] = __builtin_bit_cast(bf16x8, q1); }
        for (int k = lane; k < 8 * 128; k += 64) imp[w * 8 * 128 + k] = 0.f;
        if (tid < 4) tor[tid] = 0u;
        f32x4 Oacc[2][4], Lacc[2] = {(f32x4){0.f, 0.f, 0.f, 0.f}, (f32x4){0.f, 0.f, 0.f, 0.f}}; float mrow[2], invl[2] = {0.f, 0.f};
#pragma unroll
        for (int bt = 0; bt < 2; ++bt) {
#pragma unroll
            for (int dt = 0; dt < 4; ++dt) Oacc[bt][dt] = (f32x4){0.f, 0.f, 0.f, 0.f};
        }
        auto norml = [&]() {
#pragma unroll
            for (int bt = 0; bt < 2; ++bt) { const float l = __shfl(Lacc[bt][0], i16); invl[bt] = l > 0.f ? 1.f / l : 0.f; Lacc[bt] = (f32x4){0.f, 0.f, 0.f, 0.f}; }
        };
        auto finish = [&](int c) {
#pragma unroll
            for (int bt = 0; bt < 2; ++bt) {
                const size_t tokc = tok0 + 8 * w + 4 * bt + (i16 >> 2);
                const float sc = gates[tokc * 48 + head * 3 + c] * invl[bt];
                u32x2* slot = (u32x2*)(smem + A2_IMP) + ((w * 2 + bt) * 4) * 64 + lane;
#pragma unroll
                for (int dt = 0; dt < 4; ++dt) { f32x4 o = Oacc[bt][dt] * sc;
                    if (c > 0) { const u32x2 q = slot[dt * 64]; o[0] += __uint_as_float(q[0] << 16); o[1] += __uint_as_float(q[0] & 0xffff0000u); o[2] += __uint_as_float(q[1] << 16); o[3] += __uint_as_float(q[1] & 0xffff0000u); }
                    const u32x2 r = {pack2(o[0], o[1]), pack2(o[2], o[3])};
                    if (c < 2) slot[dt * 64] = r; else *(u32x2*)(ao + tokc * 1024 + head * 64 + 4 * g + 16 * dt) = r;
                    Oacc[bt][dt] = (f32x4){0.f, 0.f, 0.f, 0.f}; }
            }
        };
        {
            const int nblk = min(8, (4 * cur + 2) / 64 + 1);
            unsigned orm[4] = {(1u << nblk) - 1u, 0u, 0u, 0u};
            const float kmx = __int_as_float(misc[MI_KMAXC + bg]);
            mrow[0] = qn[0] * kmx * LOG2E; mrow[1] = qn[1] * kmx * LOG2E;
            attn_branch<0>(p, smem, orm, bg, cur, mrow, invl, Lacc, Oacc, Qf);
            norml();
            attn_branch<1>(p, smem, orm, bg, cur, mrow, invl, Lacc, Oacc, Qf);
        }
        for (int k = 0; k < 8; k += 2) {
            unsigned ka[2][2]; unsigned T[2] = {0u, 0u};
#pragma unroll
            for (int u = 0; u < 2; ++u) {
                const int tl = w * 8 + k + u;
                { const int s = lane; const bool valid = s <= cur, forced = (s == 0) || (s == cur) || (s == cur - 1); ka[u][0] = valid ? __float_as_uint(imp[tl * 128 + s] + (forced ? 1000.f : 0.f)) + 1u : 0u; }
                { const int s = lane + 64; const bool valid = s <= cur, forced = (s == 0) || (s == cur) || (s == cur - 1); ka[u][1] = valid ? __float_as_uint(imp[tl * 128 + s] + (forced ? 1000.f : 0.f)) + 1u : 0u; }
            }
            bool ex[2] = {false, false};
#pragma unroll 1
            for (int bit = 30; bit >= 0; --bit) {
#pragma unroll
                for (int u = 0; u < 2; ++u) {
                    const unsigned cand = T[u] | (1u << bit);
                    const int cnt = __builtin_popcountll(__ballot(ka[u][0] >= cand)) + __builtin_popcountll(__ballot(ka[u][1] >= cand));
                    T[u] = cnt >= 16 ? cand : T[u]; ex[u] = ex[u] || cnt == 16;
                }
                if (ex[0] && ex[1]) break;
            }
#pragma unroll
            for (int u = 0; u < 2; ++u) {
                const int tl = w * 8 + k + u;
                unsigned long long s0 = __ballot(ka[u][0] > T[u]), s1 = __ballot(ka[u][1] > T[u]), e0 = __ballot(ka[u][0] == T[u]), e1 = __ballot(ka[u][1] == T[u]);
                int need = 16 - __builtin_popcountll(s0) - __builtin_popcountll(s1);
                while (need > 0 && e0) { const unsigned long long low = e0 & (~e0 + 1ull); s0 |= low; e0 ^= low; --need; }
                while (need > 0 && e1) { const unsigned long long low = e1 & (~e1 + 1ull); s1 |= low; e1 ^= low; --need; }
                const unsigned long long v0 = cur >= 63 ? ~0ull : ((1ull << (cur + 1)) - 1ull), v1 = cur >= 127 ? ~0ull : (cur >= 64 ? ((1ull << (cur - 63)) - 1ull) : 0ull);
                s0 &= v0; s1 &= v1;
                const unsigned m0 = (unsigned)s0, m1 = (unsigned)(s0 >> 32), m2 = (unsigned)s1, m3 = (unsigned)(s1 >> 32);
                if (lane == 0) { tmask[tl * 4] = m0; tmask[tl * 4 + 1] = m1; tmask[tl * 4 + 2] = m2; tmask[tl * 4 + 3] = m3; atomicOr(&tor[0], m0); atomicOr(&tor[1], m1); atomicOr(&tor[2], m2); atomicOr(&tor[3], m3); }
            }
        }
        __syncthreads();
        finish(0);
        {
            unsigned orm[4];
#pragma unroll
            for (int k = 0; k < 4; ++k) orm[k] = __builtin_amdgcn_readfirstlane(tor[k]);
            const float kmx = sqrtf(__int_as_float(misc[MI_KMAX + ((1 * 2 + b) * 4 + g4) * 2]) + __int_as_float(misc[MI_KMAX + ((1 * 2 + b) * 4 + g4) * 2 + 1])) * 1.01f + 1e-6f;
            mrow[0] = qn[0] * kmx * LOG2E; mrow[1] = qn[1] * kmx * LOG2E;
            attn_branch<2>(p, smem, orm, bg, cur, mrow, invl, Lacc, Oacc, Qf);
            norml(); finish(1);
        }
        {
            unsigned orm[4] = {0u, 0u, 0u, 0u};
            for (int jj = max(0, cur - 8); jj <= cur; ++jj) orm[jj >> 5] |= 1u << (jj & 31);
            const float kmx = sqrtf(__int_as_float(misc[MI_KMAX + ((2 * 2 + b) * 4 + g4) * 2]) + __int_as_float(misc[MI_KMAX + ((2 * 2 + b) * 4 + g4) * 2 + 1])) * 1.01f + 1e-6f;
            mrow[0] = qn[0] * kmx * LOG2E; mrow[1] = qn[1] * kmx * LOG2E;
            attn_branch<3>(p, smem, orm, bg, cur, mrow, invl, Lacc, Oacc, Qf);
            norml(); finish(2);
        }
    }
    __builtin_amdgcn_s_setprio(0);
}

struct EpiGeluBias : EpiBase { bf16_t* C; int ldc; const float* bias;
    __device__ __forceinline__ void operator()(int m, int n, f32x4 v) const {
        float y[4];
#pragma unroll
        for (int i = 0; i < 4; ++i) { const float x = v[i] + bias[n + i]; const float u2 = 1.5957691216057308f * (x + 0.044715f * x * x * x); y[i] = x / (1.f + __expf(-u2)); }
        *(u32x2*)(C + (size_t)m * ldc + n) = (u32x2){pack2(y[0], y[1]), pack2(y[2], y[3])}; } };
__device__ __forceinline__ void ph_cmp_gemm(const Params& p, unsigned char* smem) {
    const bf16_t* kvq = (const bf16_t*)(p.ws + KVQ); const float* pew = (const float*)(p.ws + MISC) + MI_PEW;
    for (int t = blockIdx.x; t < 64; t += gridDim.x) {
        const int nt = t & 1, mt = (t >> 1) & 1, bg = (t >> 2) & 7, kv = t >> 5, b = bg >> 2, g = bg & 3;
        const bf16_t* A = kvq + ((size_t)b * S_ + 16 * (mt * 256)) * KVQ_LD + kv * 256 + g * 64;
        const bf16_t* Bt = (const bf16_t*)(p.ws + WT_CW1) + (size_t)(kv * 256 + nt * 128) * 2048;
        bf16_t* C = (bf16_t*)(p.ws + HC) + (size_t)((kv * 8 + bg) * 512 + mt * 256) * 256 + nt * 128;
        gemm_tile(A, 16 * KVQ_LD, Bt, 2048, 2048, EpiGeluBias{{}, C, 256, pew + kv * 256 + nt * 128}, smem, KVQ_LD);
    }
}

#define XB_TMO      128
#define XB_XCNT(j)  (256  + 64 * (j))
#define XB_XSUB(j)  (1280 + 64 * (j))
#define XB_XGEN(j)  (2304 + 64 * (j))
#define XB_TOP      3328
#define XB_TOPGEN   3392
#define XCD_BAR_WORDS 3456
#define XB_SPIN_CAP (1u << 20)
#define LAS __attribute__((address_space(3)))
__device__ __forceinline__ unsigned xb_ld(unsigned* p) { return __hip_atomic_load(p, __ATOMIC_RELAXED, __HIP_MEMORY_SCOPE_AGENT); }
__device__ __forceinline__ unsigned xb_add(unsigned* p, unsigned v) { return __hip_atomic_fetch_add(p, v, __ATOMIC_RELAXED, __HIP_MEMORY_SCOPE_AGENT); }
__device__ __forceinline__ unsigned xb_xcc_id() { return (unsigned)__builtin_amdgcn_s_getreg((3 << 11) | 20) & 0xFu; }
#define XB_SPIN(cond, bar) do { unsigned _sp = 0; while (cond) { __builtin_amdgcn_s_sleep(1); \
    if ((++_sp & 255u) == 0u) { if (xb_ld(&(bar)[XB_TMO])) break; if (_sp > XB_SPIN_CAP) { atomicAdd(&(bar)[XB_TMO], 1u); break; } } } } while (0)
struct XcdBarrier { unsigned* bar; unsigned x; volatile LAS unsigned* st; };
__device__ __forceinline__ XcdBarrier xcd_barrier_post(unsigned* bar, volatile LAS unsigned* st) {
    XcdBarrier b; b.bar = bar; b.x = xb_xcc_id(); b.st = st;
    if (threadIdx.x == 0) (void)xb_add(&bar[XB_XCNT(b.x)], 1u);
    return b;
}
__device__ __forceinline__ void xcd_barrier_complete(unsigned* bar, unsigned x, unsigned& nloc, unsigned& nx) {
    const unsigned G = gridDim.x * gridDim.y * gridDim.z;
    unsigned sum, cnt, mine, sp = 0u;
    for (;;) {
        sum = 0u; cnt = 0u; mine = 0u;
#pragma unroll
        for (unsigned j = 0; j < 16; ++j) { const unsigned c = xb_ld(&bar[XB_XCNT(j)]); sum += c; cnt += (c > 0u) ? 1u : 0u; mine = (j == x) ? c : mine; }
        if (sum == G) break;
        __builtin_amdgcn_s_sleep(1);
        if ((++sp & 255u) == 0u) { if (xb_ld(&bar[XB_TMO])) break; if (sp > XB_SPIN_CAP) { atomicAdd(&bar[XB_TMO], 1u); break; } }
    }
    nloc = mine > 0u ? mine : 1u; nx = cnt > 0u ? cnt : 1u;
}
__device__ __forceinline__ void xcd_barrier(const XcdBarrier& b) {
    asm volatile("s_waitcnt vmcnt(0)" ::: "memory");
    __syncthreads();
    if (threadIdx.x == 0) {
        unsigned* bar = b.bar;
        __builtin_amdgcn_s_waitcnt(0);
        unsigned nloc = b.st[0], nx = b.st[1];
        if (nloc == 0u) { xcd_barrier_complete(bar, b.x, nloc, nx); b.st[0] = nloc; b.st[1] = nx; }
        const unsigned old = xb_add(&bar[XB_XSUB(b.x)], 1u);
        const unsigned gen = old / nloc;
        if (old + 1u == (gen + 1u) * nloc) {
            __builtin_amdgcn_fence(__ATOMIC_RELEASE, "agent");
            asm volatile("s_waitcnt vmcnt(0)" ::: "memory");
            const unsigned og = xb_add(&bar[XB_TOP], 1u);
            const unsigned tg = og / nx;
            if (og + 1u == (tg + 1u) * nx) xb_add(&bar[XB_TOPGEN], 1u);
            else XB_SPIN(xb_ld(&bar[XB_TOPGEN]) == tg, bar);
            __builtin_amdgcn_fence(__ATOMIC_ACQUIRE, "agent");
            xb_add(&bar[XB_XGEN(b.x)], 1u);
            asm volatile("s_waitcnt vmcnt(0)" ::: "memory");
        } else {
            XB_SPIN(xb_ld(&bar[XB_XGEN(b.x)]) == gen, bar);
            __builtin_amdgcn_fence(__ATOMIC_ACQUIRE, "agent");
            asm volatile("s_waitcnt vmcnt(0)" ::: "memory");
        }
    }
    __syncthreads();
}
__global__ void __launch_bounds__(NT) fwd_kernel(Params p) {
    cg::grid_group grid = cg::this_grid();
    extern __shared__ __attribute__((aligned(16))) unsigned char smem[];
    float* hf = (float*)(p.ws + H_F32); bf16_t* hb = (bf16_t*)(p.ws + H_BF);
    volatile LAS unsigned* xst = (volatile LAS unsigned*)(smem + LDS_BYTES - 16);
    if (threadIdx.x == 0) { xst[0] = 0u; xst[1] = 0u; }
    __syncthreads();
    const XcdBarrier xb = xcd_barrier_post((unsigned*)(p.ws + BAR_OFF), xst);
    ph_prep0(p, smem); ph_moe_weights(p, 0, smem);
    grid.sync();
    PHASE(1, ph_gemm_retin8(p, smem));
    PHASE(2, ph_ret_state(p, smem));
    PHASE(3, ph_ret_scan(p, smem));
    PHASE(4, ph_gnorm_gate(p));
    PHASE(5, ph_gemm_f32_8((const bf16_t*)p.out, (const bf16_t*)(p.ws + WT_OUT), hf, 1024, 2048, smem));
    PHASE(6, (ph_ln<false, true, false, false>(p, p.x, hf, hf, hb, p.ln_mix_g, p.ln_mix_b, 0, smem)));
    constexpr int MW_T1 = 3100, MW_T2 = 5200;
    PHASE(7, (ph_moe_up8(p, 0, smem), moe_tail_convert(p, 0, smem, 0, MW_T1)));
    PHASE(8, (ph_moe_down8(p, 0, smem), moe_tail_convert(p, 0, smem, MW_T1, MW_T2)));
    PHASE(9, (ph_ln<true, false, false, true>(p, (const float*)hb, nullptr, hf, hb, p.ln_ffn_g, p.ln_ffn_b, 0, smem), ph_prep1(p, smem)));
    const int G_ = (int)gridDim.x, c_ = (int)blockIdx.x;
    PHASE(10, (ph_gemm_kvq8(p, smem), [&] { const int rem = ((T_ / 256) * (KVQ_N / 256)) % G_; if (rem == 0) moe_weights_range(p, 1, smem, MW_T2, MOEW_TILES, c_, G_); else if (c_ >= rem) moe_weights_range(p, 1, smem, MW_T2, MOEW_TILES, c_ - rem, G_ - rem); }()));
    PHASE(11, (ph_vt(p), ph_cmp_gemm(p, smem)));
    PHASE(12, ph_cmp2(p, smem));
    PHASE(13, ph_attn(p, smem));
    PHASE(14, ph_gemm_f32_8((const bf16_t*)(p.ws + ATTN_OUT), (const bf16_t*)(p.ws + WT_NSAOUT), (float*)(p.ws + MIX2), 1024, 1024, smem));
    PHASE(15, (ph_ln<false, true, false, true>(p, (const float*)hb, (const float*)(p.ws + MIX2), hf, hb, p.ln_mix_g + 1024, p.ln_mix_b + 1024, 1, smem)));
    PHASE(16, ph_moe_up8(p, 1, smem));
    PHASE(17, ph_moe_down8(p, 1, smem));
    ph_ln<true, false, true, true>(p, (const float*)hb, nullptr, p.out, nullptr, p.ln_ffn_g + 1024, p.ln_ffn_b + 1024, 1, smem);
}

extern "C" void kernel_launch(void* const* d_in, const int* in_sizes, int n_in, void* d_out, int out_size, void* d_ws, size_t ws_size, hipStream_t stream) {
    (void)in_sizes; (void)n_in; (void)out_size;
    if (ws_size < WS_NEEDED) { fprintf(stderr, "workspace too small: %zu < %zu\n", ws_size, (size_t)WS_NEEDED); return; }
    static int grid_blocks = 0;
    if (!grid_blocks) {
        int dev = 0, cus = 0, per_cu = 0;
        (void)hipGetDevice(&dev);
        (void)hipDeviceGetAttribute(&cus, hipDeviceAttributeMultiprocessorCount, dev);
        (void)hipFuncSetAttribute((const void*)fwd_kernel, hipFuncAttributeMaxDynamicSharedMemorySize, LDS_BYTES);
        (void)hipOccupancyMaxActiveBlocksPerMultiprocessor(&per_cu, fwd_kernel, NT, LDS_BYTES);
        if (per_cu > 1) per_cu = 1;
        grid_blocks = cus * per_cu;
    }
    Params p{};
    const float** pp = (const float**)&p;
    for (int i = 0; i < 21; ++i) pp[i] = (const float*)d_in[i];
    p.out = (float*)d_out; p.ws = (unsigned char*)d_ws;
    (void)hipMemsetAsync((unsigned char*)d_ws + BAR_OFF, 0, CTL_ZERO_BYTES, stream);
    void* args[] = {&p};
    hipError_t e = hipLaunchCooperativeKernel((void*)fwd_kernel, dim3(grid_blocks), dim3(NT), args, LDS_BYTES, stream);
    if (e != hipSuccess) fprintf(stderr, "cooperative launch failed: %s (grid %d)\n", hipGetErrorString(e), grid_blocks);
}
```

```cpp
#include <hip/hip_runtime.h>
#include <hip/hip_cooperative_groups.h>
#include <cstdio>
#include <cstdint>
namespace cg = cooperative_groups;

typedef unsigned short bf16_t;
typedef short bf16x8 __attribute__((ext_vector_type(8)));
typedef float f32x4 __attribute__((ext_vector_type(4)));
typedef unsigned u32x4 __attribute__((ext_vector_type(4)));
typedef unsigned u32x2 __attribute__((ext_vector_type(2)));

#define NT 512
#ifndef PROBEMASK
#define PROBEMASK 0u
#endif
#define PROBE_W 3ull
#define PROBE_ON(id) ((PROBEMASK >> (id)) & 1u)
#define PHASE(id, ...) do { const unsigned long long _t0 = PROBE_ON(id) ? __builtin_amdgcn_s_memrealtime() : 0ull; __VA_ARGS__; xcd_barrier(xb); \
    if (PROBE_ON(id)) { const unsigned long long _t1 = __builtin_amdgcn_s_memrealtime(), _end = _t1 + PROBE_W * (_t1 - _t0); while (__builtin_amdgcn_s_memrealtime() < _end) __builtin_amdgcn_s_sleep(8); } } while (0)
constexpr int LDS_BYTES = 144 * 1024;
constexpr int T_ = 16384, D_ = 1024, S_ = 8192;
constexpr size_t MiB = 1u << 20;
constexpr size_t XB = 0, WT_IN = 32 * MiB, QB = 44 * MiB, KB = 76 * MiB, VB = 108 * MiB, GB = 172 * MiB;
constexpr size_t WT_OUT = 246 * MiB, MOEW_GU = 250 * MiB, MOEW_D = 282 * MiB;
constexpr size_t H_F32 = 0, H_BF = 64 * MiB, YEXP = 96 * MiB, XS = 172 * MiB, MISC = 244 * MiB;
constexpr size_t WT_KVQ = 236 * MiB, WT_NSAOUT = 242 * MiB;
constexpr size_t KVQ = 96 * MiB, GATES = 180 * MiB, HC = 183 * MiB, KCMPB = 187 * MiB, VCMPT = 187 * MiB + 512 * 1024, VST = 188 * MiB, VWT = 196 * MiB, ATTN_OUT = 204 * MiB, WT_CW1 = 246 * MiB, WT_CW2 = 248 * MiB;
constexpr size_t MIX2 = 96 * MiB;
constexpr size_t MOEW1_GU = 0, MOEW1_D = 32 * MiB;
constexpr size_t RET_L = 0;
constexpr size_t WS_NEEDED = 298 * MiB;
constexpr size_t MOE_INV = 168 * MiB;
constexpr size_t ROPE_RT = 236 * MiB, ROPE_NT = 232 * MiB;
constexpr int KVQ_LD = 2688, KVQ_N = 2816;
constexpr size_t BAR_OFF = 245 * MiB;
constexpr size_t CNT_OFF = BAR_OFF + 16384;
constexpr int CTL_ZERO_BYTES = 16384 + 32 * 256;
constexpr int MI_KMAX = 64, MI_KMAXC = 120, MI_PEW = 512;
constexpr int MI_CNT = 0, MI_TE = 1024, MI_TW = MI_TE + 32768, MI_TI = MI_TW + 32768, MI_TR = MI_TI + 32768;

struct Params {
    const float *x, *ret_w_in, *ret_w_out, *nsa_w_kv, *pe_k, *pe_v, *ck_w1, *ck_w2, *cv_w1, *cv_w2, *nsa_w_in, *nsa_w_out,
        *router_w, *router_b, *moe_wg, *moe_wu, *moe_wd, *ln_mix_g, *ln_mix_b, *ln_ffn_g, *ln_ffn_b;
    float* out; unsigned char* ws;
};

__device__ __forceinline__ bf16_t f2bf(float f) { unsigned u = __float_as_uint(f); u += 0x7fffu + ((u >> 16) & 1u); return (bf16_t)(u >> 16); }
__device__ __forceinline__ float bf2f(bf16_t h) { return __uint_as_float(((unsigned)h) << 16); }
typedef float f32x2 __attribute__((ext_vector_type(2)));
typedef __bf16 bf16x2_t __attribute__((ext_vector_type(2)));
__device__ __forceinline__ unsigned pack2(float a, float b) { const f32x2 v = {a, b}; return __builtin_bit_cast(unsigned, __builtin_convertvector(v, bf16x2_t)); }
__device__ __forceinline__ float lo2f(unsigned u) { return __uint_as_float(u << 16); }
__device__ __forceinline__ float hi2f(unsigned u) { return __uint_as_float(u & 0xffff0000u); }
__device__ __forceinline__ float wave_sum(float v) {
#pragma unroll
    for (int o = 32; o > 0; o >>= 1) v += __shfl_xor(v, o);
    return v;
}
__device__ __forceinline__ float wave_max(float v) {
#pragma unroll
    for (int o = 32; o > 0; o >>= 1) v = fmaxf(v, __shfl_xor(v, o));
    return v;
}
__device__ __forceinline__ int ptid() { int t = threadIdx.x; asm volatile("" : "+v"(t)); return t; }
__device__ __forceinline__ int gtid() { return blockIdx.x * NT + ptid(); }
__device__ __forceinline__ int gthreads() { return gridDim.x * NT; }
__device__ __forceinline__ int gwave() { return (ptid() >> 6) * gridDim.x + blockIdx.x; }
__device__ __forceinline__ int gwaves() { return gridDim.x * (NT / 64); }
__device__ __forceinline__ void unpack8(u32x4 u, float* f) {
    f[0] = lo2f(u.x); f[1] = hi2f(u.x); f[2] = lo2f(u.y); f[3] = hi2f(u.y); f[4] = lo2f(u.z); f[5] = hi2f(u.z); f[6] = lo2f(u.w); f[7] = hi2f(u.w);
}

template <class F> __device__ __forceinline__ void transpose_conv_tiles(F src, bf16_t* dst, int K, float* tile, int tb, int te, int rank, int nranks) {
    const int tilesK = K >> 6, tix = ptid();
    for (int t = tb + rank; t < te; t += nranks) {
        const int n0 = (t / tilesK) << 6, k0 = (t % tilesK) << 6;
#pragma unroll
        for (int i = 0; i < 8; ++i) { const int idx = tix + i * NT, kk = idx >> 6, r = idx & 63; tile[kk * 65 + r] = src(k0 + kk, n0 + r); }
        __syncthreads();
        {   const int r = tix >> 3, kk0 = (tix & 7) * 8; float f[8];
#pragma unroll
            for (int j = 0; j < 8; ++j) f[j] = tile[(kk0 + j) * 65 + r];
            *(u32x4*)(dst + (size_t)(n0 + r) * K + k0 + kk0) = (u32x4){pack2(f[0], f[1]), pack2(f[2], f[3]), pack2(f[4], f[5]), pack2(f[6], f[7])}; }
        __syncthreads();
    }
}
template <class F> __device__ __forceinline__ void transpose_conv(F src, bf16_t* dst, int K, int N, float* tile) { transpose_conv_tiles(src, dst, K, tile, 0, (N >> 6) * (K >> 6), (int)blockIdx.x, (int)gridDim.x); }

template <class Epi> __device__ __forceinline__ void gemm_tile_rows(const bf16_t* const (&ap)[4], const bf16_t* __restrict__ Bt, int ldb, int K, Epi epi, unsigned char* smem, int akstride = 64) {
    const int tid = ptid(), lane = tid & 63, wid = tid >> 6, wm = wid >> 1, wn = wid & 1, fr = lane & 15, fq = lane >> 4;
    bf16_t* As = (bf16_t*)smem;
    bf16_t* Bs = As + 256 * 72;
    f32x4 acc[4][4];
#pragma unroll
    for (int i = 0; i < 4; ++i)
#pragma unroll
        for (int j = 0; j < 4; ++j) acc[i][j] = (f32x4){0.f, 0.f, 0.f, 0.f};
    u32x4 ra[4], rb[2];
    const int lrow = tid >> 3, lkc = tid & 7;
    const bf16_t* bg = Bt + (size_t)lrow * ldb + lkc * 8;
#pragma unroll
    for (int i = 0; i < 4; ++i) ra[i] = *(const u32x4*)(ap[i]);
#pragma unroll
    for (int i = 0; i < 2; ++i) rb[i] = *(const u32x4*)(bg + (size_t)i * 64 * ldb);
    const int nk = K >> 6;
    for (int kt = 0; kt < nk; ++kt) {
#pragma unroll
        for (int i = 0; i < 4; ++i) *(u32x4*)(As + (lrow + i * 64) * 72 + lkc * 8) = ra[i];
#pragma unroll
        for (int i = 0; i < 2; ++i) *(u32x4*)(Bs + (lrow + i * 64) * 72 + lkc * 8) = rb[i];
        __syncthreads();
        if (kt + 1 < nk) {
            const int k0 = (kt + 1) << 6; const size_t ka = (size_t)(kt + 1) * akstride;
#pragma unroll
            for (int i = 0; i < 4; ++i) ra[i] = *(const u32x4*)(ap[i] + ka);
#pragma unroll
            for (int i = 0; i < 2; ++i) rb[i] = *(const u32x4*)(bg + (size_t)i * 64 * ldb + k0);
        }
#pragma unroll
        for (int s = 0; s < 2; ++s) {
            bf16x8 af[4], bfr[4];
#pragma unroll
            for (int i = 0; i < 4; ++i) af[i] = *(const bf16x8*)(As + (wm * 64 + i * 16 + fr) * 72 + s * 32 + fq * 8);
#pragma unroll
            for (int j = 0; j < 4; ++j) bfr[j] = *(const bf16x8*)(Bs + (wn * 64 + j * 16 + fr) * 72 + s * 32 + fq * 8);
#pragma unroll
            for (int i = 0; i < 4; ++i)
#pragma unroll
                for (int j = 0; j < 4; ++j) acc[i][j] = __builtin_amdgcn_mfma_f32_16x16x32_bf16(bfr[j], af[i], acc[i][j], 0, 0, 0);
        }
        __syncthreads();
    }
    epi.start(wm, wn, fr, fq);
#pragma unroll
    for (int i = 0; i < 4; ++i) {
#pragma unroll
        for (int j = 0; j < 4; ++j) epi(wm * 64 + i * 16 + fr, wn * 64 + j * 16 + fq * 4, acc[i][j]);
        epi.row_done(i);
    }
    epi.finish();
}
template <class Epi> __device__ __forceinline__ void gemm_tile(const bf16_t* __restrict__ A, int lda, const bf16_t* __restrict__ Bt, int ldb, int K, const Epi& epi, unsigned char* smem, int akstride = 64) {
    const bf16_t* ap[4]; const int tix = ptid();
#pragma unroll
    for (int i = 0; i < 4; ++i) ap[i] = A + (size_t)((tix >> 3) + 64 * i) * lda + (tix & 7) * 8;
    gemm_tile_rows(ap, Bt, ldb, K, epi, smem, akstride);
}

struct EpiBase { __device__ __forceinline__ void start(int, int, int, int) {} __device__ __forceinline__ void row_done(int) {} __device__ __forceinline__ void finish() {} };
struct EpiBf16 : EpiBase { bf16_t* C; int ldc;
    __device__ __forceinline__ void operator()(int m, int n, f32x4 v) const { *(uint2*)(C + (size_t)m * ldc + n) = make_uint2(pack2(v[0], v[1]), pack2(v[2], v[3])); } };
struct EpiF32 : EpiBase { float* C; int ldc;
    __device__ __forceinline__ void operator()(int m, int n, f32x4 v) const { *(float4*)(C + (size_t)m * ldc + n) = make_float4(v[0], v[1], v[2], v[3]); } };
struct EpiSwiglu : EpiBase { bf16_t* C; int ldc;
    __device__ __forceinline__ void operator()(int m, int n, f32x4 v) const {
        const float a0 = v[0] / (1.f + __expf(-v[0])) * v[1], a1 = v[2] / (1.f + __expf(-v[2])) * v[3];
        *(unsigned*)(C + (size_t)m * ldc + (n >> 1)) = pack2(a0, a1); } };

namespace pg8 {
#define PG8_LAS __attribute__((address_space(3)))
typedef unsigned short bf16_t;
typedef short bf16x8 __attribute__((ext_vector_type(8)));
typedef float f32x4 __attribute__((ext_vector_type(4)));
typedef unsigned u32x4 __attribute__((ext_vector_type(4)));
constexpr int BM = 256, BK = 64, HALF = 128, HTB = HALF * BK * 2  , STAGE_BYTES = 8 * HTB, NXCD = 8, WGM = 8;

__host__ __device__ __forceinline__ int lds_byte(int r, int c) { const int st = (r >> 4) * 2 + (c >> 5), rr = r & 15, cc = c & 31, ob = rr * 64 + cc * 2; return st * 1024 + (ob ^ (((ob >> 9) & 1) << 5)); }
__host__ __device__ __forceinline__ void stage_rc(int b, int& R, int& C) { const int st = b / 1024, sb = b % 1024, swz = sb ^ (((sb >> 9) & 1) << 5); R = (st >> 1) * 16 + swz / 64; C = (st & 1) * 32 + (swz % 64) / 2; }
__host__ __device__ __forceinline__ int perm32(int rho) { const int n = rho >> 4, i = rho & 15; return 8 * (i >> 2) + 4 * n + (i & 3); }

struct Unit { int pm, pn; };
struct Gemm { const bf16_t* A; const bf16_t* Bt; int M, N, K; };

struct StaticOrder {
    int nM, nN, nwg, G, c;
    __host__ __device__ void init(int M, int N, int G_, int c_) { nM = M / BM; nN = N / BM; nwg = nM * nN; G = G_; c = c_; }
    __host__ __device__ bool next(int i, Unit& u) const {
        const long L = (long)i * G + c; if (L >= nwg) return false;
        int wgid = (int)L; { const int q = nwg / NXCD, r = nwg % NXCD, xcd = wgid % NXCD, off = wgid / NXCD; wgid = (xcd < r ? xcd * (q + 1) : r * (q + 1) + (xcd - r) * q) + off; }
        const int nig = WGM * nN, gid = wgid / nig, fm = gid * WGM, gsz = (nM - fm) < WGM ? (nM - fm) : WGM;
        u.pm = fm + ((wgid % nig) % gsz); u.pn = (wgid % nig) / gsz; return true;
    }
    __device__ __forceinline__ void a_ready(const Unit&) const {}
    __device__ __forceinline__ void done(const Unit&) const {}
};


template <class Epi, class Sched, bool ALIGN_EPI = false, bool SP2 = false, bool GATHER = false>
__device__ __forceinline__ void gemm_phase(PG8_LAS unsigned char* lds, const Gemm g, const Sched& S, const Epi& E) {
    const int tid = ptid(), wid = __builtin_amdgcn_readfirstlane(tid >> 6), lane = tid & 63, wr = wid >> 2, wc = wid & 3, fr = lane & 15, fq = lane >> 4;
    const int K = g.K, nt = K / BK;
    unsigned voffA[2], voffB[2];
#pragma unroll
    for (int i = 0; i < 2; ++i) { int R, C; stage_rc(tid * 16 + i * 8192, R, C); const int Rb = Epi::PERM ? ((R & ~31) + perm32(R & 31)) : R;
        voffA[i] = (unsigned)(R * K + C) * 2u; voffB[i] = (unsigned)(Rb * K + C) * 2u; }
    const size_t kstep = (size_t)(BK * 2);
    const size_t hstep = (size_t)HALF * K * 2;
    const size_t tstep = 2 * hstep;
    const size_t hstepA = GATHER ? 0 : hstep, tstepA = GATHER ? 0 : tstep;
    int gR[2], gC[2];
#pragma unroll
    for (int i = 0; i < 2; ++i) stage_rc(tid * 16 + i * 8192, gR[i], gC[i]);
    unsigned vgc[2][2], vgn[2][2], vgs[2][2];
    auto gath = [&](const Unit& u, unsigned (&v)[2][2]) {
        if constexpr (GATHER) {
#pragma unroll
            for (int h = 0; h < 2; ++h)
#pragma unroll
                for (int i = 0; i < 2; ++i) v[h][i] = (unsigned)(S.rowidx(u, 128 * h + gR[i]) * K + gC[i]) * 2u;
        }
    };
    const unsigned ldsw = (unsigned)wid * 1024u;
    const int aoff = lds_byte(wr * 64 + fr, fq * 8), boff = lds_byte(wc * 32 + fr, fq * 8);
#define PG8_SA(b, h) (((b) * 2 + (h)) * HTB)
#define PG8_SB(b, h) ((4 + (b) * 2 + (h)) * HTB)
#define PG8_STAGE(bufoff, gbase, voff) do { _Pragma("unroll") for (int _i = 0; _i < 2; ++_i) \
        __builtin_amdgcn_global_load_lds((const unsigned*)((const char*)(gbase) + (voff)[_i]), (PG8_LAS unsigned*)(lds + (bufoff) + ldsw + _i * 8192), 16, 0, 0); } while (0)
#define PG8_STAGE_A(bufoff, gbase, VG, h) do { if constexpr (GATHER) PG8_STAGE(bufoff, gbase, (VG)[h]); else PG8_STAGE(bufoff, gbase, voffA); } while (0)
#define PG8_LDA(dst, b, h) do { _Pragma("unroll") for (int m = 0; m < 4; ++m) _Pragma("unroll") for (int k = 0; k < 2; ++k) dst[m][k] = *(const PG8_LAS bf16x8*)(lds + PG8_SA(b, h) + aoff + m * 2048 + k * 1024); } while (0)
#define PG8_LDB(dst, b, h) do { _Pragma("unroll") for (int n = 0; n < 2; ++n) _Pragma("unroll") for (int k = 0; k < 2; ++k) dst[n][k] = *(const PG8_LAS bf16x8*)(lds + PG8_SB(b, h) + boff + n * 2048 + k * 1024); } while (0)
#define PG8_MMA(ai, bj, At, Bt) do { __builtin_amdgcn_s_setprio(1); _Pragma("unroll") for (int m = 0; m < 4; ++m) _Pragma("unroll") for (int n = 0; n < 2; ++n) _Pragma("unroll") for (int k = 0; k < 2; ++k) \
        acc[ai][bj][m][n] = __builtin_amdgcn_mfma_f32_16x16x32_bf16(Bt[n][k], At[m][k], acc[ai][bj][m][n], 0, 0, 0); __builtin_amdgcn_s_setprio(0); } while (0)
#define PG8_WAIT_V(n) asm volatile("s_waitcnt vmcnt(" #n ")" ::: "memory")
#define PG8_WAIT_L(n) asm volatile("s_waitcnt lgkmcnt(" #n ")" ::: "memory")
#define PG8_BAR __builtin_amdgcn_s_barrier()
#define PG8_SCHED __builtin_amdgcn_sched_barrier(0)
    Unit cur, nxt; int ui = 0;
    if (!S.next(0, cur)) return;
    f32x4 acc[2][2][4][2];
#pragma unroll
    for (int a = 0; a < 2; ++a)
#pragma unroll
        for (int b = 0; b < 2; ++b)
#pragma unroll
            for (int m = 0; m < 4; ++m)
#pragma unroll
                for (int n = 0; n < 2; ++n) acc[a][b][m][n] = (f32x4){0.f, 0.f, 0.f, 0.f};
    bf16x8 At[4][2], B0[2][2], B1[2][2];
    const char* cA = (const char*)g.A + (size_t)cur.pm * tstepA; gath(cur, vgc); const char* cB = (const char*)g.Bt + (size_t)cur.pn * tstep;
    S.a_ready(cur);
    if constexpr (SP2) {
        PG8_STAGE(PG8_SB(0, 0), cB, voffB); PG8_STAGE(PG8_SB(0, 1), cB + hstep, voffB); PG8_STAGE_A(PG8_SA(0, 0), cA, vgc, 0); PG8_STAGE_A(PG8_SA(0, 1), cA + hstepA, vgc, 1);
        if (wr == 1) PG8_BAR;
        PG8_WAIT_V(2); PG8_BAR;
        PG8_STAGE(PG8_SB(1, 0), cB + kstep, voffB); PG8_STAGE_A(PG8_SA(1, 0), cA + kstep, vgc, 0); PG8_STAGE(PG8_SB(1, 1), cB + hstep + kstep, voffB);
        PG8_WAIT_V(6); PG8_BAR;
    } else {
        PG8_STAGE(PG8_SB(0, 0), cB, voffB); PG8_STAGE_A(PG8_SA(0, 0), cA, vgc, 0); PG8_STAGE(PG8_SB(0, 1), cB + hstep, voffB); PG8_STAGE_A(PG8_SA(0, 1), cA + hstepA, vgc, 1);
        if (wr == 1) PG8_BAR;
        PG8_WAIT_V(4); PG8_BAR;
        PG8_STAGE(PG8_SB(1, 0), cB + kstep, voffB); PG8_STAGE_A(PG8_SA(1, 0), cA + kstep, vgc, 0); PG8_STAGE(PG8_SB(1, 1), cB + hstep + kstep, voffB);
        PG8_WAIT_V(6); PG8_BAR;
    }
    for (;;) {
        const bool has_next = S.next(ui + 1, nxt);
        const char* nA = has_next ? (const char*)g.A + (size_t)nxt.pm * tstepA : cA;
        if constexpr (GATHER) { if (has_next) gath(nxt, vgn); else {
#pragma unroll
            for (int h = 0; h < 2; ++h) { vgn[h][0] = vgc[h][0]; vgn[h][1] = vgc[h][1]; } } } const char* nB = has_next ? (const char*)g.Bt + (size_t)nxt.pn * tstep : cB;
        for (int t = 0; t < nt; t += 2) {
            const bool last = (t == nt - 2);
            const char* a1 = cA + (size_t)(t + 1) * kstep;
            const char* a2 = last ? nA : cA + (size_t)(t + 2) * kstep; const char* b2 = last ? nB : cB + (size_t)(t + 2) * kstep;
            const char* a3 = a2 + kstep; const char* b3 = b2 + kstep;
            if (last && has_next) S.a_ready(nxt);
            if constexpr (GATHER) {
#pragma unroll
                for (int h = 0; h < 2; ++h) { vgs[h][0] = last ? vgn[h][0] : vgc[h][0]; vgs[h][1] = last ? vgn[h][1] : vgc[h][1]; } }
            if constexpr (SP2) {
            PG8_LDB(B0, 0, 0); PG8_LDB(B1, 0, 1); PG8_SCHED; PG8_LDA(At, 0, 0); PG8_STAGE_A(PG8_SA(1, 1), a1 + hstepA, vgc, 1);
            PG8_WAIT_V(8); PG8_WAIT_L(0); PG8_BAR; PG8_MMA(0, 0, At, B0); PG8_MMA(0, 1, At, B1); PG8_BAR; PG8_SCHED;
            PG8_LDA(At, 0, 1); PG8_STAGE(PG8_SB(0, 0), b2, voffB); PG8_STAGE(PG8_SB(0, 1), b2 + hstep, voffB); PG8_STAGE_A(PG8_SA(0, 0), a2, vgs, 0);
            PG8_WAIT_V(8); PG8_WAIT_L(0); PG8_BAR; PG8_MMA(1, 0, At, B0); PG8_MMA(1, 1, At, B1); PG8_BAR; PG8_SCHED;
            PG8_LDB(B0, 1, 0); PG8_LDB(B1, 1, 1); PG8_SCHED; PG8_LDA(At, 1, 0); PG8_STAGE_A(PG8_SA(0, 1), a2 + hstepA, vgs, 1);
            PG8_WAIT_V(8); PG8_WAIT_L(0); PG8_BAR; PG8_MMA(0, 0, At, B0); PG8_MMA(0, 1, At, B1); PG8_BAR; PG8_SCHED;
            PG8_LDA(At, 1, 1); PG8_STAGE(PG8_SB(1, 0), b3, voffB); PG8_STAGE(PG8_SB(1, 1), b3 + hstep, voffB); PG8_STAGE_A(PG8_SA(1, 0), a3, vgs, 0);
            PG8_WAIT_V(8); PG8_WAIT_L(0); PG8_BAR; PG8_MMA(1, 0, At, B0); PG8_MMA(1, 1, At, B1); PG8_BAR; PG8_SCHED;
            } else {
            PG8_LDB(B0, 0, 0); PG8_SCHED; PG8_LDA(At, 0, 0); PG8_STAGE_A(PG8_SA(1, 1), a1 + hstepA, vgc, 1);
            PG8_WAIT_L(8); PG8_BAR; PG8_WAIT_L(0); PG8_MMA(0, 0, At, B0); PG8_BAR; PG8_SCHED;
            PG8_LDB(B1, 0, 1); PG8_STAGE(PG8_SB(0, 0), b2, voffB);
            PG8_BAR; PG8_WAIT_L(0); PG8_MMA(0, 1, At, B1); PG8_BAR;
            PG8_LDA(At, 0, 1); PG8_STAGE_A(PG8_SA(0, 0), a2, vgs, 0);
            PG8_BAR; PG8_WAIT_L(0); PG8_MMA(1, 0, At, B0); PG8_BAR; PG8_SCHED;
            PG8_STAGE(PG8_SB(0, 1), b2 + hstep, voffB);
            PG8_WAIT_V(6); PG8_BAR; PG8_MMA(1, 1, At, B1); PG8_BAR;
            PG8_LDB(B0, 1, 0); PG8_SCHED; PG8_LDA(At, 1, 0); PG8_STAGE_A(PG8_SA(0, 1), a2 + hstepA, vgs, 1);
            PG8_WAIT_L(8); PG8_BAR; PG8_WAIT_L(0); PG8_MMA(0, 0, At, B0); PG8_BAR; PG8_SCHED;
            PG8_LDB(B1, 1, 1); PG8_STAGE(PG8_SB(1, 0), b3, voffB);
            PG8_BAR; PG8_WAIT_L(0); PG8_MMA(0, 1, At, B1); PG8_BAR;
            PG8_LDA(At, 1, 1); PG8_STAGE_A(PG8_SA(1, 0), a3, vgs, 0);
            PG8_BAR; PG8_WAIT_L(0); PG8_MMA(1, 0, At, B0); PG8_BAR; PG8_SCHED;
            PG8_STAGE(PG8_SB(1, 1), b3 + hstep, voffB);
            PG8_WAIT_V(6); PG8_BAR; PG8_MMA(1, 1, At, B1); PG8_BAR;
            }
        }
        if constexpr (ALIGN_EPI) { if (wr == 0) PG8_BAR; }
        if constexpr (!Epi::AFTER_DRAIN) { E(acc, cur, wr, wc, fr, fq); S.done(cur); }
        if (!has_next) break;
#pragma unroll
        for (int a = 0; a < 2; ++a)
#pragma unroll
            for (int b = 0; b < 2; ++b)
#pragma unroll
                for (int m = 0; m < 4; ++m)
#pragma unroll
                    for (int n = 0; n < 2; ++n) acc[a][b][m][n] = (f32x4){0.f, 0.f, 0.f, 0.f};
        cur = nxt; cA = nA; cB = nB; ++ui;
        if constexpr (GATHER) {
#pragma unroll
            for (int h = 0; h < 2; ++h) { vgc[h][0] = vgn[h][0]; vgc[h][1] = vgn[h][1]; } }
        if constexpr (ALIGN_EPI) { if (wr == 1) PG8_BAR; }
    }
    PG8_WAIT_V(0);
    if constexpr (!ALIGN_EPI) { if (wr == 0) PG8_BAR; }
    PG8_BAR;
    if constexpr (Epi::AFTER_DRAIN) { E.fused(acc, cur, wr, wc, fr, fq, lds, wid, lane); S.done(cur); }
#undef PG8_SA
#undef PG8_SB
#undef PG8_STAGE
#undef PG8_LDA
#undef PG8_LDB
#undef PG8_MMA
#undef PG8_WAIT_V
#undef PG8_WAIT_L
#undef PG8_BAR
#undef PG8_SCHED
#undef PG8_STAGE_A
}
struct EpiF32P { static constexpr bool PERM = false, AFTER_DRAIN = false; float* C; int ldc;
    __device__ __forceinline__ void operator()(const f32x4 (&acc)[2][2][4][2], const Unit& u, int wr, int wc, int fr, int fq) const {
#pragma unroll
        for (int ai = 0; ai < 2; ++ai)
#pragma unroll
            for (int m = 0; m < 4; ++m) { float* rp = C + (size_t)(u.pm * 256 + ai * 128 + wr * 64 + m * 16 + fr) * ldc + u.pn * 256 + wc * 32 + 4 * fq;
#pragma unroll
                for (int bj = 0; bj < 2; ++bj)
#pragma unroll
                    for (int n = 0; n < 2; ++n) *(f32x4*)(rp + bj * 128 + n * 16) = acc[ai][bj][m][n]; } } };
struct EpiBf16P { static constexpr bool PERM = false, AFTER_DRAIN = false; ::bf16_t* C; int ldc; int pnmask;
    __device__ __forceinline__ void operator()(const f32x4 (&acc)[2][2][4][2], const Unit& u, int wr, int wc, int fr, int fq) const {
#pragma unroll
        for (int ai = 0; ai < 2; ++ai)
#pragma unroll
            for (int m = 0; m < 4; ++m) { ::bf16_t* rp = C + (size_t)(u.pm * 256 + ai * 128 + wr * 64 + m * 16 + fr) * ldc + (u.pn & pnmask) * 256 + wc * 32 + 4 * fq;
#pragma unroll
                for (int bj = 0; bj < 2; ++bj)
#pragma unroll
                    for (int n = 0; n < 2; ++n) { const f32x4 v = acc[ai][bj][m][n]; *(::u32x2*)(rp + bj * 128 + n * 16) = (::u32x2){pack2(v[0], v[1]), pack2(v[2], v[3])}; } } } };
struct EpiRetInP { static constexpr bool PERM = false, AFTER_DRAIN = false; const Params* p;
    __device__ __forceinline__ void operator()(const f32x4 (&acc)[2][2][4][2], const Unit& u, int wr, int wc, int fr, int fq) const {
        const int pn = u.pn;
        if (pn < 8) {
            const int head = pn & 3, isk = pn >> 2; const float lg = log2f(1.f - exp2f(-5.f - (float)head));
            ::bf16_t* base = (::bf16_t*)(p->ws + (isk ? KB : QB)) + head * 256;
#pragma unroll
            for (int ai = 0; ai < 2; ++ai)
#pragma unroll
                for (int m = 0; m < 4; ++m) {
                    const int row = u.pm * 256 + ai * 128 + wr * 64 + m * 16 + fr, t = row & (S_ - 1);
                    const float sc = isk ? 0.0625f * exp2f((float)(127 - (t & 127)) * lg) : 1.f;
                    const float* rt = (const float*)(p->ws + ROPE_RT) + (size_t)t * 256;
#pragma unroll
                    for (int bj = 0; bj < 2; ++bj)
#pragma unroll
                        for (int n = 0; n < 2; ++n) {
                            const int c = bj * 128 + wc * 32 + n * 16 + 4 * fq, d = c >> 1; const f32x4 v = acc[ai][bj][m][n]; const f32x4 cs = *(const f32x4*)(rt + d * 2);
                            const float a0 = (v[0] * cs[0] - v[1] * cs[1]) * sc, b0 = (v[1] * cs[0] + v[0] * cs[1]) * sc, a1 = (v[2] * cs[2] - v[3] * cs[3]) * sc, b1 = (v[3] * cs[2] + v[2] * cs[3]) * sc;
                            ::bf16_t* dst = base + (size_t)row * 1024 + d; *(unsigned*)dst = pack2(a0, a1); *(unsigned*)(dst + 128) = pack2(b0, b1);
                        }
                }
        } else {
            ::bf16_t* base = (::bf16_t*)(p->ws + (pn < 16 ? VB : GB)) + ((pn - 8) & 7) * 256 + wc * 32 + 4 * fq;
#pragma unroll
            for (int ai = 0; ai < 2; ++ai)
#pragma unroll
                for (int m = 0; m < 4; ++m) { ::bf16_t* rp = base + (size_t)(u.pm * 256 + ai * 128 + wr * 64 + m * 16 + fr) * 2048;
#pragma unroll
                    for (int bj = 0; bj < 2; ++bj)
#pragma unroll
                        for (int n = 0; n < 2; ++n) { const f32x4 v = acc[ai][bj][m][n]; *(::u32x2*)(rp + bj * 128 + n * 16) = (::u32x2){pack2(v[0], v[1]), pack2(v[2], v[3])}; } }
        }
    }
};
struct EpiKvqP { static constexpr bool PERM = false, AFTER_DRAIN = false; const Params* p;
    __device__ __forceinline__ void operator()(const f32x4 (&acc)[2][2][4][2], const Unit& u, int wr, int wc, int fr, int fq) const {
        const int pn = u.pn; ::bf16_t* kvq = (::bf16_t*)(p->ws + KVQ);
        if (pn == 1 || pn == 3 || pn == 5) {
#pragma unroll
            for (int ai = 0; ai < 2; ++ai)
#pragma unroll
                for (int m = 0; m < 4; ++m) { ::bf16_t* rp = kvq + (size_t)(u.pm * 256 + ai * 128 + wr * 64 + m * 16 + fr) * KVQ_LD + pn * 256 + wc * 32 + 4 * fq;
#pragma unroll
                    for (int bj = 0; bj < 2; ++bj)
#pragma unroll
                        for (int n = 0; n < 2; ++n) { const f32x4 v = acc[ai][bj][m][n]; *(::u32x2*)(rp + bj * 128 + n * 16) = (::u32x2){pack2(v[0], v[1]), pack2(v[2], v[3])}; } }
        } else if (pn < 10) {
            const float sc = pn >= 6 ? 0.125f : 1.f; float mx[2] = {0.f, 0.f};
#pragma unroll
            for (int ai = 0; ai < 2; ++ai)
#pragma unroll
                for (int m = 0; m < 4; ++m) {
                    const int row = u.pm * 256 + ai * 128 + wr * 64 + m * 16 + fr, t = row & (S_ - 1);
                    const float* nt = (const float*)(p->ws + ROPE_NT) + (size_t)t * 64;
#pragma unroll
                    for (int bj = 0; bj < 2; ++bj) {
                        float nrm = 0.f;
#pragma unroll
                        for (int n = 0; n < 2; ++n) {
                            const int c = bj * 128 + wc * 32 + n * 16 + 4 * fq, d = (c & 63) >> 1; const f32x4 v = acc[ai][bj][m][n]; const f32x4 cs = *(const f32x4*)(nt + d * 2);
                            const float a0 = (v[0] * cs[0] - v[1] * cs[1]) * sc, b0 = (v[1] * cs[0] + v[0] * cs[1]) * sc, a1 = (v[2] * cs[2] - v[3] * cs[3]) * sc, b1 = (v[3] * cs[2] + v[2] * cs[3]) * sc;
                            ::bf16_t* dst = kvq + (size_t)row * KVQ_LD + pn * 256 + (c & ~63) + d; *(unsigned*)dst = pack2(a0, a1); *(unsigned*)(dst + 32) = pack2(b0, b1);
                            nrm += a0 * a0 + b0 * b0 + a1 * a1 + b1 * b1;
                        }
                        nrm += __shfl_xor(nrm, 16); nrm += __shfl_xor(nrm, 32);
                        mx[bj] = fmaxf(mx[bj], nrm);
                    }
                }
            if (pn < 6) {
#pragma unroll
                for (int bj = 0; bj < 2; ++bj) { const float mm = wave_max(mx[bj]); if ((ptid() & 63) == 0) atomicMax((int*)(p->ws + MISC) + MI_KMAX + ((((pn >> 1) * 2 + (u.pm >> 5)) * 4 + 2 * bj + (wc >> 1)) << 1) + (wc & 1), __float_as_int(mm)); }
            }
        } else if (pn == 10) {
#pragma unroll
            for (int ai = 0; ai < 2; ++ai)
#pragma unroll
                for (int m = 0; m < 4; ++m) { float* gt = (float*)(p->ws + GATES) + (size_t)(u.pm * 256 + ai * 128 + wr * 64 + m * 16 + fr) * 48;
#pragma unroll
                    for (int n = 0; n < 2; ++n) { const int c = wc * 32 + n * 16 + 4 * fq; const f32x4 v = acc[ai][0][m][n];
                        if (c < 48) *(f32x4*)(gt + c) = (f32x4){1.f / (1.f + __expf(-v[0])), 1.f / (1.f + __expf(-v[1])), 1.f / (1.f + __expf(-v[2])), 1.f / (1.f + __expf(-v[3]))}; } }
        }
    }
};
struct EpiSwigluP { static constexpr bool PERM = false, AFTER_DRAIN = false; ::bf16_t* C;
    __device__ __forceinline__ void operator()(const f32x4 (&acc)[2][2][4][2], const Unit& u, int wr, int wc, int fr, int fq) const {
#pragma unroll
        for (int ai = 0; ai < 2; ++ai)
#pragma unroll
            for (int m = 0; m < 4; ++m) { ::bf16_t* rp = C + (size_t)(u.pm * 256 + ai * 128 + wr * 64 + m * 16 + fr) * 512 + (u.pn & 3) * 128 + wc * 16 + 2 * fq;
#pragma unroll
                for (int bj = 0; bj < 2; ++bj)
#pragma unroll
                    for (int n = 0; n < 2; ++n) { const f32x4 v = acc[ai][bj][m][n];
                        *(unsigned*)(rp + bj * 64 + n * 8) = pack2(v[0] / (1.f + __expf(-v[0])) * v[1], v[2] / (1.f + __expf(-v[2])) * v[3]); } } } };
struct GroupedGatherOrder { const int* eoff; const int* cnt; const int* inv; int nunits, G, c;
    __device__ __forceinline__ bool next(int i, Unit& u) const {
        const int x = c & 7, q = i * (G >> 3) + (c >> 3), mt = (q >> 2) * 8 + x; if (mt >= (nunits >> 2)) return false;
        int e = 0; while (e < 15 && (mt << 8) >= eoff[e + 1]) ++e;
        u.pm = mt; u.pn = e * 4 + (q & 3); return true; }
    __device__ __forceinline__ int rowidx(const Unit& u, int r) const { const int e = u.pn >> 2, ix = (u.pm << 8) - eoff[e] + r; return inv[e * 16384 + (ix < cnt[e * 64] ? ix : 0)]; }
    __device__ __forceinline__ void a_ready(const Unit&) const {}
    __device__ __forceinline__ void done(const Unit&) const {}
};
struct GroupedOrder { const int* eoff; int nunits, G, c;
    __device__ __forceinline__ bool next(int i, Unit& u) const {
        const int x = c & 7, q = i * (G >> 3) + (c >> 3), mt = (q >> 2) * 8 + x; if (mt >= (nunits >> 2)) return false;
        int e = 0; while (e < 15 && (mt << 8) >= eoff[e + 1]) ++e;
        u.pm = mt; u.pn = e * 4 + (q & 3); return true; }
    __device__ __forceinline__ void a_ready(const Unit&) const {}
    __device__ __forceinline__ void done(const Unit&) const {}
};
}

__device__ __forceinline__ void ph_prep0(const Params& p, unsigned char* smem) {
    { const int tix = ptid(); if (blockIdx.x == 0 && tix < 128) ((int*)(p.ws + MISC))[tix] = 0; }
    {   const float4* x4 = (const float4*)p.x; uint2* xb = (uint2*)(p.ws + XB);
        const int n4 = T_ * D_ / 4, gt = gthreads();
        for (int i0 = gtid(); i0 < n4; i0 += 8 * gt) {
            f32x4 v[8];
#pragma unroll
            for (int j = 0; j < 8; ++j) { const int i = i0 + j * gt; v[j] = *(const f32x4*)(x4 + (i < n4 ? i : i0)); }
#pragma unroll
            for (int j = 0; j < 8; ++j) { const int i = i0 + j * gt; if (i < n4) xb[i] = make_uint2(pack2(v[j][0], v[j][1]), pack2(v[j][2], v[j][3])); }
        } }
    float* tile = (float*)smem;
    {   float* rt = (float*)(p.ws + ROPE_RT);
        const float inv = (float)pow(10000.0, (double)(-(float)(2 * (gtid() & 127)) / 256.0f));
        for (int it = gtid(); it < S_ * 128; it += gthreads()) { const int t = it >> 7; const float ang = (float)t * inv; float sn, cs; sincosf(ang, &sn, &cs); *(float2*)(rt + it * 2) = make_float2(cs, sn); } }
    { const float* w = p.ret_w_in; transpose_conv([w](int k, int n) { const int c = n < 2048 ? (n & ~255) + ((n & 1) << 7) + ((n & 255) >> 1) : n; return w[(size_t)k * 6144 + c]; }, (bf16_t*)(p.ws + WT_IN), 1024, 6144, tile); }
    { const float* w = p.ret_w_out; transpose_conv([w](int k, int n) { return w[(size_t)k * 1024 + n]; }, (bf16_t*)(p.ws + WT_OUT), 2048, 1024, tile); }
}
constexpr int MOEW_TILES_GU = 4096, MOEW_TILES = 6144;
__device__ __forceinline__ void moe_weights_range(const Params& p, int l, unsigned char* smem, int tb, int te, int rank, int nranks) {
    float* tile = (float*)smem;
    if (tb < MOEW_TILES_GU) { const float* wg = p.moe_wg + (size_t)l * 16 * 1024 * 512; const float* wu = p.moe_wu + (size_t)l * 16 * 1024 * 512;
      const ptrdiff_t du = wu - wg;
      transpose_conv_tiles([wg, du](int k, int n) { const int e = n >> 10, c = n & 1023; return wg[(ptrdiff_t)(c & 1) * du + ((size_t)e * 1024 + k) * 512 + (c >> 1)]; },
                           (bf16_t*)(p.ws + (l ? MOEW1_GU : MOEW_GU)), 1024, tile, tb, te < MOEW_TILES_GU ? te : MOEW_TILES_GU, rank, nranks); }
    if (te > MOEW_TILES_GU) { const float* wd = p.moe_wd + (size_t)l * 16 * 512 * 1024;
      transpose_conv_tiles([wd](int k, int n) { const int e = n >> 10, c = n & 1023; return wd[((size_t)e * 512 + k) * 1024 + c]; }, (bf16_t*)(p.ws + (l ? MOEW1_D : MOEW_D)), 512, tile,
                           (tb > MOEW_TILES_GU ? tb : MOEW_TILES_GU) - MOEW_TILES_GU, te - MOEW_TILES_GU, rank, nranks); }
}
__device__ __forceinline__ void ph_moe_weights(const Params& p, int l, unsigned char* smem) {
    float* tile = (float*)smem;
    { const float* wg = p.moe_wg + (size_t)l * 16 * 1024 * 512; const float* wu = p.moe_wu + (size_t)l * 16 * 1024 * 512;
      const ptrdiff_t du = wu - wg;
      transpose_conv([wg, du](int k, int n) { const int e = n >> 10, c = n & 1023; return wg[(ptrdiff_t)(c & 1) * du + ((size_t)e * 1024 + k) * 512 + (c >> 1)]; },
                     (bf16_t*)(p.ws + MOEW_GU), 1024, 16 * 1024, tile); }
    { const float* wd = p.moe_wd + (size_t)l * 16 * 512 * 1024;
      transpose_conv([wd](int k, int n) { const int e = n >> 10, c = n & 1023; return wd[((size_t)e * 512 + k) * 1024 + c]; }, (bf16_t*)(p.ws + MOEW_D), 512, 16 * 1024, tile); }
}
__device__ __forceinline__ void ph_prep1(const Params& p, unsigned char* smem) {
    float* tile = (float*)smem;
    { const float* wkv = p.nsa_w_kv; const float* win = p.nsa_w_in;
      transpose_conv([wkv, win](int k, int n) { const int sec = n >> 8; const bool rot = (sec == 0 || sec == 2 || sec == 4 || (sec >= 6 && sec < 10));
                         const int c = rot ? (n & ~63) + ((n & 1) << 5) + ((n & 63) >> 1) : n;
                         return c < 1536 ? wkv[(size_t)k * 1536 + c] : (c < 2608 ? win[(size_t)k * 1072 + (c - 1536)] : 0.f); },
                     (bf16_t*)(p.ws + WT_KVQ), 1024, KVQ_N, tile); }
    { const float* wk = p.ck_w2; const ptrdiff_t dv = p.cv_w2 - p.ck_w2; transpose_conv([wk, dv](int k, int n) { return (n & 127) < 64 ? wk[(ptrdiff_t)(n >> 7) * dv + (size_t)k * 64 + (n & 127)] : 0.f; }, (bf16_t*)(p.ws + WT_CW2), 256, 256, tile); }
    {   float* nt = (float*)(p.ws + ROPE_NT);
        const float inv = (float)pow(10000.0, (double)(-(float)(2 * (gtid() & 31)) / 64.0f));
        for (int it = gtid(); it < S_ * 32; it += gthreads()) { const int t = it >> 5; const float ang = (float)t * inv; float sn, cs; sincosf(ang, &sn, &cs); *(float2*)(nt + it * 2) = make_float2(cs, sn); } }
    {
        const int lane = ptid() & 63; float* part = (float*)(p.ws + ATTN_OUT);
        for (int it = gwave(); it < 256; it += gwaves()) {
            const int kv = it >> 7, jg = (it >> 5) & 3, ks = it & 31; const float* w1 = (kv ? p.cv_w1 : p.ck_w1) + (size_t)ks * 64 * 256 + jg * 64 + lane; const float* pe = (kv ? p.pe_v : p.pe_k) + ks * 64;
            float a = 0.f;
#pragma unroll
            for (int kb = 0; kb < 64; kb += 16) {
                float wv[16], pv[16];
#pragma unroll
                for (int k = 0; k < 16; ++k) { wv[k] = w1[(size_t)(kb + k) * 256]; pv[k] = pe[kb + k]; }
#pragma unroll
                for (int k = 0; k < 16; ++k) a += pv[k] * wv[k];
            }
            part[ks * 512 + kv * 256 + jg * 64 + lane] = a;
        } }
    { const float* w = p.nsa_w_out; transpose_conv([w](int k, int n) { return w[(size_t)k * 1024 + n]; }, (bf16_t*)(p.ws + WT_NSAOUT), 1024, 1024, tile); }
    { const float* wk = p.ck_w1; const ptrdiff_t dv = p.cv_w1 - p.ck_w1; transpose_conv([wk, dv](int k, int n) { return wk[(ptrdiff_t)(n >> 8) * dv + (size_t)k * 256 + (n & 255)]; }, (bf16_t*)(p.ws + WT_CW1), 2048, 512, tile); }
}

struct EpiRetIn : EpiBase { const Params* p; int m0, n0; float lg; int head, sec; float kd[4]; int wm_, fr_;
    __device__ __forceinline__ void start(int wm, int wn, int fr, int) {
        wm_ = wm; fr_ = fr; sec = n0 >> 10; head = ((n0 + wn * 64) >> 8) & 3;
        lg = log2f(1.f - exp2f(-5.f - (float)head));
#pragma unroll
        for (int i = 0; i < 4; ++i) { const int t = (m0 + wm * 64 + i * 16 + fr) & (S_ - 1); kd[i] = sec == 1 ? 0.0625f * exp2f((float)(127 - (t & 127)) * lg) : 1.f; }
    }
    __device__ __forceinline__ void operator()(int m, int n, f32x4 v) const {
        const size_t tok = (size_t)(m0 + m); const int c = n0 + n;
        if (n0 < 2048) {
            const int d = (c & 255) >> 1, t = (int)tok & (S_ - 1), i = (m - wm_ * 64 - fr_) >> 4;
            const f32x4 cs = *(const f32x4*)((const float*)(p->ws + ROPE_RT) + ((size_t)t * 128 + d) * 2);
            const float sc = i == 0 ? kd[0] : (i == 1 ? kd[1] : (i == 2 ? kd[2] : kd[3]));
            const float a0 = (v[0] * cs[0] - v[1] * cs[1]) * sc, b0 = (v[1] * cs[0] + v[0] * cs[1]) * sc, a1 = (v[2] * cs[2] - v[3] * cs[3]) * sc, b1 = (v[3] * cs[2] + v[2] * cs[3]) * sc;
            bf16_t* dst = (bf16_t*)(p->ws + (sec ? KB : QB)) + tok * 1024 + head * 256 + d;
            *(unsigned*)dst = pack2(a0, a1); *(unsigned*)(dst + 128) = pack2(b0, b1);
        } else {
            bf16_t* dst = (n0 < 4096 ? (bf16_t*)(p->ws + VB) + (c - 2048) : (bf16_t*)(p->ws + GB) + (c - 4096)) + tok * 2048;
            *(u32x2*)dst = (u32x2){pack2(v[0], v[1]), pack2(v[2], v[3])};
        }
    }
};
__device__ __forceinline__ void ph_gemm_retin(const Params& p, unsigned char* smem) {
    const bf16_t* A = (const bf16_t*)(p.ws + XB); const bf16_t* Bt = (const bf16_t*)(p.ws + WT_IN);
    for (int t = blockIdx.x; t < 64 * 48; t += gridDim.x) {
        const int mt = t / 48, nt = t % 48, n0 = nt * 128;
        EpiRetIn e{}; e.p = &p; e.m0 = mt * 256; e.n0 = n0;
        gemm_tile(A + (size_t)mt * 256 * 1024, 1024, Bt + (size_t)n0 * 1024, 1024, 1024, e, smem);
    }
}
__device__ __forceinline__ void ph_gemm_f32(const bf16_t* A, const bf16_t* Bt, float* C, int Mt, int Nt, int K, int N, unsigned char* smem) {
    for (int t = blockIdx.x; t < Mt * Nt; t += gridDim.x) {
        const int mt = t / Nt, nt = t % Nt;
        gemm_tile(A + (size_t)mt * 256 * K, K, Bt + (size_t)nt * 128 * K, K, K, EpiF32{{}, C + (size_t)mt * 256 * N + nt * 128, N}, smem);
    }
}
__device__ __forceinline__ void ph_gemm_bf16(const bf16_t* A, const bf16_t* Bt, bf16_t* C, int Mt, int Nt, int K, int N, unsigned char* smem) {
    for (int t = blockIdx.x; t < Mt * Nt; t += gridDim.x) {
        const int mt = t / Nt, nt = t % Nt;
        gemm_tile(A + (size_t)mt * 256 * K, K, Bt + (size_t)nt * 128 * K, K, K, EpiBf16{{}, C + (size_t)mt * 256 * N + nt * 128, N}, smem);
    }
}

typedef short s16x4 __attribute__((ext_vector_type(4)));
#define LDSP(T, ptr) ((__attribute__((address_space(3))) T*)(ptr))
__device__ __forceinline__ bf16x8 tr_frag(const bf16_t* tile, int ld, int row0, int col0, int lane) {
    const int g = lane >> 4, q = (lane & 15) >> 2, pp = lane & 3;
    const bf16_t* a = tile + (row0 + 8 * g + q) * ld + col0 + 4 * pp;
    const s16x4 lo = __builtin_amdgcn_ds_read_tr16_b64_v4i16(LDSP(s16x4, a));
    const s16x4 hi = __builtin_amdgcn_ds_read_tr16_b64_v4i16(LDSP(s16x4, a + 4 * ld));
    return (bf16x8){lo[0], lo[1], lo[2], lo[3], hi[0], hi[1], hi[2], hi[3]};
}
__device__ __forceinline__ bf16x8 pack_frag(f32x4 a, f32x4 b) {
    u32x4 u = {pack2(a[0], a[1]), pack2(a[2], a[3]), pack2(b[0], b[1]), pack2(b[2], b[3])};
    return __builtin_bit_cast(bf16x8, u);
}
constexpr int RQ_LD = 264, RK_LD = 136;
template <int NCH> __device__ __forceinline__ void stage_tile(const bf16_t* g, int gld, bf16_t* l, int lld) {
    const int tix = ptid(), row = tix / NCH, ch = tix % NCH, goff = row * gld + ch * 8, loff = row * lld + ch * 8;
#pragma unroll
    for (int i = 0; i < (128 * NCH) / NT; ++i) { *(u32x4*)(l + loff + i * (NT / NCH) * lld) = *(const u32x4*)(g + (size_t)i * (NT / NCH) * gld + goff); if ((i & 3) == 3) asm volatile("" ::: "memory"); }
}
__device__ __forceinline__ void ph_ret_state(const Params& p, unsigned char* smem) {
    const bf16_t* K = (const bf16_t*)(p.ws + KB); const bf16_t* V = (const bf16_t*)(p.ws + VB); float* L = (float*)(p.ws + RET_L);
    bf16_t* Ks = (bf16_t*)smem; bf16_t* Vs = Ks + 128 * RQ_LD;
    const int tix = ptid(), lane = tix & 63, w = __builtin_amdgcn_readfirstlane(tix >> 6), g = lane >> 4, i16 = lane & 15;
    for (int unit = blockIdx.x; unit < 224; unit += gridDim.x) {
        const int slice = unit & 3, seg = (unit >> 2) % 7, bh = unit / 28, b = bh >> 2, h = bh & 3;
        const float lg = log2f(1.f - exp2f(-5.f - (float)h)), g128 = exp2f(128.f * lg);
        f32x4 S[16];
#pragma unroll
        for (int dt = 0; dt < 16; ++dt) S[dt] = (f32x4){0.f, 0.f, 0.f, 0.f};
        u32x4 pk[8], pv[4];
        const int kg = (tix >> 5) * 1024 + (tix & 31) * 8, kl = (tix >> 5) * RQ_LD + (tix & 31) * 8, vg = (tix >> 4) * 2048 + (tix & 15) * 8, vl = (tix >> 4) * RK_LD + (tix & 15) * 8;
        {   const size_t t0 = (size_t)b * S_ + seg * 1024;
#pragma unroll
            for (int i = 0; i < 8; ++i) pk[i] = *(const u32x4*)(K + t0 * 1024 + h * 256 + (size_t)i * 16 * 1024 + kg);
#pragma unroll
            for (int i = 0; i < 4; ++i) pv[i] = *(const u32x4*)(V + t0 * 2048 + h * 512 + slice * 128 + (size_t)i * 32 * 2048 + vg); }
        for (int ch = 0; ch < 8; ++ch) {
            __syncthreads();
#pragma unroll
            for (int i = 0; i < 8; ++i) *(u32x4*)(Ks + kl + i * 16 * RQ_LD) = pk[i];
#pragma unroll
            for (int i = 0; i < 4; ++i) *(u32x4*)(Vs + vl + i * 32 * RK_LD) = pv[i];
            __syncthreads();
            {   const size_t t1 = (size_t)b * S_ + seg * 1024 + (ch < 7 ? ch + 1 : ch) * 128;
#pragma unroll
                for (int i = 0; i < 8; ++i) pk[i] = *(const u32x4*)(K + t1 * 1024 + h * 256 + (size_t)i * 16 * 1024 + kg);
#pragma unroll
                for (int i = 0; i < 4; ++i) pv[i] = *(const u32x4*)(V + t1 * 2048 + h * 512 + slice * 128 + (size_t)i * 32 * 2048 + vg); }
            bf16x8 Vf[4];
#pragma unroll
            for (int ks = 0; ks < 4; ++ks) Vf[ks] = tr_frag(Vs, RK_LD, 32 * ks, 16 * w, lane);
#pragma unroll
            for (int dt = 0; dt < 16; ++dt) {
                S[dt] = S[dt] * g128;
#pragma unroll
                for (int ks = 0; ks < 4; ++ks) S[dt] = __builtin_amdgcn_mfma_f32_16x16x32_bf16(tr_frag(Ks, RQ_LD, 32 * ks, 16 * dt, lane), Vf[ks], S[dt], 0, 0, 0);
            }
        }
        float* Lu = L + (size_t)((bh * 8 + seg) * 4 + slice) * (256 * 128) + tix * 64;
#pragma unroll
        for (int dt = 0; dt < 16; ++dt) *(f32x4*)(Lu + dt * 4) = S[dt];
    }
}
__device__ __forceinline__ void ph_ret_scan(const Params& p, unsigned char* smem) {
    const bf16_t* Q = (const bf16_t*)(p.ws + QB); const bf16_t* K = (const bf16_t*)(p.ws + KB); const bf16_t* V = (const bf16_t*)(p.ws + VB);
    const float* L = (const float*)(p.ws + RET_L); bf16_t* O = (bf16_t*)p.out;
    bf16_t* Qs = (bf16_t*)smem; bf16_t* Ks = Qs + 128 * RK_LD; bf16_t* Vs = Ks + 128 * RK_LD; bf16_t* Ps = Vs + 128 * RK_LD;
    const int tix = ptid(), lane = tix & 63, w = __builtin_amdgcn_readfirstlane(tix >> 6), g = lane >> 4, i16 = lane & 15;
    for (int unit = blockIdx.x; unit < 256; unit += gridDim.x) {
        const int slice = unit & 3, seg = (unit >> 2) & 7, bh = unit >> 5, b = bh >> 2, h = bh & 3;
        const float lg = log2f(1.f - exp2f(-5.f - (float)h)), g128 = exp2f(128.f * lg), g1024 = exp2f(1024.f * lg), gm128 = exp2f(-128.f * lg);
        f32x4 S[16];
#pragma unroll
        for (int dt = 0; dt < 16; ++dt) S[dt] = (f32x4){0.f, 0.f, 0.f, 0.f};
        for (int j = 0; j < seg; ++j) {
            const float* Lu = L + (size_t)((bh * 8 + j) * 4 + slice) * (256 * 128) + tix * 64;
#pragma unroll
            for (int dt = 0; dt < 16; ++dt) { S[dt] = S[dt] * g1024 + *(const f32x4*)(Lu + dt * 4); if ((dt & 3) == 3) asm volatile("" ::: "memory"); }
        }
        u32x4 pfq[4], pfk[4]; const int pfg = (tix >> 4) * 1024 + (tix & 15) * 8, pfl = (tix >> 4) * RK_LD + (tix & 15) * 8;
        {   const bf16_t* q0 = Q + ((size_t)b * S_ + seg * 1024) * 1024 + h * 256; const bf16_t* k0_ = K + ((size_t)b * S_ + seg * 1024) * 1024 + h * 256;
#pragma unroll
            for (int i = 0; i < 4; ++i) { pfq[i] = *(const u32x4*)(q0 + (size_t)i * 32 * 1024 + pfg); pfk[i] = *(const u32x4*)(k0_ + (size_t)i * 32 * 1024 + pfg); } }
        for (int ch = 0; ch < 8; ++ch) {
            const size_t tok0 = (size_t)b * S_ + seg * 1024 + ch * 128;
            f32x4 Oa[8], P[8];
#pragma unroll
            for (int i = 0; i < 8; ++i) { Oa[i] = (f32x4){0.f, 0.f, 0.f, 0.f}; P[i] = (f32x4){0.f, 0.f, 0.f, 0.f}; }
#pragma unroll
            for (int hf = 0; hf < 2; ++hf) {
                __syncthreads();
#pragma unroll
                for (int i = 0; i < 4; ++i) { *(u32x4*)(Qs + pfl + i * 32 * RK_LD) = pfq[i]; *(u32x4*)(Ks + pfl + i * 32 * RK_LD) = pfk[i]; }
                if (hf == 0) stage_tile<16>(V + tok0 * 2048 + h * 512 + slice * 128, 2048, Vs, RK_LD);
                __syncthreads();
                {
                    const int nch = hf == 0 ? ch : (ch < 7 ? ch + 1 : ch), nhf = hf == 0 ? 1 : (ch < 7 ? 0 : 1);
                    const bf16_t* qn_ = Q + ((size_t)b * S_ + seg * 1024 + nch * 128) * 1024 + h * 256 + nhf * 128; const bf16_t* kn_ = K + ((size_t)b * S_ + seg * 1024 + nch * 128) * 1024 + h * 256 + nhf * 128;
#pragma unroll
                    for (int i = 0; i < 4; ++i) { pfq[i] = *(const u32x4*)(qn_ + (size_t)i * 32 * 1024 + pfg); pfk[i] = *(const u32x4*)(kn_ + (size_t)i * 32 * 1024 + pfg); }
                }
                {
                    bf16x8 Sf[4];
#pragma unroll
                    for (int ks = 0; ks < 4; ++ks) Sf[ks] = pack_frag(S[8 * hf + 2 * ks], S[8 * hf + 2 * ks + 1]);
#pragma unroll
                    for (int ct = 0; ct < 8; ++ct) {
#pragma unroll
                        for (int ks = 0; ks < 4; ++ks) {
                            const bf16_t* qa = Qs + (16 * ct + i16) * RK_LD + 32 * ks + 4 * g;
                            const u32x2 lo = *(const u32x2*)qa, hi = *(const u32x2*)(qa + 16);
                            const u32x4 qq = {lo[0], lo[1], hi[0], hi[1]};
                            Oa[ct] = __builtin_amdgcn_mfma_f32_16x16x32_bf16(Sf[ks], __builtin_bit_cast(bf16x8, qq), Oa[ct], 0, 0, 0);
                        }
                        if (ct & 1) __builtin_amdgcn_sched_barrier(0);
                    }
                }
#pragma unroll
                for (int ks = 0; ks < 4; ++ks) {
                    const bf16x8 Qf = *(const bf16x8*)(Qs + (16 * w + i16) * RK_LD + 32 * ks + 8 * g);
#pragma unroll
                    for (int mt = 0; mt < 8; ++mt) if (mt <= w) P[mt] = __builtin_amdgcn_mfma_f32_16x16x32_bf16(*(const bf16x8*)(Ks + (16 * mt + i16) * RK_LD + 32 * ks + 8 * g), Qf, P[mt], 0, 0, 0);
                }
                __builtin_amdgcn_sched_barrier(0);
                if (hf == 1) {
                    const int c = 16 * w + i16;
#pragma unroll
                    for (int mt = 0; mt < 8; ++mt) {
                        float v[4];
#pragma unroll
                        for (int r = 0; r < 4; ++r) { const int m = 16 * mt + 4 * g + r; v[r] = (mt <= w && m <= c) ? P[mt][r] * gm128 : 0.f; }
                        *(u32x2*)(Ps + c * RK_LD + 16 * mt + 4 * g) = (u32x2){pack2(v[0], v[1]), pack2(v[2], v[3])};
                    }
                }
                {
                    bf16x8 Vf[4];
#pragma unroll
                    for (int ks = 0; ks < 4; ++ks) Vf[ks] = tr_frag(Vs, RK_LD, 32 * ks, 16 * w, lane);
#pragma unroll
                    for (int dt = 0; dt < 8; ++dt) {
                        S[8 * hf + dt] = S[8 * hf + dt] * g128;
#pragma unroll
                        for (int ks = 0; ks < 4; ++ks) S[8 * hf + dt] = __builtin_amdgcn_mfma_f32_16x16x32_bf16(tr_frag(Ks, RK_LD, 32 * ks, 16 * dt, lane), Vf[ks], S[8 * hf + dt], 0, 0, 0);
                        if (dt & 1) __builtin_amdgcn_sched_barrier(0);
                    }
                }
            }
            __syncthreads();
            {
                bf16x8 Vf[4];
#pragma unroll
                for (int ks = 0; ks < 4; ++ks) Vf[ks] = tr_frag(Vs, RK_LD, 32 * ks, 16 * w, lane);
#pragma unroll
                for (int ct = 0; ct < 8; ++ct)
#pragma unroll
                    for (int ks = 0; ks < 4; ++ks) if (ks <= ct / 2) Oa[ct] = __builtin_amdgcn_mfma_f32_16x16x32_bf16(Vf[ks], *(const bf16x8*)(Ps + (16 * ct + i16) * RK_LD + 32 * ks + 8 * g), Oa[ct], 0, 0, 0);
            }
            {
                bf16_t* ob = O + tok0 * 2048 + h * 512 + slice * 128 + 16 * w; const int ooff = i16 * 2048 + 4 * g;
#pragma unroll
                for (int ct = 0; ct < 8; ++ct) { const float sc = exp2f((float)(16 * ct + i16 + 1) * lg); *(u32x2*)(ob + (size_t)ct * 16 * 2048 + ooff) = (u32x2){pack2(Oa[ct][0] * sc, Oa[ct][1] * sc), pack2(Oa[ct][2] * sc, Oa[ct][3] * sc)}; }
            }
        }
    }
}
__device__ __forceinline__ void ph_gnorm_gate(const Params& p) {
    bf16_t* O = (bf16_t*)p.out; const bf16_t* G = (const bf16_t*)(p.ws + GB);
    const int lane = ptid() & 63, gw = gwaves();
    for (int it0 = gwave(); it0 < T_ * 4; it0 += 4 * gw) {
        u32x4 xr[4], gr[4];
#pragma unroll
        for (int u = 0; u < 4; ++u) { const int it = it0 + u * gw < T_ * 4 ? it0 + u * gw : it0; const size_t off = (size_t)it * 512 + lane * 8; xr[u] = *(const u32x4*)(O + off); gr[u] = *(const u32x4*)(G + off); }
#pragma unroll
        for (int u = 0; u < 4; ++u) {
            const int it = it0 + u * gw; if (it >= T_ * 4) break;
            const size_t off = (size_t)it * 512 + lane * 8;
            float x[8], g[8]; unpack8(xr[u], x); unpack8(gr[u], g);
            float s = 0.f;
#pragma unroll
            for (int j = 0; j < 8; ++j) s += x[j];
            const float mean = wave_sum(s) * (1.f / 512.f);
            float q = 0.f;
#pragma unroll
            for (int j = 0; j < 8; ++j) { x[j] -= mean; q += x[j] * x[j]; }
            const float rstd = rsqrtf(wave_sum(q) * (1.f / 512.f) + 1e-5f);
            float r[8];
#pragma unroll
            for (int j = 0; j < 8; ++j) r[j] = x[j] * rstd * (g[j] / (1.f + __expf(-g[j])));
            *(u32x4*)(O + off) = (u32x4){pack2(r[0], r[1]), pack2(r[2], r[3]), pack2(r[4], r[5]), pack2(r[6], r[7])};
        }
    }
}

template <bool COMBINE, bool ROUTER, bool FINAL, bool BASEBF> __forceinline__
__device__ __forceinline__ void ph_ln(const Params& p, const float* base, const float* mix, float* hout, bf16_t* hb, const float* lng, const float* lnb, int layer, unsigned char* smem) {
    const int tix = ptid(), lane = tix & 63;
    int* misc = (int*)(p.ws + MISC);
    const bf16_t* yexp = (const bf16_t*)(p.ws + YEXP);
    float* rwl = (float*)smem;
    int* eoffs = (int*)(smem + 65536);
    int* lcnt = (int*)(smem + 65536 + 256);
    int* lbase = lcnt + 16; int* llist = lcnt + 32; int nloc = 0;
    if (ROUTER) {
        for (int i0 = 0; i0 < 1024 * 16; i0 += 8 * NT) {
            float rv[8];
#pragma unroll
            for (int j = 0; j < 8; ++j) rv[j] = p.router_w[i0 + j * NT + tix];
#pragma unroll
            for (int j = 0; j < 8; ++j) { const int idx = i0 + j * NT + tix, d = idx >> 4, e = idx & 15; rwl[((((d >> 8) * 4 + (d & 3)) * 64 + ((d & 255) >> 2)) << 4) + e] = rv[j]; }
        }
        if (tix < 16) lcnt[tix] = 0;
        __syncthreads();
    }
    if (COMBINE) {
        if (tix == 0) { const int* cnt = (const int*)(p.ws + CNT_OFF) + layer * 1024; int o = 0; for (int e = 0; e < 16; ++e) { eoffs[e] = o; o += (cnt[e * 64] + 255) & ~255; } }
        __syncthreads();
    }
    struct LnIn { f32x4 a[4], m[4]; u32x2 ab[4], y0[4], y1[4]; float w0, w1; };
    int pr0 = 0, pr1 = 0; float pw0 = 0.f, pw1 = 0.f;
    auto ln_load = [&](int tok, int ix, LnIn& in) {
        int r0 = 0, r1 = 0;
        if (COMBINE) { in.w0 = __shfl(pw0, ix); in.w1 = __shfl(pw1, ix); r0 = __shfl(pr0, ix); r1 = __shfl(pr1, ix); }
#pragma unroll
        for (int i = 0; i < 4; ++i) {
            if (BASEBF) in.ab[i] = *(const u32x2*)((const bf16_t*)base + (size_t)tok * 1024 + i * 256 + lane * 4); else in.a[i] = *(const f32x4*)(base + (size_t)tok * 1024 + i * 256 + lane * 4);
            if (COMBINE) { in.y0[i] = *(const u32x2*)(yexp + (size_t)r0 * 1024 + i * 256 + lane * 4); in.y1[i] = *(const u32x2*)(yexp + (size_t)r1 * 1024 + i * 256 + lane * 4); }
            else in.m[i] = *(const f32x4*)(mix + (size_t)tok * 1024 + i * 256 + lane * 4);
        }
    };
    auto ln_token = [&](int tok, const LnIn& in) {
        float v[16];
#pragma unroll
        for (int i = 0; i < 4; ++i) {
            f32x4 m;
            if (COMBINE) { m[0] = in.w0 * lo2f(in.y0[i][0]) + in.w1 * lo2f(in.y1[i][0]); m[1] = in.w0 * hi2f(in.y0[i][0]) + in.w1 * hi2f(in.y1[i][0]); m[2] = in.w0 * lo2f(in.y0[i][1]) + in.w1 * lo2f(in.y1[i][1]); m[3] = in.w0 * hi2f(in.y0[i][1]) + in.w1 * hi2f(in.y1[i][1]); }
            else m = in.m[i];
            const f32x4 av = BASEBF ? (f32x4){lo2f(in.ab[i][0]), hi2f(in.ab[i][0]), lo2f(in.ab[i][1]), hi2f(in.ab[i][1])} : in.a[i];
            v[i * 4 + 0] = 1.41421356237f * av[0] + m[0]; v[i * 4 + 1] = 1.41421356237f * av[1] + m[1]; v[i * 4 + 2] = 1.41421356237f * av[2] + m[2]; v[i * 4 + 3] = 1.41421356237f * av[3] + m[3];
        }
        float s = 0.f;
#pragma unroll
        for (int i = 0; i < 16; ++i) s += v[i];
        const float mean = wave_sum(s) * (1.f / 1024.f);
        float q = 0.f;
#pragma unroll
        for (int i = 0; i < 16; ++i) { v[i] -= mean; q += v[i] * v[i]; }
        const float rstd = rsqrtf(wave_sum(q) * (1.f / 1024.f) + 1e-5f);
#pragma unroll
        for (int i = 0; i < 4; ++i) {
            const float4 g = *(const float4*)(lng + i * 256 + lane * 4), bb = *(const float4*)(lnb + i * 256 + lane * 4);
            v[i * 4 + 0] = v[i * 4 + 0] * rstd * g.x + bb.x; v[i * 4 + 1] = v[i * 4 + 1] * rstd * g.y + bb.y; v[i * 4 + 2] = v[i * 4 + 2] * rstd * g.z + bb.z; v[i * 4 + 3] = v[i * 4 + 3] * rstd * g.w + bb.w;
            if (FINAL) *(float4*)(hout + (size_t)tok * 1024 + i * 256 + lane * 4) = make_float4(v[i * 4 + 0], v[i * 4 + 1], v[i * 4 + 2], v[i * 4 + 3]);
            if (!FINAL) *(uint2*)(hb + (size_t)tok * 1024 + i * 256 + lane * 4) = make_uint2(pack2(v[i * 4 + 0], v[i * 4 + 1]), pack2(v[i * 4 + 2], v[i * 4 + 3]));
        }
        if (ROUTER) {
            __builtin_amdgcn_sched_barrier(0);
            float lg[16];
#pragma unroll
            for (int e = 0; e < 16; ++e) lg[e] = 0.f;
#pragma unroll
            for (int i = 0; i < 4; ++i)
#pragma unroll
                for (int j = 0; j < 4; ++j) {
                    const f32x4* rw = (const f32x4*)(rwl + (((i * 4 + j) * 64 + lane) << 4));
                    const float hv = v[i * 4 + j];
#pragma unroll
                    for (int e4 = 0; e4 < 4; ++e4) { const f32x4 r = rw[e4]; lg[e4 * 4 + 0] += hv * r[0]; lg[e4 * 4 + 1] += hv * r[1]; lg[e4 * 4 + 2] += hv * r[2]; lg[e4 * 4 + 3] += hv * r[3]; }
                    if (j & 1) asm volatile("" ::: "memory");
                }
            __builtin_amdgcn_sched_barrier(0);
            float r8[8], r4[4], r2[2], r1;
#pragma unroll
            for (int e = 0; e < 8; ++e) { const bool hi = lane & 32; const float keep = hi ? lg[e + 8] : lg[e], send = hi ? lg[e] : lg[e + 8]; r8[e] = keep + __shfl_xor(send, 32); }
#pragma unroll
            for (int e = 0; e < 4; ++e) { const bool hi = lane & 16; const float keep = hi ? r8[e + 4] : r8[e], send = hi ? r8[e] : r8[e + 4]; r4[e] = keep + __shfl_xor(send, 16); }
#pragma unroll
            for (int e = 0; e < 2; ++e) { const bool hi = lane & 8; const float keep = hi ? r4[e + 2] : r4[e], send = hi ? r4[e] : r4[e + 2]; r2[e] = keep + __shfl_xor(send, 8); }
            { const bool hi = lane & 4; const float keep = hi ? r2[1] : r2[0], send = hi ? r2[0] : r2[1]; r1 = keep + __shfl_xor(send, 4); }
            r1 += __shfl_xor(r1, 1); r1 += __shfl_xor(r1, 2);
            float aff[16], sel[16];
#pragma unroll
            for (int e = 0; e < 16; ++e) { const int src = ((e >> 3) & 1) * 32 + ((e >> 2) & 1) * 16 + ((e >> 1) & 1) * 8 + (e & 1) * 4; const float l = __shfl(r1, src); aff[e] = 1.f / (1.f + expf(-l)); sel[e] = aff[e] + p.router_b[e]; }
            float best = -3.0e38f; int bg = 0; float b0 = 0, b1 = 0, b2 = 0, b3 = 0, a0 = 0, a1 = 0, a2 = 0, a3 = 0;
#pragma unroll
            for (int g = 0; g < 4; ++g) {
                const float x0 = sel[4 * g], x1 = sel[4 * g + 1], x2 = sel[4 * g + 2], x3 = sel[4 * g + 3];
                const float mx = fmaxf(fmaxf(x0, x1), fmaxf(x2, x3));
                const float m2 = fmaxf(fmaxf(fminf(x0, x1), fminf(x2, x3)), fminf(fmaxf(x0, x1), fmaxf(x2, x3)));
                const float gs = mx + m2;
                if (gs > best) { best = gs; bg = g; b0 = x0; b1 = x1; b2 = x2; b3 = x3; a0 = aff[4 * g]; a1 = aff[4 * g + 1]; a2 = aff[4 * g + 2]; a3 = aff[4 * g + 3]; }
            }
            int i1 = 0; float m = b0, wa = a0;
            if (b1 > m) { m = b1; i1 = 1; wa = a1; } if (b2 > m) { m = b2; i1 = 2; wa = a2; } if (b3 > m) { m = b3; i1 = 3; wa = a3; }
            int i2 = -1; float m2 = -3.0e38f, wb = 0.f;
            if (i1 != 0 && b0 > m2) { m2 = b0; i2 = 0; wb = a0; } if (i1 != 1 && b1 > m2) { m2 = b1; i2 = 1; wb = a1; }
            if (i1 != 2 && b2 > m2) { m2 = b2; i2 = 2; wb = a2; } if (i1 != 3 && b3 > m2) { m2 = b3; i2 = 3; wb = a3; }
            const float nrm = wa + wb;
            if (lane == 0) {
                const int e1 = bg * 4 + i1, e2 = bg * 4 + i2;
                misc[MI_TE + tok * 2] = e1; misc[MI_TE + tok * 2 + 1] = e2;
                misc[MI_TW + tok * 2] = __float_as_int(wa / nrm); misc[MI_TW + tok * 2 + 1] = __float_as_int(wb / nrm);
                const int li1 = atomicAdd(&lcnt[e1], 1), li2 = atomicAdd(&lcnt[e2], 1);
                int* ent = llist + ((tix >> 6) * 16 + nloc) * 5; ent[0] = tok; ent[1] = e1; ent[2] = e2; ent[3] = li1; ent[4] = li2;
            }
            ++nloc;
        }
    };
    {
        const int t00 = gwave(), step = gwaves(), ntk_all = (T_ - t00 + step - 1) / step;
        for (int c0 = 0; c0 < ntk_all; c0 += 64) {
            const int t0 = t00 + c0 * step, ntk = ntk_all - c0 < 64 ? ntk_all - c0 : 64;
            if (COMBINE) { const int tl = t0 + (lane < ntk ? lane : 0) * step;
                pw0 = __int_as_float(misc[MI_TW + tl * 2]); pw1 = __int_as_float(misc[MI_TW + tl * 2 + 1]); pr0 = eoffs[misc[MI_TE + tl * 2]] + misc[MI_TI + tl * 2]; pr1 = eoffs[misc[MI_TE + tl * 2 + 1]] + misc[MI_TI + tl * 2 + 1]; }
            LnIn inA, inB;
            ln_load(t0, 0, inA);
            for (int it = 0; it < ntk; it += 2) {
                const int tk = t0 + it * step, tk1 = tk + step, tk2 = tk + 2 * step;
                ln_load(it + 1 < ntk ? tk1 : tk, it + 1 < ntk ? it + 1 : it, inB);
                ln_token(tk, inA);
                if (it + 1 >= ntk) break;
                ln_load(it + 2 < ntk ? tk2 : tk1, it + 2 < ntk ? it + 2 : it + 1, inA);
                ln_token(tk1, inB);
            }
        }
    }
    if (ROUTER) {
        __syncthreads();
        int* cnt = (int*)(p.ws + CNT_OFF) + layer * 1024;
        if (tix < 16) lbase[tix] = lcnt[tix] ? atomicAdd(&cnt[tix * 64], lcnt[tix]) : 0;
        __syncthreads();
        int* inv = (int*)(p.ws + MOE_INV);
        const int wv = tix >> 6, k = tix & 63;
        if (k < nloc) { const int* ent = llist + (wv * 16 + k) * 5; const int tok = ent[0], e1 = ent[1], e2 = ent[2], i1x = lbase[e1] + ent[3], i2x = lbase[e2] + ent[4];
            misc[MI_TI + tok * 2] = i1x; misc[MI_TI + tok * 2 + 1] = i2x; inv[e1 * 16384 + i1x] = tok; inv[e2 * 16384 + i2x] = tok; }
    }
}

template <int WHICH> __device__ __forceinline__ void ph_moe_gemm(const Params& p, int layer, unsigned char* smem) {
    const int* cnt = (const int*)(p.ws + CNT_OFF) + layer * 1024;
    __shared__ int eoff[17]; const int tix = ptid();
    if (tix == 0) { int o = 0; for (int e = 0; e < 16; ++e) { eoff[e] = o; o += (cnt[e * 64] + 255) & ~255; } eoff[16] = o; }
    __syncthreads();
    const int Mt = eoff[16] >> 8;
    for (int t = blockIdx.x; t < Mt * 8; t += gridDim.x) {
        const int mt = t >> 3, nt = t & 7, row0 = mt << 8;
        int e = 0;
        while (e < 15 && row0 >= eoff[e + 1]) ++e;
        if (WHICH == 0) {
            const int* inv = (const int*)(p.ws + MOE_INV) + e * 16384; const int ne = cnt[e * 64], i0 = row0 - eoff[e] + (tix >> 3);
            const bf16_t* ap[4];
#pragma unroll
            for (int i = 0; i < 4; ++i) { const int ix = i0 + 64 * i; ap[i] = (const bf16_t*)(p.ws + H_BF) + (size_t)inv[ix < ne ? ix : 0] * 1024 + (tix & 7) * 8; }
            const bf16_t* Bt = (const bf16_t*)(p.ws + MOEW_GU) + ((size_t)e * 1024 + nt * 128) * 1024;
            gemm_tile_rows(ap, Bt, 1024, 1024, EpiSwiglu{{}, (bf16_t*)p.out + (size_t)row0 * 512 + nt * 64, 512}, smem);
        } else {
            const bf16_t* A = (const bf16_t*)p.out + (size_t)row0 * 512;
            const bf16_t* Bt = (const bf16_t*)(p.ws + MOEW_D) + ((size_t)e * 1024 + nt * 128) * 512;
            gemm_tile(A, 512, Bt, 512, 512, EpiBf16{{}, (bf16_t*)(p.ws + YEXP) + (size_t)row0 * 1024 + nt * 128, 1024}, smem);
        }
    }
}

struct EpiKvq : EpiBase { const Params* p; int m0, n0; int wm_, fr_, hbase; bool isk; float nrm, mx;
    __device__ __forceinline__ void start(int wm, int wn, int fr, int) { wm_ = wm; fr_ = fr; hbase = n0 + wn * 64; const int sec = n0 >> 8; isk = sec == 0 || sec == 2 || sec == 4; nrm = 0.f; mx = 0.f; }
    __device__ __forceinline__ void operator()(int m, int n, f32x4 v) {
        const size_t tok = (size_t)(m0 + m); const int c = n0 + n, sec = n0 >> 8;
        bf16_t* row = (bf16_t*)(p->ws + KVQ) + tok * KVQ_LD;
        if (sec == 1 || sec == 3 || sec == 5) { *(u32x2*)(row + c) = (u32x2){pack2(v[0], v[1]), pack2(v[2], v[3])}; }
        else if (sec < 10) {
            const int d = (c & 63) >> 1, t = (int)tok & (S_ - 1);
            const f32x4 cs = *(const f32x4*)((const float*)(p->ws + ROPE_NT) + ((size_t)t * 32 + d) * 2);
            const float sc = sec >= 6 ? 0.125f : 1.f;
            const float a0 = (v[0] * cs[0] - v[1] * cs[1]) * sc, b0 = (v[1] * cs[0] + v[0] * cs[1]) * sc, a1 = (v[2] * cs[2] - v[3] * cs[3]) * sc, b1 = (v[3] * cs[2] + v[2] * cs[3]) * sc;
            bf16_t* dst = row + (c & ~63) + d;
            *(unsigned*)dst = pack2(a0, a1); *(unsigned*)(dst + 32) = pack2(b0, b1);
            nrm += a0 * a0 + b0 * b0 + a1 * a1 + b1 * b1;
        } else if (c < 2608) {
            float* gt = (float*)(p->ws + GATES) + tok * 48 + (c - 2560);
            *(f32x4*)gt = (f32x4){1.f / (1.f + __expf(-v[0])), 1.f / (1.f + __expf(-v[1])), 1.f / (1.f + __expf(-v[2])), 1.f / (1.f + __expf(-v[3]))};
        }
    }
    __device__ __forceinline__ void row_done(int) { float r = nrm; r += __shfl_xor(r, 16); r += __shfl_xor(r, 32); mx = fmaxf(mx, r); nrm = 0.f; }
    __device__ __forceinline__ void finish() {
        if (isk) { const float m = wave_max(mx); if ((ptid() & 63) == 0) atomicMax((int*)(p->ws + MISC) + MI_KMAX + ((n0 >> 9) * 2 + (m0 >> 13)) * 4 + ((hbase & 255) >> 6), __float_as_int(sqrtf(m) * 1.01f + 1e-6f)); }
    }
};
__device__ __forceinline__ void ph_gemm_kvq(const Params& p, unsigned char* smem) {
    const bf16_t* A = (const bf16_t*)(p.ws + H_BF); const bf16_t* Bt = (const bf16_t*)(p.ws + WT_KVQ);
    for (int t = blockIdx.x; t < 64 * (KVQ_LD / 128); t += gridDim.x) {
        const int mt = t / (KVQ_LD / 128), nt = t % (KVQ_LD / 128);
        EpiKvq e{}; e.p = &p; e.m0 = mt * 256; e.n0 = nt * 128;
        gemm_tile(A + (size_t)mt * 256 * 1024, 1024, Bt + (size_t)nt * 128 * 1024, 1024, 1024, e, smem);
    }
}

#define PG8_LDS(ptr) ((PG8_LAS unsigned char*)(ptr))
__device__ __forceinline__ void ph_gemm_retin8(const Params& p, unsigned char* smem) {
    const pg8::Gemm g{(const bf16_t*)(p.ws + XB), (const bf16_t*)(p.ws + WT_IN), T_, 6144, 1024}; pg8::StaticOrder S; S.init(T_, 6144, (int)gridDim.x, (int)blockIdx.x);
    const pg8::EpiRetInP E{&p};
    pg8::gemm_phase<pg8::EpiRetInP, pg8::StaticOrder, true, true>(PG8_LDS(smem), g, S, E);
}
__device__ __forceinline__ void ph_gemm_f32_8(const bf16_t* A, const bf16_t* Bt, float* C, int N, int K, unsigned char* smem) {
    const pg8::Gemm g{A, Bt, T_, N, K}; pg8::StaticOrder S; S.init(T_, N, (int)gridDim.x, (int)blockIdx.x);
    const pg8::EpiF32P E{C, N};
    pg8::gemm_phase<pg8::EpiF32P, pg8::StaticOrder, true, true>(PG8_LDS(smem), g, S, E);
}
__device__ __forceinline__ void ph_gemm_kvq8(const Params& p, unsigned char* smem) {
    const pg8::Gemm g{(const bf16_t*)(p.ws + H_BF), (const bf16_t*)(p.ws + WT_KVQ), T_, KVQ_N, 1024}; pg8::StaticOrder S; S.init(T_, KVQ_N, (int)gridDim.x, (int)blockIdx.x);
    const pg8::EpiKvqP E{&p};
    pg8::gemm_phase<pg8::EpiKvqP, pg8::StaticOrder, true, true>(PG8_LDS(smem), g, S, E);
}
__device__ __forceinline__ void ph_moe_up8(const Params& p, int layer, unsigned char* smem) {
    const int* cnt = (const int*)(p.ws + CNT_OFF) + layer * 1024;
    int* eoff = (int*)(smem + 131072 + 1024);
    if (ptid() == 0) { int o = 0; for (int e = 0; e < 16; ++e) { eoff[e] = o; o += (cnt[e * 64] + 255) & ~255; } eoff[16] = o; }
    __syncthreads();
    const pg8::Gemm g{(const bf16_t*)(p.ws + H_BF), (const bf16_t*)(p.ws + (layer ? MOEW1_GU : MOEW_GU)), eoff[16], 16 * 1024, 1024};
    const pg8::GroupedGatherOrder S{eoff, cnt, (const int*)(p.ws + MOE_INV), (eoff[16] >> 8) * 4, (int)gridDim.x, (int)blockIdx.x};
    const pg8::EpiSwigluP E{(bf16_t*)p.out};
    pg8::gemm_phase<pg8::EpiSwigluP, pg8::GroupedGatherOrder, true, true, true>(PG8_LDS(smem), g, S, E);
}
__device__ __forceinline__ void ph_moe_down8(const Params& p, int layer, unsigned char* smem) {
    const int* cnt = (const int*)(p.ws + CNT_OFF) + layer * 1024;
    int* eoff = (int*)(smem + 131072 + 1024);
    if (ptid() == 0) { int o = 0; for (int e = 0; e < 16; ++e) { eoff[e] = o; o += (cnt[e * 64] + 255) & ~255; } eoff[16] = o; }
    __syncthreads();
    const pg8::Gemm g{(const bf16_t*)p.out, (const bf16_t*)(p.ws + (layer ? MOEW1_D : MOEW_D)), eoff[16], 16 * 1024, 512};
    const pg8::GroupedOrder S{eoff, (eoff[16] >> 8) * 4, (int)gridDim.x, (int)blockIdx.x};
    const pg8::EpiBf16P E{(bf16_t*)(p.ws + YEXP), 1024, 3};
    pg8::gemm_phase<pg8::EpiBf16P, pg8::GroupedOrder, true, true>(PG8_LDS(smem), g, S, E);
}
__device__ __forceinline__ void moe_tail_convert(const Params& p, int layer, unsigned char* smem, int tb, int te) {
    const int* cnt = (const int*)(p.ws + CNT_OFF) + layer * 1024;
    int MT = 0; for (int e = 0; e < 16; ++e) MT += (cnt[e * 64] + 255) >> 8;
    const int G = (int)gridDim.x, c = (int)blockIdx.x;
    if (G != 256) { moe_weights_range(p, 1, smem, tb, te, c, G); return; }
    const int x = c & 7, pw = c >> 3;
    int before = 0, total = 0, mine = -1;
    for (int xx = 0; xx < 8; ++xx) { const int Ux = 4 * ((MT - xx + 7) >> 3), hv = Ux > 64 ? (Ux - 64 < 32 ? Ux - 64 : 32) : 0;
        if (xx == x) mine = pw >= hv ? total + (pw - hv) : -1; total += 32 - hv; (void)before; }
    if (total == 0) { moe_weights_range(p, 1, smem, tb, te, c, G); return; }
    if (mine >= 0) moe_weights_range(p, 1, smem, tb, te, mine, total);
}
__device__ __forceinline__ void ph_vt(const Params& p) {
    const bf16_t* kvq = (const bf16_t*)(p.ws + KVQ);
    const int tix = ptid(), lane = tix & 63;
    const bool split = gridDim.x > 128; if (split && blockIdx.x < 64) return;
    const int nbl = split ? (int)gridDim.x - 64 : (int)gridDim.x, bl = split ? (int)blockIdx.x - 64 : (int)blockIdx.x;
    for (int it = (tix >> 6) * nbl + bl; it < 2048; it += nbl * (NT / 64)) {
        const int part = it >> 10, bg = (it >> 7) & 7, blk = it & 127, b = bg >> 2, g = bg & 3;
        const bf16_t* src = kvq + ((size_t)b * S_ + blk * 64 + lane) * KVQ_LD + (part ? 1280 : 768) + g * 64;
        const int kpos = (lane & ~31) + 8 * ((lane & 15) >> 2) + 4 * ((lane & 31) >> 4) + (lane & 3);
        bf16_t* dst = (bf16_t*)(p.ws + (part ? VWT : VST)) + (size_t)(bg * 128 + blk) * 4096 + kpos;
        u32x4 v[8];
#pragma unroll
        for (int c = 0; c < 8; ++c) v[c] = *(const u32x4*)(src + c * 8);
#pragma unroll
        for (int c = 0; c < 8; ++c)
#pragma unroll
            for (int e = 0; e < 4; ++e) { dst[(c * 8 + e * 2) * 64] = (bf16_t)(v[c][e] & 0xffffu); dst[(c * 8 + e * 2 + 1) * 64] = (bf16_t)(v[c][e] >> 16); }
    }
}
struct EpiCmp2 : EpiBase { const Params* p; int kv, bg, mt; int wn_; float nrm, mx;
    __device__ __forceinline__ void start(int, int wn, int, int) { wn_ = wn; nrm = 0.f; mx = 0.f; }
    __device__ __forceinline__ void operator()(int m, int n, f32x4 v) {
        if (wn_ != 0) return;
        const int row = mt * 256 + m;
        if (row == 511) v = (f32x4){0.f, 0.f, 0.f, 0.f};
        if (kv == 0) { *(u32x2*)((bf16_t*)(p->ws + KCMPB) + (size_t)(bg * 512 + row) * 64 + n) = (u32x2){pack2(v[0], v[1]), pack2(v[2], v[3])}; nrm += v[0] * v[0] + v[1] * v[1] + v[2] * v[2] + v[3] * v[3]; }
        else { const int rp = (row & ~31) + 8 * ((row & 15) >> 2) + 4 * ((row & 31) >> 4) + (row & 3);
            bf16_t* vt = (bf16_t*)(p->ws + VCMPT) + (size_t)(bg * 64 + n) * 512 + rp; vt[0] = f2bf(v[0]); vt[512] = f2bf(v[1]); vt[1024] = f2bf(v[2]); vt[1536] = f2bf(v[3]); }
    }
    __device__ __forceinline__ void row_done(int) { float r = nrm; r += __shfl_xor(r, 16); r += __shfl_xor(r, 32); mx = fmaxf(mx, r); nrm = 0.f; }
    __device__ __forceinline__ void finish() { if (kv == 0 && wn_ == 0) { const float m = wave_max(mx); if ((ptid() & 63) == 0) atomicMax((int*)(p->ws + MISC) + MI_KMAXC + bg, __float_as_int(sqrtf(m) * 1.01f + 1e-6f)); } }
};
__device__ __forceinline__ void ph_cmp2(const Params& p, unsigned char* smem) {
    for (int t = blockIdx.x; t < 32; t += gridDim.x) {
        const int mt = t & 1, bg = (t >> 1) & 7, kv = t >> 4;
        EpiCmp2 e{}; e.p = &p; e.kv = kv; e.bg = bg; e.mt = mt;
        gemm_tile((const bf16_t*)(p.ws + HC) + (size_t)((kv * 8 + bg) * 512 + mt * 256) * 256, 256, (const bf16_t*)(p.ws + WT_CW2) + (size_t)kv * 128 * 256, 256, 256, e, smem);
    }
}
__device__ __forceinline__ float quad_xor1(float v) { return __int_as_float(__builtin_amdgcn_mov_dpp(__float_as_int(v), 0xB1, 0xF, 0xF, true)); }
__device__ __forceinline__ float quad_xor2(float v) { return __int_as_float(__builtin_amdgcn_mov_dpp(__float_as_int(v), 0x4E, 0xF, 0xF, true)); }
__device__ __forceinline__ void lds_barrier() { asm volatile("s_waitcnt lgkmcnt(0)" ::: "memory"); __builtin_amdgcn_s_barrier(); asm volatile("" ::: "memory"); }
constexpr int KT_LD = 80;
constexpr int A2_BUF = 0, A2_BUFSZ = 2 * 64 * KT_LD * 2, A2_IMP = 4 * A2_BUFSZ, A2_TM = A2_IMP + 32768, A2_OR = A2_TM + 1024, A2_END = A2_OR + 16;
static_assert(A2_END <= LDS_BYTES - 16, "attention LDS");
constexpr float LOG2E = 1.4426950408889634f;
struct BlkSrc { const bf16_t* K; int ldk; const bf16_t* VT; int ldv; };
__device__ __forceinline__ int next_bit128(const unsigned (&m)[4], int j) {
    for (int k = j + 1; k < 128; ++k) if ((m[k >> 5] >> (k & 31)) & 1u) return k;
    return 128;
}
template <int BR> __device__ __forceinline__ void attn_branch(const Params& p, unsigned char* smem, const unsigned (&orm)[4], int bg, int cur, const float (&mrow)[2],
                                                               const float (&invl)[2], f32x4 (&Lacc)[2], f32x4 (&Oacc)[2][4], const bf16x8 (&Qs)[2][2]) {
    const int tid = ptid(), lane = tid & 63, w = __builtin_amdgcn_readfirstlane(tid >> 6), g = lane >> 4, i16 = lane & 15;
    const int b = bg >> 2, g4 = bg & 3;
    const bf16_t* kvq = (const bf16_t*)(p.ws + KVQ);
    float* imp = (float*)(smem + A2_IMP);
    const unsigned onew = i16 == 0 ? 0x3f803f80u : 0u; const bf16x8 onesf = __builtin_bit_cast(bf16x8, (u32x4){onew, onew, onew, onew});
    const int srow = tid >> 3, sch = tid & 7;
    auto src = [&](int j) -> BlkSrc {
        if (BR <= 1) return BlkSrc{(const bf16_t*)(p.ws + KCMPB) + (size_t)(bg * 512 + j * 64) * 64, 64, (const bf16_t*)(p.ws + VCMPT) + (size_t)bg * 64 * 512 + j * 64, 512};
        if (BR == 2) return BlkSrc{kvq + ((size_t)b * S_ + j * 64) * KVQ_LD + 512 + g4 * 64, KVQ_LD, (const bf16_t*)(p.ws + VST) + (size_t)(bg * 128 + j) * 4096, 64};
        return BlkSrc{kvq + ((size_t)b * S_ + j * 64) * KVQ_LD + 1024 + g4 * 64, KVQ_LD, (const bf16_t*)(p.ws + VWT) + (size_t)(bg * 128 + j) * 4096, 64};
    };
    u32x4 rk[2], rv[2];
    auto ld = [&](u32x4& rk, u32x4& rv, int j) { const BlkSrc s = src(j); rk = *(const u32x4*)(s.K + (size_t)srow * s.ldk + sch * 8); if (BR != 1) rv = *(const u32x4*)(s.VT + (size_t)srow * s.ldv + sch * 8); };
    auto st = [&](const u32x4& rk, const u32x4& rv, int bi) {
        bf16_t* buf = (bf16_t*)(smem + A2_BUF + bi * A2_BUFSZ);
        *(u32x4*)(buf + srow * KT_LD + sch * 8) = rk;
        if (BR != 1) *(u32x4*)(buf + 64 * KT_LD + srow * KT_LD + sch * 8) = rv;
    };
    auto process = [&](int j, int bi) {
        const bf16_t* Kt = (const bf16_t*)(smem + A2_BUF + bi * A2_BUFSZ); const bf16_t* Vt = Kt + 64 * KT_LD;
        bool need[2]; unsigned selb[2];
#pragma unroll
        for (int bt = 0; bt < 2; ++bt) { selb[bt] = BR == 2 ? ((((const unsigned*)(smem + A2_TM))[(8 * w + 4 * bt + (i16 >> 2)) * 4 + (j >> 5)] >> (j & 31)) & 1u) : 1u; need[bt] = BR == 2 ? (__ballot(selb[bt] != 0u) != 0ull) : true; }
        if (need[0] || need[1]) {
            bf16x8 Kf[4][2];
#pragma unroll
            for (int mt = 0; mt < 4; ++mt) { Kf[mt][0] = *(const bf16x8*)(Kt + (16 * mt + i16) * KT_LD + 8 * g); Kf[mt][1] = *(const bf16x8*)(Kt + (16 * mt + i16) * KT_LD + 32 + 8 * g); }
#pragma unroll
            for (int bt = 0; bt < 2; ++bt) {
                if (!need[bt]) continue;
                const int tq = 8 * w + 4 * bt + (i16 >> 2);
                const bf16x8 Qf0 = Qs[bt][0], Qf1 = Qs[bt][1];
                const float msel = selb[bt] != 0u ? mrow[bt] : __builtin_inff();
                f32x4 St[4];
                const bool edge = BR <= 1 ? (64 * j + 63 > ((64 * cur + 8 * w - 31) >> 4)) : (j == cur || (BR == 3 && j == cur - 8));
                if (!edge) {
                    const f32x4 sinit = {-msel, -msel, -msel, -msel};
#pragma unroll
                    for (int mt = 0; mt < 4; ++mt) St[mt] = __builtin_amdgcn_mfma_f32_16x16x32_bf16(Kf[mt][0], Qf0, sinit, 0, 0, 0);
#pragma unroll
                    for (int mt = 0; mt < 4; ++mt) St[mt] = __builtin_amdgcn_mfma_f32_16x16x32_bf16(Kf[mt][1], Qf1, St[mt], 0, 0, 0);
                } else {
                    int lo = 0, hi = 63;
                    if (BR <= 1) hi = ((64 * cur + tq - 31) >> 4) - 64 * j;
                    if (BR >= 2 && j == cur) hi = tq;
                    if (BR == 3 && j == cur - 8) lo = tq + 1;
                    const int k0 = 4 * g - lo, k1 = hi - 4 * g;
#pragma unroll
                    for (int mt = 0; mt < 4; ++mt)
#pragma unroll
                        for (int r = 0; r < 4; ++r) St[mt][r] = (16 * mt + r + k0 >= 0 && 16 * mt + r <= k1) ? -msel : -__builtin_inff();
#pragma unroll
                    for (int mt = 0; mt < 4; ++mt) St[mt] = __builtin_amdgcn_mfma_f32_16x16x32_bf16(Kf[mt][0], Qf0, St[mt], 0, 0, 0);
#pragma unroll
                    for (int mt = 0; mt < 4; ++mt) St[mt] = __builtin_amdgcn_mfma_f32_16x16x32_bf16(Kf[mt][1], Qf1, St[mt], 0, 0, 0);
                }
#pragma unroll
                for (int mt = 0; mt < 4; ++mt)
#pragma unroll
                    for (int r = 0; r < 4; ++r) St[mt][r] = __builtin_amdgcn_exp2f(St[mt][r]);
                if (BR == 1) {
#pragma unroll
                    for (int mt = 0; mt < 4; ++mt) {
                        float s4 = (St[mt][0] + St[mt][1] + St[mt][2] + St[mt][3]) * invl[bt], p3 = St[mt][3] * invl[bt];
                        s4 += quad_xor1(s4); s4 += quad_xor2(s4); p3 += quad_xor1(p3); p3 += quad_xor2(p3);
                        const int sb = 16 * j + 4 * mt + g;
                        if ((i16 & 3) == 0) { atomicAdd(&imp[tq * 128 + sb], s4); if (sb + 1 < 128) atomicAdd(&imp[tq * 128 + sb + 1], p3); }
                    }
                } else {
                    bf16x8 Vf[4][2];
#pragma unroll
                    for (int dt = 0; dt < 4; ++dt) { Vf[dt][0] = *(const bf16x8*)(Vt + (16 * dt + i16) * KT_LD + 8 * g); Vf[dt][1] = *(const bf16x8*)(Vt + (16 * dt + i16) * KT_LD + 32 + 8 * g); }
                    const bf16x8 Pf0 = pack_frag(St[0], St[1]), Pf1 = pack_frag(St[2], St[3]);
#pragma unroll
                    for (int dt = 0; dt < 4; ++dt) Oacc[bt][dt] = __builtin_amdgcn_mfma_f32_16x16x32_bf16(Vf[dt][0], Pf0, Oacc[bt][dt], 0, 0, 0);
#pragma unroll
                    for (int dt = 0; dt < 4; ++dt) Oacc[bt][dt] = __builtin_amdgcn_mfma_f32_16x16x32_bf16(Vf[dt][1], Pf1, Oacc[bt][dt], 0, 0, 0);
                    Lacc[bt] = __builtin_amdgcn_mfma_f32_16x16x32_bf16(onesf, Pf0, Lacc[bt], 0, 0, 0);
                    Lacc[bt] = __builtin_amdgcn_mfma_f32_16x16x32_bf16(onesf, Pf1, Lacc[bt], 0, 0, 0);
                }
            }
        }
    };
    int a0 = next_bit128(orm, -1);
    if (a0 >= 128) return;
    const int jsafe = a0;
    int b0 = next_bit128(orm, a0), a1 = b0 < 128 ? next_bit128(orm, b0) : 128, b1 = a1 < 128 ? next_bit128(orm, a1) : 128;
    ld(rk[0], rv[0], a0); ld(rk[1], rv[1], b0 < 128 ? b0 : jsafe);
    lds_barrier();
    st(rk[0], rv[0], 0); st(rk[1], rv[1], 1);
    ld(rk[0], rv[0], a1 < 128 ? a1 : jsafe); ld(rk[1], rv[1], b1 < 128 ? b1 : jsafe);
    lds_barrier();
    int sg = 0;
    for (;;) {
        const int a2 = b1 < 128 ? next_bit128(orm, b1) : 128, b2 = a2 < 128 ? next_bit128(orm, a2) : 128;
        process(a0, 2 * sg);
        st(rk[0], rv[0], 2 * (sg ^ 1)); st(rk[1], rv[1], 2 * (sg ^ 1) + 1);
        ld(rk[0], rv[0], a2 < 128 ? a2 : jsafe); ld(rk[1], rv[1], b2 < 128 ? b2 : jsafe);
        if (b0 < 128) process(b0, 2 * sg + 1);
        lds_barrier();
        if (a1 >= 128) break;
        a0 = a1; b0 = b1; a1 = a2; b1 = b2; sg ^= 1;
    }
}
__device__ __forceinline__ void ph_attn(const Params& p, unsigned char* smem) {
    const bf16_t* kvq = (const bf16_t*)(p.ws + KVQ); const float* gates = (const float*)(p.ws + GATES); const int* misc = (const int*)(p.ws + MISC);
    bf16_t* ao = (bf16_t*)(p.ws + ATTN_OUT);
    float* imp = (float*)(smem + A2_IMP); unsigned* tmask = (unsigned*)(smem + A2_TM); unsigned* tor = (unsigned*)(smem + A2_OR);
    const int tid = ptid(), lane = tid & 63, w = __builtin_amdgcn_readfirstlane(tid >> 6), g = lane >> 4, i16 = lane & 15;
    if (w >= 4) __builtin_amdgcn_s_setprio(1);
    for (int u = blockIdx.x; u < 1024; u += gridDim.x) {
        const int bg = u & 7, c5 = (u >> 3) & 31, kq = u >> 8;
        const int cur = kq == 0 ? c5 : (kq == 1 ? 63 - c5 : (kq == 2 ? 64 + c5 : 127 - c5));
        const int b = bg >> 2, g4 = bg & 3; const size_t tok0 = (size_t)b * S_ + cur * 64;
        bf16x8 Qf[2][2]; float qn[2];
        const int head = g4 * 4 + (i16 & 3);
#pragma unroll
        for (int bt = 0; bt < 2; ++bt) {
            const size_t tok = tok0 + 8 * w + 4 * bt + (i16 >> 2);
            const bf16_t* qp = kvq + tok * KVQ_LD + 1536 + head * 64 + 8 * g;
            Qf[bt][0] = *(const bf16x8*)qp; Qf[bt][1] = *(const bf16x8*)(qp + 32);
            float f[16]; unpack8(__builtin_bit_cast(u32x4, Qf[bt][0]), f); unpack8(__builtin_bit_cast(u32x4, Qf[bt][1]), f + 8);
            float s = 0.f;
#pragma unroll
            for (int k = 0; k < 16; ++k) s += f[k] * f[k];
            s += __shfl_xor(s, 16); s += __shfl_xor(s, 32);
            qn[bt] = sqrtf(s) * 1.01f + 1e-6f;
        }
        __syncthreads();
#pragma unroll
        for (int bt = 0; bt < 2; ++bt) {
            float f[16]; unpack8(__builtin_bit_cast(u32x4, Qf[bt][0]), f); unpack8(__builtin_bit_cast(u32x4, Qf[bt][1]), f + 8);
            u32x4 q0, q1;
#pragma unroll
            for (int k = 0; k < 4; ++k) { q0[k] = pack2(f[2 * k] * LOG2E, f[2 * k + 1] * LOG2E); q1[k] = pack2(f[8 + 2 * k] * LOG2E, f[9 + 2 * k] * LOG2E); }
            Qf[bt][0] = __builtin_bit_cast(bf16x8, q0); Qf[bt][1] = __builtin_bit_cast(bf16x8, q1); }
        for (int k = lane; k < 8 * 128; k += 64) imp[w * 8 * 128 + k] = 0.f;
        if (tid < 4) tor[tid] = 0u;
        f32x4 Oacc[2][4], Lacc[2] = {(f32x4){0.f, 0.f, 0.f, 0.f}, (f32x4){0.f, 0.f, 0.f, 0.f}}; float mrow[2], invl[2] = {0.f, 0.f};
#pragma unroll
        for (int bt = 0; bt < 2; ++bt) {
#pragma unroll
            for (int dt = 0; dt < 4; ++dt) Oacc[bt][dt] = (f32x4){0.f, 0.f, 0.f, 0.f};
        }
        auto norml = [&]() {
#pragma unroll
            for (int bt = 0; bt < 2; ++bt) { const float l = __shfl(Lacc[bt][0], i16); invl[bt] = l > 0.f ? 1.f / l : 0.f; Lacc[bt] = (f32x4){0.f, 0.f, 0.f, 0.f}; }
        };
        auto finish = [&](int c) {
#pragma unroll
            for (int bt = 0; bt < 2; ++bt) {
                const size_t tokc = tok0 + 8 * w + 4 * bt + (i16 >> 2);
                const float sc = gates[tokc * 48 + head * 3 + c] * invl[bt];
                u32x2* slot = (u32x2*)(smem + A2_IMP) + ((w * 2 + bt) * 4) * 64 + lane;
#pragma unroll
                for (int dt = 0; dt < 4; ++dt) { f32x4 o = Oacc[bt][dt] * sc;
                    if (c > 0) { const u32x2 q = slot[dt * 64]; o[0] += __uint_as_float(q[0] << 16); o[1] += __uint_as_float(q[0] & 0xffff0000u); o[2] += __uint_as_float(q[1] << 16); o[3] += __uint_as_float(q[1] & 0xffff0000u); }
                    const u32x2 r = {pack2(o[0], o[1]), pack2(o[2], o[3])};
                    if (c < 2) slot[dt * 64] = r; else *(u32x2*)(ao + tokc * 1024 + head * 64 + 4 * g + 16 * dt) = r;
                    Oacc[bt][dt] = (f32x4){0.f, 0.f, 0.f, 0.f}; }
            }
        };
        {
            const int nblk = min(8, (4 * cur + 2) / 64 + 1);
            unsigned orm[4] = {(1u << nblk) - 1u, 0u, 0u, 0u};
            const float kmx = __int_as_float(misc[MI_KMAXC + bg]);
            mrow[0] = qn[0] * kmx * LOG2E; mrow[1] = qn[1] * kmx * LOG2E;
            attn_branch<0>(p, smem, orm, bg, cur, mrow, invl, Lacc, Oacc, Qf);
            norml();
            attn_branch<1>(p, smem, orm, bg, cur, mrow, invl, Lacc, Oacc, Qf);
        }
        for (int k = 0; k < 8; k += 2) {
            unsigned ka[2][2]; unsigned T[2] = {0u, 0u};
#pragma unroll
            for (int u = 0; u < 2; ++u) {
                const int tl = w * 8 + k + u;
                { const int s = lane; const bool valid = s <= cur, forced = (s == 0) || (s == cur) || (s == cur - 1); ka[u][0] = valid ? __float_as_uint(imp[tl * 128 + s] + (forced ? 1000.f : 0.f)) + 1u : 0u; }
                { const int s = lane + 64; const bool valid = s <= cur, forced = (s == 0) || (s == cur) || (s == cur - 1); ka[u][1] = valid ? __float_as_uint(imp[tl * 128 + s] + (forced ? 1000.f : 0.f)) + 1u : 0u; }
            }
            bool ex[2] = {false, false};
#pragma unroll 1
            for (int bit = 30; bit >= 0; --bit) {
#pragma unroll
                for (int u = 0; u < 2; ++u) {
                    const unsigned cand = T[u] | (1u << bit);
                    const int cnt = __builtin_popcountll(__ballot(ka[u][0] >= cand)) + __builtin_popcountll(__ballot(ka[u][1] >= cand));
                    T[u] = cnt >= 16 ? cand : T[u]; ex[u] = ex[u] || cnt == 16;
                }
                if (ex[0] && ex[1]) break;
            }
#pragma unroll
            for (int u = 0; u < 2; ++u) {
                const int tl = w * 8 + k + u;
                unsigned long long s0 = __ballot(ka[u][0] > T[u]), s1 = __ballot(ka[u][1] > T[u]), e0 = __ballot(ka[u][0] == T[u]), e1 = __ballot(ka[u][1] == T[u]);
                int need = 16 - __builtin_popcountll(s0) - __builtin_popcountll(s1);
                while (need > 0 && e0) { const unsigned long long low = e0 & (~e0 + 1ull); s0 |= low; e0 ^= low; --need; }
                while (need > 0 && e1) { const unsigned long long low = e1 & (~e1 + 1ull); s1 |= low; e1 ^= low; --need; }
                const unsigned long long v0 = cur >= 63 ? ~0ull : ((1ull << (cur + 1)) - 1ull), v1 = cur >= 127 ? ~0ull : (cur >= 64 ? ((1ull << (cur - 63)) - 1ull) : 0ull);
                s0 &= v0; s1 &= v1;
                const unsigned m0 = (unsigned)s0, m1 = (unsigned)(s0 >> 32), m2 = (unsigned)s1, m3 = (unsigned)(s1 >> 32);
                if (lane == 0) { tmask[tl * 4] = m0; tmask[tl * 4 + 1] = m1; tmask[tl * 4 + 2] = m2; tmask[tl * 4 + 3] = m3; atomicOr(&tor[0], m0); atomicOr(&tor[1], m1); atomicOr(&tor[2], m2); atomicOr(&tor[3], m3); }
            }
        }
        __syncthreads();
        finish(0);
        {
            unsigned orm[4];
#pragma unroll
            for (int k = 0; k < 4; ++k) orm[k] = __builtin_amdgcn_readfirstlane(tor[k]);
            const float kmx = sqrtf(__int_as_float(misc[MI_KMAX + ((1 * 2 + b) * 4 + g4) * 2]) + __int_as_float(misc[MI_KMAX + ((1 * 2 + b) * 4 + g4) * 2 + 1])) * 1.01f + 1e-6f;
            mrow[0] = qn[0] * kmx * LOG2E; mrow[1] = qn[1] * kmx * LOG2E;
            attn_branch<2>(p, smem, orm, bg, cur, mrow, invl, Lacc, Oacc, Qf);
            norml(); finish(1);
        }
        {
            unsigned orm[4] = {0u, 0u, 0u, 0u};
            for (int jj = max(0, cur - 8); jj <= cur; ++jj) orm[jj >> 5] |= 1u << (jj & 31);
            const float kmx = sqrtf(__int_as_float(misc[MI_KMAX + ((2 * 2 + b) * 4 + g4) * 2]) + __int_as_float(misc[MI_KMAX + ((2 * 2 + b) * 4 + g4) * 2 + 1])) * 1.01f + 1e-6f;
            mrow[0] = qn[0] * kmx * LOG2E; mrow[1] = qn[1] * kmx * LOG2E;
            attn_branch<3>(p, smem, orm, bg, cur, mrow, invl, Lacc, Oacc, Qf);
            norml(); finish(2);
        }
    }
    __builtin_amdgcn_s_setprio(0);
}

struct EpiGeluBias : EpiBase { bf16_t* C; int ldc; const float* bias;
    __device__ __forceinline__ void operator()(int m, int n, f32x4 v) const {
        float y[4];
#pragma unroll
        for (int i = 0; i < 4; ++i) { const float x = v[i] + bias[n + i]; const float u2 = 1.5957691216057308f * (x + 0.044715f * x * x * x); y[i] = x / (1.f + __expf(-u2)); }
        *(u32x2*)(C + (size_t)m * ldc + n) = (u32x2){pack2(y[0], y[1]), pack2(y[2], y[3])}; } };
__device__ __forceinline__ void ph_cmp_gemm(const Params& p, unsigned char* smem) {
    const bf16_t* kvq = (const bf16_t*)(p.ws + KVQ); const float* pew = (const float*)(p.ws + MISC) + MI_PEW;
    for (int t = blockIdx.x; t < 64; t += gridDim.x) {
        const int nt = t & 1, mt = (t >> 1) & 1, bg = (t >> 2) & 7, kv = t >> 5, b = bg >> 2, g = bg & 3;
        const bf16_t* A = kvq + ((size_t)b * S_ + 16 * (mt * 256)) * KVQ_LD + kv * 256 + g * 64;
        const bf16_t* Bt = (const bf16_t*)(p.ws + WT_CW1) + (size_t)(kv * 256 + nt * 128) * 2048;
        bf16_t* C = (bf16_t*)(p.ws + HC) + (size_t)((kv * 8 + bg) * 512 + mt * 256) * 256 + nt * 128;
        gemm_tile(A, 16 * KVQ_LD, Bt, 2048, 2048, EpiGeluBias{{}, C, 256, pew + kv * 256 + nt * 128}, smem, KVQ_LD);
    }
}

#define XB_TMO      128
#define XB_XCNT(j)  (256  + 64 * (j))
#define XB_XSUB(j)  (1280 + 64 * (j))
#define XB_XGEN(j)  (2304 + 64 * (j))
#define XB_TOP      3328
#define XB_TOPGEN   3392
#define XCD_BAR_WORDS 3456
#define XB_SPIN_CAP (1u << 20)
#define LAS __attribute__((address_space(3)))
__device__ __forceinline__ unsigned xb_ld(unsigned* p) { return __hip_atomic_load(p, __ATOMIC_RELAXED, __HIP_MEMORY_SCOPE_AGENT); }
__device__ __forceinline__ unsigned xb_add(unsigned* p, unsigned v) { return __hip_atomic_fetch_add(p, v, __ATOMIC_RELAXED, __HIP_MEMORY_SCOPE_AGENT); }
__device__ __forceinline__ unsigned xb_xcc_id() { return (unsigned)__builtin_amdgcn_s_getreg((3 << 11) | 20) & 0xFu; }
#define XB_SPIN(cond, bar) do { unsigned _sp = 0; while (cond) { __builtin_amdgcn_s_sleep(1); \
    if ((++_sp & 255u) == 0u) { if (xb_ld(&(bar)[XB_TMO])) break; if (_sp > XB_SPIN_CAP) { atomicAdd(&(bar)[XB_TMO], 1u); break; } } } } while (0)
struct XcdBarrier { unsigned* bar; unsigned x; volatile LAS unsigned* st; };
__device__ __forceinline__ XcdBarrier xcd_barrier_post(unsigned* bar, volatile LAS unsigned* st) {
    XcdBarrier b; b.bar = bar; b.x = xb_xcc_id(); b.st = st;
    if (threadIdx.x == 0) (void)xb_add(&bar[XB_XCNT(b.x)], 1u);
    return b;
}
__device__ __forceinline__ void xcd_barrier_complete(unsigned* bar, unsigned x, unsigned& nloc, unsigned& nx) {
    const unsigned G = gridDim.x * gridDim.y * gridDim.z;
    unsigned sum, cnt, mine, sp = 0u;
    for (;;) {
        sum = 0u; cnt = 0u; mine = 0u;
#pragma unroll
        for (unsigned j = 0; j < 16; ++j) { const unsigned c = xb_ld(&bar[XB_XCNT(j)]); sum += c; cnt += (c > 0u) ? 1u : 0u; mine = (j == x) ? c : mine; }
        if (sum == G) break;
        __builtin_amdgcn_s_sleep(1);
        if ((++sp & 255u) == 0u) { if (xb_ld(&bar[XB_TMO])) break; if (sp > XB_SPIN_CAP) { atomicAdd(&bar[XB_TMO], 1u); break; } }
    }
    nloc = mine > 0u ? mine : 1u; nx = cnt > 0u ? cnt : 1u;
}
__device__ __forceinline__ void xcd_barrier(const XcdBarrier& b) {
    asm volatile("s_waitcnt vmcnt(0)" ::: "memory");
    __syncthreads();
    if (threadIdx.x == 0) {
        unsigned* bar = b.bar;
        __builtin_amdgcn_s_waitcnt(0);
        unsigned nloc = b.st[0], nx = b.st[1];
        if (nloc == 0u) { xcd_barrier_complete(bar, b.x, nloc, nx); b.st[0] = nloc; b.st[1] = nx; }
        const unsigned old = xb_add(&bar[XB_XSUB(b.x)], 1u);
        const unsigned gen = old / nloc;
        if (old + 1u == (gen + 1u) * nloc) {
            __builtin_amdgcn_fence(__ATOMIC_RELEASE, "agent");
            asm volatile("s_waitcnt vmcnt(0)" ::: "memory");
            const unsigned og = xb_add(&bar[XB_TOP], 1u);
            const unsigned tg = og / nx;
            if (og + 1u == (tg + 1u) * nx) xb_add(&bar[XB_TOPGEN], 1u);
            else XB_SPIN(xb_ld(&bar[XB_TOPGEN]) == tg, bar);
            __builtin_amdgcn_fence(__ATOMIC_ACQUIRE, "agent");
            xb_add(&bar[XB_XGEN(b.x)], 1u);
            asm volatile("s_waitcnt vmcnt(0)" ::: "memory");
        } else {
            XB_SPIN(xb_ld(&bar[XB_XGEN(b.x)]) == gen, bar);
            __builtin_amdgcn_fence(__ATOMIC_ACQUIRE, "agent");
            asm volatile("s_waitcnt vmcnt(0)" ::: "memory");
        }
    }
    __syncthreads();
}
__global__ void __launch_bounds__(NT) fwd_kernel(Params p) {
    cg::grid_group grid = cg::this_grid();
    extern __shared__ __attribute__((aligned(16))) unsigned char smem[];
    float* hf = (float*)(p.ws + H_F32); bf16_t* hb = (bf16_t*)(p.ws + H_BF);
    volatile LAS unsigned* xst = (volatile LAS unsigned*)(smem + LDS_BYTES - 16);
    if (threadIdx.x == 0) { xst[0] = 0u; xst[1] = 0u; }
    __syncthreads();
    const XcdBarrier xb = xcd_barrier_post((unsigned*)(p.ws + BAR_OFF), xst);
    ph_prep0(p, smem); ph_moe_weights(p, 0, smem);
    grid.sync();
    PHASE(1, ph_gemm_retin8(p, smem));
    PHASE(2, ph_ret_state(p, smem));
    PHASE(3, ph_ret_scan(p, smem));
    PHASE(4, ph_gnorm_gate(p));
    PHASE(5, ph_gemm_f32_8((const bf16_t*)p.out, (const bf16_t*)(p.ws + WT_OUT), hf, 1024, 2048, smem));
    PHASE(6, (ph_ln<false, true, false, false>(p, p.x, hf, hf, hb, p.ln_mix_g, p.ln_mix_b, 0, smem)));
    constexpr int MW_T1 = 3100, MW_T2 = 5200;
    PHASE(7, (ph_moe_up8(p, 0, smem), moe_tail_convert(p, 0, smem, 0, MW_T1)));
    PHASE(8, (ph_moe_down8(p, 0, smem), moe_tail_convert(p, 0, smem, MW_T1, MW_T2)));
    PHASE(9, (ph_ln<true, false, false, true>(p, (const float*)hb, nullptr, hf, hb, p.ln_ffn_g, p.ln_ffn_b, 0, smem), ph_prep1(p, smem)));
    const int G_ = (int)gridDim.x, c_ = (int)blockIdx.x;
    PHASE(10, (ph_gemm_kvq8(p, smem), [&] { if (c_ == G_ - 1) { const int o = ptid(); const float* part = (const float*)(p.ws + ATTN_OUT); float a = 0.f; for (int ks = 0; ks < 32; ++ks) a += part[ks * 512 + o]; ((float*)(p.ws + MISC))[MI_PEW + o] = a; } }(), [&] { const int rem = ((T_ / 256) * (KVQ_N / 256)) % G_; if (rem == 0) moe_weights_range(p, 1, smem, MW_T2, MOEW_TILES, c_, G_); else if (c_ >= rem) moe_weights_range(p, 1, smem, MW_T2, MOEW_TILES, c_ - rem, G_ - rem); }()));
    PHASE(11, (ph_vt(p), ph_cmp_gemm(p, smem)));
    PHASE(12, ph_cmp2(p, smem));
    PHASE(13, ph_attn(p, smem));
    PHASE(14, ph_gemm_f32_8((const bf16_t*)(p.ws + ATTN_OUT), (const bf16_t*)(p.ws + WT_NSAOUT), (float*)(p.ws + MIX2), 1024, 1024, smem));
    PHASE(15, (ph_ln<false, true, false, true>(p, (const float*)hb, (const float*)(p.ws + MIX2), hf, hb, p.ln_mix_g + 1024, p.ln_mix_b + 1024, 1, smem)));
    PHASE(16, ph_moe_up8(p, 1, smem));
    PHASE(17, ph_moe_down8(p, 1, smem));
    ph_ln<true, false, true, true>(p, (const float*)hb, nullptr, p.out, nullptr, p.ln_ffn_g + 1024, p.ln_ffn_b + 1024, 1, smem);
}

extern "C" void kernel_launch(void* const* d_in, const int* in_sizes, int n_in, void* d_out, int out_size, void* d_ws, size_t ws_size, hipStream_t stream) {
    (void)in_sizes; (void)n_in; (void)out_size;
    if (ws_size < WS_NEEDED) { fprintf(stderr, "workspace too small: %zu < %zu\n", ws_size, (size_t)WS_NEEDED); return; }
    static int grid_blocks = 0;
    if (!grid_blocks) {
        int dev = 0, cus = 0, per_cu = 0;
        (void)hipGetDevice(&dev);
        (void)hipDeviceGetAttribute(&cus, hipDeviceAttributeMultiprocessorCount, dev);
        (void)hipFuncSetAttribute((const void*)fwd_kernel, hipFuncAttributeMaxDynamicSharedMemorySize, LDS_BYTES);
        (void)hipOccupancyMaxActiveBlocksPerMultiprocessor(&per_cu, fwd_kernel, NT, LDS_BYTES);
        if (per_cu > 1) per_cu = 1;
        grid_blocks = cus * per_cu;
    }
    Params p{};
    const float** pp = (const float**)&p;
    for (int i = 0; i < 21; ++i) pp[i] = (const float*)d_in[i];
    p.out = (float*)d_out; p.ws = (unsigned char*)d_ws;
    (void)hipMemsetAsync((unsigned char*)d_ws + BAR_OFF, 0, CTL_ZERO_BYTES, stream);
    void* args[] = {&p};
    hipError_t e = hipLaunchCooperativeKernel((void*)fwd_kernel, dim3(grid_blocks), dim3(NT), args, LDS_BYTES, stream);
    if (e != hipSuccess) fprintf(stderr, "cooperative launch failed: %s (grid %d)\n", hipGetErrorString(e), grid_blocks);
}
```

```cpp
#include <hip/hip_runtime.h>
#include <hip/hip_cooperative_groups.h>
#include <cstdio>
#include <cstdint>
namespace cg = cooperative_groups;

typedef unsigned short bf16_t;
typedef short bf16x8 __attribute__((ext_vector_type(8)));
typedef float f32x4 __attribute__((ext_vector_type(4)));
typedef unsigned u32x4 __attribute__((ext_vector_type(4)));
typedef unsigned u32x2 __attribute__((ext_vector_type(2)));

#define NT 512
#ifndef PROBEMASK
#define PROBEMASK 0u
#endif
#define PROBE_W 3ull
#define PROBE_ON(id) ((PROBEMASK >> (id)) & 1u)
#define PHASE(id, ...) do { const unsigned long long _t0 = PROBE_ON(id) ? __builtin_amdgcn_s_memrealtime() : 0ull; __VA_ARGS__; xcd_barrier(xb); \
    if (PROBE_ON(id)) { const unsigned long long _t1 = __builtin_amdgcn_s_memrealtime(), _end = _t1 + PROBE_W * (_t1 - _t0); while (__builtin_amdgcn_s_memrealtime() < _end) __builtin_amdgcn_s_sleep(8); } } while (0)
constexpr int LDS_BYTES = 144 * 1024;
constexpr int T_ = 16384, D_ = 1024, S_ = 8192;
constexpr size_t MiB = 1u << 20;
constexpr size_t XB = 0, WT_IN = 32 * MiB, QB = 44 * MiB, KB = 76 * MiB, VB = 108 * MiB, GB = 172 * MiB;
constexpr size_t WT_OUT = 246 * MiB, MOEW_GU = 250 * MiB, MOEW_D = 282 * MiB;
constexpr size_t H_F32 = 0, H_BF = 64 * MiB, YEXP = 96 * MiB, XS = 172 * MiB, MISC = 244 * MiB;
constexpr size_t WT_KVQ = 236 * MiB, WT_NSAOUT = 242 * MiB;
constexpr size_t KVQ = 96 * MiB, GATES = 180 * MiB, HC = 183 * MiB, KCMPB = 187 * MiB, VCMPT = 187 * MiB + 512 * 1024, VST = 188 * MiB, VWT = 196 * MiB, ATTN_OUT = 204 * MiB, WT_CW1 = 246 * MiB, WT_CW2 = 248 * MiB;
constexpr size_t MIX2 = 96 * MiB;
constexpr size_t MOEW1_GU = 0, MOEW1_D = 32 * MiB;
constexpr size_t RET_L = 0;
constexpr size_t WS_NEEDED = 298 * MiB;
constexpr size_t MOE_INV = 168 * MiB;
constexpr size_t ROPE_RT = 236 * MiB, ROPE_NT = 232 * MiB;
constexpr int KVQ_LD = 2688, KVQ_N = 2816;
constexpr size_t BAR_OFF = 245 * MiB;
constexpr size_t CNT_OFF = BAR_OFF + 16384;
constexpr int CTL_ZERO_BYTES = 16384 + 32 * 256;
constexpr int MI_KMAX = 64, MI_KMAXC = 120, MI_PEW = 512;
constexpr int MI_CNT = 0, MI_TE = 1024, MI_TW = MI_TE + 32768, MI_TI = MI_TW + 32768, MI_TR = MI_TI + 32768;

struct Params {
    const float *x, *ret_w_in, *ret_w_out, *nsa_w_kv, *pe_k, *pe_v, *ck_w1, *ck_w2, *cv_w1, *cv_w2, *nsa_w_in, *nsa_w_out,
        *router_w, *router_b, *moe_wg, *moe_wu, *moe_wd, *ln_mix_g, *ln_mix_b, *ln_ffn_g, *ln_ffn_b;
    float* out; unsigned char* ws;
};

__device__ __forceinline__ bf16_t f2bf(float f) { unsigned u = __float_as_uint(f); u += 0x7fffu + ((u >> 16) & 1u); return (bf16_t)(u >> 16); }
__device__ __forceinline__ float bf2f(bf16_t h) { return __uint_as_float(((unsigned)h) << 16); }
typedef float f32x2 __attribute__((ext_vector_type(2)));
typedef __bf16 bf16x2_t __attribute__((ext_vector_type(2)));
__device__ __forceinline__ unsigned pack2(float a, float b) { const f32x2 v = {a, b}; return __builtin_bit_cast(unsigned, __builtin_convertvector(v, bf16x2_t)); }
__device__ __forceinline__ float lo2f(unsigned u) { return __uint_as_float(u << 16); }
__device__ __forceinline__ float hi2f(unsigned u) { return __uint_as_float(u & 0xffff0000u); }
__device__ __forceinline__ float wave_sum(float v) {
#pragma unroll
    for (int o = 32; o > 0; o >>= 1) v += __shfl_xor(v, o);
    return v;
}
__device__ __forceinline__ float wave_max(float v) {
#pragma unroll
    for (int o = 32; o > 0; o >>= 1) v = fmaxf(v, __shfl_xor(v, o));
    return v;
}
__device__ __forceinline__ int ptid() { int t = threadIdx.x; asm volatile("" : "+v"(t)); return t; }
__device__ __forceinline__ int gtid() { return blockIdx.x * NT + ptid(); }
__device__ __forceinline__ int gthreads() { return gridDim.x * NT; }
__device__ __forceinline__ int gwave() { return (ptid() >> 6) * gridDim.x + blockIdx.x; }
__device__ __forceinline__ int gwaves() { return gridDim.x * (NT / 64); }
__device__ __forceinline__ void unpack8(u32x4 u, float* f) {
    f[0] = lo2f(u.x); f[1] = hi2f(u.x); f[2] = lo2f(u.y); f[3] = hi2f(u.y); f[4] = lo2f(u.z); f[5] = hi2f(u.z); f[6] = lo2f(u.w); f[7] = hi2f(u.w);
}

template <class F> __device__ __forceinline__ void transpose_conv_tiles(F src, bf16_t* dst, int K, float* tile, int tb, int te, int rank, int nranks) {
    const int tilesK = K >> 6, tix = ptid();
    for (int t = tb + rank; t < te; t += nranks) {
        const int n0 = (t / tilesK) << 6, k0 = (t % tilesK) << 6;
#pragma unroll
        for (int i = 0; i < 8; ++i) { const int idx = tix + i * NT, kk = idx >> 6, r = idx & 63; tile[kk * 65 + r] = src(k0 + kk, n0 + r); }
        __syncthreads();
        {   const int r = tix >> 3, kk0 = (tix & 7) * 8; float f[8];
#pragma unroll
            for (int j = 0; j < 8; ++j) f[j] = tile[(kk0 + j) * 65 + r];
            *(u32x4*)(dst + (size_t)(n0 + r) * K + k0 + kk0) = (u32x4){pack2(f[0], f[1]), pack2(f[2], f[3]), pack2(f[4], f[5]), pack2(f[6], f[7])}; }
        __syncthreads();
    }
}
template <class F> __device__ __forceinline__ void transpose_conv(F src, bf16_t* dst, int K, int N, float* tile) { transpose_conv_tiles(src, dst, K, tile, 0, (N >> 6) * (K >> 6), (int)blockIdx.x, (int)gridDim.x); }

template <class Epi, bool NH = false> __device__ __forceinline__ void gemm_tile_rows(const bf16_t* const (&ap)[4], const bf16_t* __restrict__ Bt, int ldb, int K, Epi epi, unsigned char* smem, int akstride = 64) {
    const int tid = ptid(), lane = tid & 63, wid = tid >> 6, wm = NH ? wid : wid >> 1, wn = NH ? 0 : wid & 1, fr = lane & 15, fq = lane >> 4;
    bf16_t* As = (bf16_t*)smem;
    bf16_t* Bs = As + 256 * 80;
    f32x4 acc[4][4];
#pragma unroll
    for (int i = 0; i < 4; ++i)
#pragma unroll
        for (int j = 0; j < 4; ++j) acc[i][j] = (f32x4){0.f, 0.f, 0.f, 0.f};
    u32x4 raA[4], rbA[2], raB[4], rbB[2];
    const int lrow = tid >> 3, lkc = tid & 7;
    const bf16_t* bg = Bt + (size_t)lrow * ldb + lkc * 8;
    const int nk = K >> 6;
    auto fetch = [&](u32x4 (&ra)[4], u32x4 (&rb)[2], int kt) {
        const int kc = kt < nk ? kt : nk - 1; const int k0 = kc << 6; const size_t ka = (size_t)kc * akstride;
#pragma unroll
        for (int i = 0; i < 4; ++i) ra[i] = *(const u32x4*)(ap[i] + ka);
#pragma unroll
        for (int i = 0; i < (NH ? 1 : 2); ++i) rb[i] = *(const u32x4*)(bg + (size_t)i * 64 * ldb + k0);
    };
    auto step = [&](u32x4 (&ra)[4], u32x4 (&rb)[2], int kt) {
#pragma unroll
        for (int i = 0; i < 4; ++i) *(u32x4*)(As + (lrow + i * 64) * 80 + lkc * 8) = ra[i];
#pragma unroll
        for (int i = 0; i < (NH ? 1 : 2); ++i) *(u32x4*)(Bs + (lrow + i * 64) * 80 + lkc * 8) = rb[i];
        __syncthreads();
        fetch(ra, rb, kt + 2);
#pragma unroll
        for (int s = 0; s < 2; ++s) {
            bf16x8 af[4], bfr[4];
#pragma unroll
            for (int i = 0; i < (NH ? 2 : 4); ++i) af[i] = *(const bf16x8*)(As + (wm * (NH ? 32 : 64) + i * 16 + fr) * 80 + s * 32 + fq * 8);
#pragma unroll
            for (int j = 0; j < 4; ++j) bfr[j] = *(const bf16x8*)(Bs + (wn * 64 + j * 16 + fr) * 80 + s * 32 + fq * 8);
#pragma unroll
            for (int i = 0; i < (NH ? 2 : 4); ++i)
#pragma unroll
                for (int j = 0; j < 4; ++j) acc[i][j] = __builtin_amdgcn_mfma_f32_16x16x32_bf16(bfr[j], af[i], acc[i][j], 0, 0, 0);
        }
        __syncthreads();
    };
    fetch(raA, rbA, 0); fetch(raB, rbB, 1);
    for (int kt = 0; kt < nk; kt += 2) { step(raA, rbA, kt); if (kt + 1 < nk) step(raB, rbB, kt + 1); }
    epi.start(wm, wn, fr, fq);
#pragma unroll
    for (int i = 0; i < (NH ? 2 : 4); ++i) {
#pragma unroll
        for (int j = 0; j < 4; ++j) epi(wm * (NH ? 32 : 64) + i * 16 + fr, wn * 64 + j * 16 + fq * 4, acc[i][j]);
        epi.row_done(i);
    }
    epi.finish();
}
template <class Epi, bool NH = false> __device__ __forceinline__ void gemm_tile(const bf16_t* __restrict__ A, int lda, const bf16_t* __restrict__ Bt, int ldb, int K, const Epi& epi, unsigned char* smem, int akstride = 64) {
    const bf16_t* ap[4]; const int tix = ptid();
#pragma unroll
    for (int i = 0; i < 4; ++i) ap[i] = A + (size_t)((tix >> 3) + 64 * i) * lda + (tix & 7) * 8;
    gemm_tile_rows<Epi, NH>(ap, Bt, ldb, K, epi, smem, akstride);
}

struct EpiBase { __device__ __forceinline__ void start(int, int, int, int) {} __device__ __forceinline__ void row_done(int) {} __device__ __forceinline__ void finish() {} };
struct EpiBf16 : EpiBase { bf16_t* C; int ldc;
    __device__ __forceinline__ void operator()(int m, int n, f32x4 v) const { *(uint2*)(C + (size_t)m * ldc + n) = make_uint2(pack2(v[0], v[1]), pack2(v[2], v[3])); } };
struct EpiF32 : EpiBase { float* C; int ldc;
    __device__ __forceinline__ void operator()(int m, int n, f32x4 v) const { *(float4*)(C + (size_t)m * ldc + n) = make_float4(v[0], v[1], v[2], v[3]); } };
struct EpiSwiglu : EpiBase { bf16_t* C; int ldc;
    __device__ __forceinline__ void operator()(int m, int n, f32x4 v) const {
        const float a0 = v[0] / (1.f + __expf(-v[0])) * v[1], a1 = v[2] / (1.f + __expf(-v[2])) * v[3];
        *(unsigned*)(C + (size_t)m * ldc + (n >> 1)) = pack2(a0, a1); } };

namespace pg8 {
#define PG8_LAS __attribute__((address_space(3)))
typedef unsigned short bf16_t;
typedef short bf16x8 __attribute__((ext_vector_type(8)));
typedef float f32x4 __attribute__((ext_vector_type(4)));
typedef unsigned u32x4 __attribute__((ext_vector_type(4)));
constexpr int BM = 256, BK = 64, HALF = 128, HTB = HALF * BK * 2  , STAGE_BYTES = 8 * HTB, NXCD = 8, WGM = 8;

__host__ __device__ __forceinline__ int lds_byte(int r, int c) { const int st = (r >> 4) * 2 + (c >> 5), rr = r & 15, cc = c & 31, ob = rr * 64 + cc * 2; return st * 1024 + (ob ^ (((ob >> 9) & 1) << 5)); }
__host__ __device__ __forceinline__ void stage_rc(int b, int& R, int& C) { const int st = b / 1024, sb = b % 1024, swz = sb ^ (((sb >> 9) & 1) << 5); R = (st >> 1) * 16 + swz / 64; C = (st & 1) * 32 + (swz % 64) / 2; }
__host__ __device__ __forceinline__ int perm32(int rho) { const int n = rho >> 4, i = rho & 15; return 8 * (i >> 2) + 4 * n + (i & 3); }

struct Unit { int pm, pn; };
struct Gemm { const bf16_t* A; const bf16_t* Bt; int M, N, K; };

struct StaticOrder {
    int nM, nN, nwg, G, c;
    __host__ __device__ void init(int M, int N, int G_, int c_) { nM = M / BM; nN = N / BM; nwg = nM * nN; G = G_; c = c_; }
    __host__ __device__ bool next(int i, Unit& u) const {
        const long L = (long)i * G + c; if (L >= nwg) return false;
        int wgid = (int)L; { const int q = nwg / NXCD, r = nwg % NXCD, xcd = wgid % NXCD, off = wgid / NXCD; wgid = (xcd < r ? xcd * (q + 1) : r * (q + 1) + (xcd - r) * q) + off; }
        const int nig = WGM * nN, gid = wgid / nig, fm = gid * WGM, gsz = (nM - fm) < WGM ? (nM - fm) : WGM;
        u.pm = fm + ((wgid % nig) % gsz); u.pn = (wgid % nig) / gsz; return true;
    }
    __device__ __forceinline__ void a_ready(const Unit&) const {}
    __device__ __forceinline__ void done(const Unit&) const {}
};


template <class Epi, class Sched, bool ALIGN_EPI = false, bool SP2 = false, bool GATHER = false>
__device__ __forceinline__ void gemm_phase(PG8_LAS unsigned char* lds, const Gemm g, const Sched& S, const Epi& E) {
    const int tid = ptid(), wid = __builtin_amdgcn_readfirstlane(tid >> 6), lane = tid & 63, wr = wid >> 2, wc = wid & 3, fr = lane & 15, fq = lane >> 4;
    const int K = g.K, nt = K / BK;
    unsigned voffA[2], voffB[2];
#pragma unroll
    for (int i = 0; i < 2; ++i) { int R, C; stage_rc(tid * 16 + i * 8192, R, C); const int Rb = Epi::PERM ? ((R & ~31) + perm32(R & 31)) : R;
        voffA[i] = (unsigned)(R * K + C) * 2u; voffB[i] = (unsigned)(Rb * K + C) * 2u; }
    const size_t kstep = (size_t)(BK * 2);
    const size_t hstep = (size_t)HALF * K * 2;
    const size_t tstep = 2 * hstep;
    const size_t hstepA = GATHER ? 0 : hstep, tstepA = GATHER ? 0 : tstep;
    int gR[2], gC[2];
#pragma unroll
    for (int i = 0; i < 2; ++i) stage_rc(tid * 16 + i * 8192, gR[i], gC[i]);
    unsigned vgc[2][2], vgn[2][2], vgs[2][2];
    auto gath = [&](const Unit& u, unsigned (&v)[2][2]) {
        if constexpr (GATHER) {
#pragma unroll
            for (int h = 0; h < 2; ++h)
#pragma unroll
                for (int i = 0; i < 2; ++i) v[h][i] = (unsigned)(S.rowidx(u, 128 * h + gR[i]) * K + gC[i]) * 2u;
        }
    };
    const unsigned ldsw = (unsigned)wid * 1024u;
    const int aoff = lds_byte(wr * 64 + fr, fq * 8), boff = lds_byte(wc * 32 + fr, fq * 8);
#define PG8_SA(b, h) (((b) * 2 + (h)) * HTB)
#define PG8_SB(b, h) ((4 + (b) * 2 + (h)) * HTB)
#define PG8_STAGE(bufoff, gbase, voff) do { _Pragma("unroll") for (int _i = 0; _i < 2; ++_i) \
        __builtin_amdgcn_global_load_lds((const unsigned*)((const char*)(gbase) + (voff)[_i]), (PG8_LAS unsigned*)(lds + (bufoff) + ldsw + _i * 8192), 16, 0, 0); } while (0)
#define PG8_STAGE_A(bufoff, gbase, VG, h) do { if constexpr (GATHER) PG8_STAGE(bufoff, gbase, (VG)[h]); else PG8_STAGE(bufoff, gbase, voffA); } while (0)
#define PG8_LDA(dst, b, h) do { _Pragma("unroll") for (int m = 0; m < 4; ++m) _Pragma("unroll") for (int k = 0; k < 2; ++k) dst[m][k] = *(const PG8_LAS bf16x8*)(lds + PG8_SA(b, h) + aoff + m * 2048 + k * 1024); } while (0)
#define PG8_LDB(dst, b, h) do { _Pragma("unroll") for (int n = 0; n < 2; ++n) _Pragma("unroll") for (int k = 0; k < 2; ++k) dst[n][k] = *(const PG8_LAS bf16x8*)(lds + PG8_SB(b, h) + boff + n * 2048 + k * 1024); } while (0)
#define PG8_MMA(ai, bj, At, Bt) do { __builtin_amdgcn_s_setprio(1); _Pragma("unroll") for (int m = 0; m < 4; ++m) _Pragma("unroll") for (int n = 0; n < 2; ++n) _Pragma("unroll") for (int k = 0; k < 2; ++k) \
        acc[ai][bj][m][n] = __builtin_amdgcn_mfma_f32_16x16x32_bf16(Bt[n][k], At[m][k], acc[ai][bj][m][n], 0, 0, 0); __builtin_amdgcn_s_setprio(0); } while (0)
#define PG8_WAIT_V(n) asm volatile("s_waitcnt vmcnt(" #n ")" ::: "memory")
#define PG8_WAIT_L(n) asm volatile("s_waitcnt lgkmcnt(" #n ")" ::: "memory")
#define PG8_BAR __builtin_amdgcn_s_barrier()
#define PG8_SCHED __builtin_amdgcn_sched_barrier(0)
    Unit cur, nxt; int ui = 0;
    if (!S.next(0, cur)) return;
    f32x4 acc[2][2][4][2];
#pragma unroll
    for (int a = 0; a < 2; ++a)
#pragma unroll
        for (int b = 0; b < 2; ++b)
#pragma unroll
            for (int m = 0; m < 4; ++m)
#pragma unroll
                for (int n = 0; n < 2; ++n) acc[a][b][m][n] = (f32x4){0.f, 0.f, 0.f, 0.f};
    bf16x8 At[4][2], B0[2][2], B1[2][2];
    const char* cA = (const char*)g.A + (size_t)cur.pm * tstepA; gath(cur, vgc); const char* cB = (const char*)g.Bt + (size_t)cur.pn * tstep;
    S.a_ready(cur);
    if constexpr (SP2) {
        PG8_STAGE(PG8_SB(0, 0), cB, voffB); PG8_STAGE(PG8_SB(0, 1), cB + hstep, voffB); PG8_STAGE_A(PG8_SA(0, 0), cA, vgc, 0); PG8_STAGE_A(PG8_SA(0, 1), cA + hstepA, vgc, 1);
        if (wr == 1) PG8_BAR;
        PG8_WAIT_V(2); PG8_BAR;
        PG8_STAGE(PG8_SB(1, 0), cB + kstep, voffB); PG8_STAGE_A(PG8_SA(1, 0), cA + kstep, vgc, 0); PG8_STAGE(PG8_SB(1, 1), cB + hstep + kstep, voffB);
        PG8_WAIT_V(6); PG8_BAR;
    } else {
        PG8_STAGE(PG8_SB(0, 0), cB, voffB); PG8_STAGE_A(PG8_SA(0, 0), cA, vgc, 0); PG8_STAGE(PG8_SB(0, 1), cB + hstep, voffB); PG8_STAGE_A(PG8_SA(0, 1), cA + hstepA, vgc, 1);
        if (wr == 1) PG8_BAR;
        PG8_WAIT_V(4); PG8_BAR;
        PG8_STAGE(PG8_SB(1, 0), cB + kstep, voffB); PG8_STAGE_A(PG8_SA(1, 0), cA + kstep, vgc, 0); PG8_STAGE(PG8_SB(1, 1), cB + hstep + kstep, voffB);
        PG8_WAIT_V(6); PG8_BAR;
    }
    for (;;) {
        const bool has_next = S.next(ui + 1, nxt);
        const char* nA = has_next ? (const char*)g.A + (size_t)nxt.pm * tstepA : cA;
        if constexpr (GATHER) { if (has_next) gath(nxt, vgn); else {
#pragma unroll
            for (int h = 0; h < 2; ++h) { vgn[h][0] = vgc[h][0]; vgn[h][1] = vgc[h][1]; } } } const char* nB = has_next ? (const char*)g.Bt + (size_t)nxt.pn * tstep : cB;
        for (int t = 0; t < nt; t += 2) {
            const bool last = (t == nt - 2);
            const char* a1 = cA + (size_t)(t + 1) * kstep;
            const char* a2 = last ? nA : cA + (size_t)(t + 2) * kstep; const char* b2 = last ? nB : cB + (size_t)(t + 2) * kstep;
            const char* a3 = a2 + kstep; const char* b3 = b2 + kstep;
            if (last && has_next) S.a_ready(nxt);
            if constexpr (GATHER) {
#pragma unroll
                for (int h = 0; h < 2; ++h) { vgs[h][0] = last ? vgn[h][0] : vgc[h][0]; vgs[h][1] = last ? vgn[h][1] : vgc[h][1]; } }
            if constexpr (SP2) {
            PG8_LDB(B0, 0, 0); PG8_LDB(B1, 0, 1); PG8_SCHED; PG8_LDA(At, 0, 0); PG8_STAGE_A(PG8_SA(1, 1), a1 + hstepA, vgc, 1);
            PG8_WAIT_V(8); PG8_WAIT_L(0); PG8_BAR; PG8_MMA(0, 0, At, B0); PG8_MMA(0, 1, At, B1); PG8_BAR; PG8_SCHED;
            PG8_LDA(At, 0, 1); PG8_STAGE(PG8_SB(0, 0), b2, voffB); PG8_STAGE(PG8_SB(0, 1), b2 + hstep, voffB); PG8_STAGE_A(PG8_SA(0, 0), a2, vgs, 0);
            PG8_WAIT_V(8); PG8_WAIT_L(0); PG8_BAR; PG8_MMA(1, 0, At, B0); PG8_MMA(1, 1, At, B1); PG8_BAR; PG8_SCHED;
            PG8_LDB(B0, 1, 0); PG8_LDB(B1, 1, 1); PG8_SCHED; PG8_LDA(At, 1, 0); PG8_STAGE_A(PG8_SA(0, 1), a2 + hstepA, vgs, 1);
            PG8_WAIT_V(8); PG8_WAIT_L(0); PG8_BAR; PG8_MMA(0, 0, At, B0); PG8_MMA(0, 1, At, B1); PG8_BAR; PG8_SCHED;
            PG8_LDA(At, 1, 1); PG8_STAGE(PG8_SB(1, 0), b3, voffB); PG8_STAGE(PG8_SB(1, 1), b3 + hstep, voffB); PG8_STAGE_A(PG8_SA(1, 0), a3, vgs, 0);
            PG8_WAIT_V(8); PG8_WAIT_L(0); PG8_BAR; PG8_MMA(1, 0, At, B0); PG8_MMA(1, 1, At, B1); PG8_BAR; PG8_SCHED;
            } else {
            PG8_LDB(B0, 0, 0); PG8_SCHED; PG8_LDA(At, 0, 0); PG8_STAGE_A(PG8_SA(1, 1), a1 + hstepA, vgc, 1);
            PG8_WAIT_L(8); PG8_BAR; PG8_WAIT_L(0); PG8_MMA(0, 0, At, B0); PG8_BAR; PG8_SCHED;
            PG8_LDB(B1, 0, 1); PG8_STAGE(PG8_SB(0, 0), b2, voffB);
            PG8_BAR; PG8_WAIT_L(0); PG8_MMA(0, 1, At, B1); PG8_BAR;
            PG8_LDA(At, 0, 1); PG8_STAGE_A(PG8_SA(0, 0), a2, vgs, 0);
            PG8_BAR; PG8_WAIT_L(0); PG8_MMA(1, 0, At, B0); PG8_BAR; PG8_SCHED;
            PG8_STAGE(PG8_SB(0, 1), b2 + hstep, voffB);
            PG8_WAIT_V(6); PG8_BAR; PG8_MMA(1, 1, At, B1); PG8_BAR;
            PG8_LDB(B0, 1, 0); PG8_SCHED; PG8_LDA(At, 1, 0); PG8_STAGE_A(PG8_SA(0, 1), a2 + hstepA, vgs, 1);
            PG8_WAIT_L(8); PG8_BAR; PG8_WAIT_L(0); PG8_MMA(0, 0, At, B0); PG8_BAR; PG8_SCHED;
            PG8_LDB(B1, 1, 1); PG8_STAGE(PG8_SB(1, 0), b3, voffB);
            PG8_BAR; PG8_WAIT_L(0); PG8_MMA(0, 1, At, B1); PG8_BAR;
            PG8_LDA(At, 1, 1); PG8_STAGE_A(PG8_SA(1, 0), a3, vgs, 0);
            PG8_BAR; PG8_WAIT_L(0); PG8_MMA(1, 0, At, B0); PG8_BAR; PG8_SCHED;
            PG8_STAGE(PG8_SB(1, 1), b3 + hstep, voffB);
            PG8_WAIT_V(6); PG8_BAR; PG8_MMA(1, 1, At, B1); PG8_BAR;
            }
        }
        if constexpr (ALIGN_EPI) { if (wr == 0) PG8_BAR; }
        if constexpr (!Epi::AFTER_DRAIN) { E(acc, cur, wr, wc, fr, fq); S.done(cur); }
        if (!has_next) break;
#pragma unroll
        for (int a = 0; a < 2; ++a)
#pragma unroll
            for (int b = 0; b < 2; ++b)
#pragma unroll
                for (int m = 0; m < 4; ++m)
#pragma unroll
                    for (int n = 0; n < 2; ++n) acc[a][b][m][n] = (f32x4){0.f, 0.f, 0.f, 0.f};
        cur = nxt; cA = nA; cB = nB; ++ui;
        if constexpr (GATHER) {
#pragma unroll
            for (int h = 0; h < 2; ++h) { vgc[h][0] = vgn[h][0]; vgc[h][1] = vgn[h][1]; } }
        if constexpr (ALIGN_EPI) { if (wr == 1) PG8_BAR; }
    }
    PG8_WAIT_V(0);
    if constexpr (!ALIGN_EPI) { if (wr == 0) PG8_BAR; }
    PG8_BAR;
    if constexpr (Epi::AFTER_DRAIN) { E.fused(acc, cur, wr, wc, fr, fq, lds, wid, lane); S.done(cur); }
#undef PG8_SA
#undef PG8_SB
#undef PG8_STAGE
#undef PG8_LDA
#undef PG8_LDB
#undef PG8_MMA
#undef PG8_WAIT_V
#undef PG8_WAIT_L
#undef PG8_BAR
#undef PG8_SCHED
#undef PG8_STAGE_A
}
struct EpiF32P { static constexpr bool PERM = false, AFTER_DRAIN = false; float* C; int ldc;
    __device__ __forceinline__ void operator()(const f32x4 (&acc)[2][2][4][2], const Unit& u, int wr, int wc, int fr, int fq) const {
#pragma unroll
        for (int ai = 0; ai < 2; ++ai)
#pragma unroll
            for (int m = 0; m < 4; ++m) { float* rp = C + (size_t)(u.pm * 256 + ai * 128 + wr * 64 + m * 16 + fr) * ldc + u.pn * 256 + wc * 32 + 4 * fq;
#pragma unroll
                for (int bj = 0; bj < 2; ++bj)
#pragma unroll
                    for (int n = 0; n < 2; ++n) *(f32x4*)(rp + bj * 128 + n * 16) = acc[ai][bj][m][n]; } } };
struct EpiBf16P { static constexpr bool PERM = false, AFTER_DRAIN = false; ::bf16_t* C; int ldc; int pnmask;
    __device__ __forceinline__ void operator()(const f32x4 (&acc)[2][2][4][2], const Unit& u, int wr, int wc, int fr, int fq) const {
#pragma unroll
        for (int ai = 0; ai < 2; ++ai)
#pragma unroll
            for (int m = 0; m < 4; ++m) { ::bf16_t* rp = C + (size_t)(u.pm * 256 + ai * 128 + wr * 64 + m * 16 + fr) * ldc + (u.pn & pnmask) * 256 + wc * 32 + 4 * fq;
#pragma unroll
                for (int bj = 0; bj < 2; ++bj)
#pragma unroll
                    for (int n = 0; n < 2; ++n) { const f32x4 v = acc[ai][bj][m][n]; *(::u32x2*)(rp + bj * 128 + n * 16) = (::u32x2){pack2(v[0], v[1]), pack2(v[2], v[3])}; } } } };
struct EpiRetInP { static constexpr bool PERM = false, AFTER_DRAIN = false; const Params* p;
    __device__ __forceinline__ void operator()(const f32x4 (&acc)[2][2][4][2], const Unit& u, int wr, int wc, int fr, int fq) const {
        const int pn = u.pn;
        if (pn < 8) {
            const int head = pn & 3, isk = pn >> 2; const float lg = log2f(1.f - exp2f(-5.f - (float)head));
            ::bf16_t* base = (::bf16_t*)(p->ws + (isk ? KB : QB)) + head * 256;
#pragma unroll
            for (int ai = 0; ai < 2; ++ai) {
                f32x4 csr[4][2][2];
#pragma unroll
                for (int m = 0; m < 4; ++m) { const int t = (u.pm * 256 + ai * 128 + wr * 64 + m * 16 + fr) & (S_ - 1); const float* rt = (const float*)(p->ws + ROPE_RT) + (size_t)t * 256;
#pragma unroll
                    for (int bj = 0; bj < 2; ++bj)
#pragma unroll
                        for (int n = 0; n < 2; ++n) csr[m][bj][n] = *(const f32x4*)(rt + ((bj * 128 + wc * 32 + n * 16 + 4 * fq) >> 1) * 2); }
#pragma unroll
                for (int m = 0; m < 4; ++m) {
                    const int row = u.pm * 256 + ai * 128 + wr * 64 + m * 16 + fr, t = row & (S_ - 1);
                    const float sc = isk ? 0.0625f * exp2f((float)(127 - (t & 127)) * lg) : 1.f;
#pragma unroll
                    for (int bj = 0; bj < 2; ++bj)
#pragma unroll
                        for (int n = 0; n < 2; ++n) {
                            const int c = bj * 128 + wc * 32 + n * 16 + 4 * fq, d = c >> 1; const f32x4 v = acc[ai][bj][m][n]; const f32x4 cs = csr[m][bj][n];
                            const float a0 = (v[0] * cs[0] - v[1] * cs[1]) * sc, b0 = (v[1] * cs[0] + v[0] * cs[1]) * sc, a1 = (v[2] * cs[2] - v[3] * cs[3]) * sc, b1 = (v[3] * cs[2] + v[2] * cs[3]) * sc;
                            ::bf16_t* dst = base + (size_t)row * 1024 + d; *(unsigned*)dst = pack2(a0, a1); *(unsigned*)(dst + 128) = pack2(b0, b1);
                        }
                }
            }
        } else {
            ::bf16_t* base = (::bf16_t*)(p->ws + (pn < 16 ? VB : GB)) + ((pn - 8) & 7) * 256 + wc * 32 + 4 * fq;
#pragma unroll
            for (int ai = 0; ai < 2; ++ai)
#pragma unroll
                for (int m = 0; m < 4; ++m) { ::bf16_t* rp = base + (size_t)(u.pm * 256 + ai * 128 + wr * 64 + m * 16 + fr) * 2048;
#pragma unroll
                    for (int bj = 0; bj < 2; ++bj)
#pragma unroll
                        for (int n = 0; n < 2; ++n) { const f32x4 v = acc[ai][bj][m][n]; *(::u32x2*)(rp + bj * 128 + n * 16) = (::u32x2){pack2(v[0], v[1]), pack2(v[2], v[3])}; } }
        }
    }
};
struct EpiKvqP { static constexpr bool PERM = false, AFTER_DRAIN = false; const Params* p;
    __device__ __forceinline__ void operator()(const f32x4 (&acc)[2][2][4][2], const Unit& u, int wr, int wc, int fr, int fq) const {
        const int pn = u.pn; ::bf16_t* kvq = (::bf16_t*)(p->ws + KVQ);
        if (pn == 1 || pn == 3 || pn == 5) {
#pragma unroll
            for (int ai = 0; ai < 2; ++ai)
#pragma unroll
                for (int m = 0; m < 4; ++m) { ::bf16_t* rp = kvq + (size_t)(u.pm * 256 + ai * 128 + wr * 64 + m * 16 + fr) * KVQ_LD + pn * 256 + wc * 32 + 4 * fq;
#pragma unroll
                    for (int bj = 0; bj < 2; ++bj)
#pragma unroll
                        for (int n = 0; n < 2; ++n) { const f32x4 v = acc[ai][bj][m][n]; *(::u32x2*)(rp + bj * 128 + n * 16) = (::u32x2){pack2(v[0], v[1]), pack2(v[2], v[3])}; } }
        } else if (pn < 10) {
            const float sc = pn >= 6 ? 0.125f : 1.f; float mx[2] = {0.f, 0.f};
#pragma unroll
            for (int ai = 0; ai < 2; ++ai) {
                f32x4 csr[4][2][2];
#pragma unroll
                for (int m = 0; m < 4; ++m) { const int t = (u.pm * 256 + ai * 128 + wr * 64 + m * 16 + fr) & (S_ - 1); const float* nt = (const float*)(p->ws + ROPE_NT) + (size_t)t * 64;
#pragma unroll
                    for (int bj = 0; bj < 2; ++bj)
#pragma unroll
                        for (int n = 0; n < 2; ++n) csr[m][bj][n] = *(const f32x4*)(nt + (((bj * 128 + wc * 32 + n * 16 + 4 * fq) & 63) >> 1) * 2); }
#pragma unroll
                for (int m = 0; m < 4; ++m) {
                    const int row = u.pm * 256 + ai * 128 + wr * 64 + m * 16 + fr;
#pragma unroll
                    for (int bj = 0; bj < 2; ++bj) {
                        float nrm = 0.f;
#pragma unroll
                        for (int n = 0; n < 2; ++n) {
                            const int c = bj * 128 + wc * 32 + n * 16 + 4 * fq, d = (c & 63) >> 1; const f32x4 v = acc[ai][bj][m][n]; const f32x4 cs = csr[m][bj][n];
                            const float a0 = (v[0] * cs[0] - v[1] * cs[1]) * sc, b0 = (v[1] * cs[0] + v[0] * cs[1]) * sc, a1 = (v[2] * cs[2] - v[3] * cs[3]) * sc, b1 = (v[3] * cs[2] + v[2] * cs[3]) * sc;
                            ::bf16_t* dst = kvq + (size_t)row * KVQ_LD + pn * 256 + (c & ~63) + d; *(unsigned*)dst = pack2(a0, a1); *(unsigned*)(dst + 32) = pack2(b0, b1);
                            nrm += a0 * a0 + b0 * b0 + a1 * a1 + b1 * b1;
                        }
                        nrm += __shfl_xor(nrm, 16); nrm += __shfl_xor(nrm, 32);
                        mx[bj] = fmaxf(mx[bj], nrm);
                    }
                }
            }
            if (pn < 6) {
#pragma unroll
                for (int bj = 0; bj < 2; ++bj) { const float mm = wave_max(mx[bj]); if ((ptid() & 63) == 0) atomicMax((int*)(p->ws + MISC) + MI_KMAX + ((((pn >> 1) * 2 + (u.pm >> 5)) * 4 + 2 * bj + (wc >> 1)) << 1) + (wc & 1), __float_as_int(mm)); }
            }
        } else if (pn == 10) {
#pragma unroll
            for (int ai = 0; ai < 2; ++ai)
#pragma unroll
                for (int m = 0; m < 4; ++m) { float* gt = (float*)(p->ws + GATES) + (size_t)(u.pm * 256 + ai * 128 + wr * 64 + m * 16 + fr) * 48;
#pragma unroll
                    for (int n = 0; n < 2; ++n) { const int c = wc * 32 + n * 16 + 4 * fq; const f32x4 v = acc[ai][0][m][n];
                        if (c < 48) *(f32x4*)(gt + c) = (f32x4){1.f / (1.f + __expf(-v[0])), 1.f / (1.f + __expf(-v[1])), 1.f / (1.f + __expf(-v[2])), 1.f / (1.f + __expf(-v[3]))}; } }
        }
    }
};
struct EpiSwigluP { static constexpr bool PERM = false, AFTER_DRAIN = false; ::bf16_t* C;
    __device__ __forceinline__ void operator()(const f32x4 (&acc)[2][2][4][2], const Unit& u, int wr, int wc, int fr, int fq) const {
#pragma unroll
        for (int ai = 0; ai < 2; ++ai)
#pragma unroll
            for (int m = 0; m < 4; ++m) { ::bf16_t* rp = C + (size_t)(u.pm * 256 + ai * 128 + wr * 64 + m * 16 + fr) * 512 + (u.pn & 3) * 128 + wc * 16 + 2 * fq;
#pragma unroll
                for (int bj = 0; bj < 2; ++bj)
#pragma unroll
                    for (int n = 0; n < 2; ++n) { const f32x4 v = acc[ai][bj][m][n];
                        *(unsigned*)(rp + bj * 64 + n * 8) = pack2(v[0] / (1.f + __expf(-v[0])) * v[1], v[2] / (1.f + __expf(-v[2])) * v[3]); } } } };
struct GroupedGatherOrder { const int* eoff; const int* cnt; const int* inv; int nunits, G, c;
    __device__ __forceinline__ bool next(int i, Unit& u) const {
        const int x = c & 7, q = i * (G >> 3) + (c >> 3), mt = (q >> 2) * 8 + x; if (mt >= (nunits >> 2)) return false;
        int e = 0; while (e < 15 && (mt << 8) >= eoff[e + 1]) ++e;
        u.pm = mt; u.pn = e * 4 + (q & 3); return true; }
    __device__ __forceinline__ int rowidx(const Unit& u, int r) const { const int e = u.pn >> 2, ix = (u.pm << 8) - eoff[e] + r; return inv[e * 16384 + (ix < cnt[e * 64] ? ix : 0)]; }
    __device__ __forceinline__ void a_ready(const Unit&) const {}
    __device__ __forceinline__ void done(const Unit&) const {}
};
struct GroupedOrder { const int* eoff; int nunits, G, c;
    __device__ __forceinline__ bool next(int i, Unit& u) const {
        const int x = c & 7, q = i * (G >> 3) + (c >> 3), mt = (q >> 2) * 8 + x; if (mt >= (nunits >> 2)) return false;
        int e = 0; while (e < 15 && (mt << 8) >= eoff[e + 1]) ++e;
        u.pm = mt; u.pn = e * 4 + (q & 3); return true; }
    __device__ __forceinline__ void a_ready(const Unit&) const {}
    __device__ __forceinline__ void done(const Unit&) const {}
};
}

__device__ __forceinline__ void ph_prep0(const Params& p, unsigned char* smem) {
    { const int tix = ptid(); if (blockIdx.x == 0 && tix < 128) ((int*)(p.ws + MISC))[tix] = 0; }
    {   const float4* x4 = (const float4*)p.x; uint2* xb = (uint2*)(p.ws + XB);
        const int n4 = T_ * D_ / 4, gt = gthreads();
        for (int i0 = gtid(); i0 < n4; i0 += 8 * gt) {
            f32x4 v[8];
#pragma unroll
            for (int j = 0; j < 8; ++j) { const int i = i0 + j * gt; v[j] = *(const f32x4*)(x4 + (i < n4 ? i : i0)); }
#pragma unroll
            for (int j = 0; j < 8; ++j) { const int i = i0 + j * gt; if (i < n4) xb[i] = make_uint2(pack2(v[j][0], v[j][1]), pack2(v[j][2], v[j][3])); }
        } }
    float* tile = (float*)smem;
    {   float* rt = (float*)(p.ws + ROPE_RT);
        const float inv = (float)pow(10000.0, (double)(-(float)(2 * (gtid() & 127)) / 256.0f));
        for (int it = gtid(); it < S_ * 128; it += gthreads()) { const int t = it >> 7; const float ang = (float)t * inv; float sn, cs; sincosf(ang, &sn, &cs); *(float2*)(rt + it * 2) = make_float2(cs, sn); } }
    { const float* w = p.ret_w_in; transpose_conv([w](int k, int n) { const int c = n < 2048 ? (n & ~255) + ((n & 1) << 7) + ((n & 255) >> 1) : n; return w[(size_t)k * 6144 + c]; }, (bf16_t*)(p.ws + WT_IN), 1024, 6144, tile); }
    { const float* w = p.ret_w_out; transpose_conv([w](int k, int n) { return w[(size_t)k * 1024 + n]; }, (bf16_t*)(p.ws + WT_OUT), 2048, 1024, tile); }
}
constexpr int MOEW_TILES_GU = 4096, MOEW_TILES = 6144;
__device__ __forceinline__ void moe_weights_range(const Params& p, int l, unsigned char* smem, int tb, int te, int rank, int nranks) {
    float* tile = (float*)smem;
    if (tb < MOEW_TILES_GU) { const float* wg = p.moe_wg + (size_t)l * 16 * 1024 * 512; const float* wu = p.moe_wu + (size_t)l * 16 * 1024 * 512;
      const ptrdiff_t du = wu - wg;
      transpose_conv_tiles([wg, du](int k, int n) { const int e = n >> 10, c = n & 1023; return wg[(ptrdiff_t)(c & 1) * du + ((size_t)e * 1024 + k) * 512 + (c >> 1)]; },
                           (bf16_t*)(p.ws + (l ? MOEW1_GU : MOEW_GU)), 1024, tile, tb, te < MOEW_TILES_GU ? te : MOEW_TILES_GU, rank, nranks); }
    if (te > MOEW_TILES_GU) { const float* wd = p.moe_wd + (size_t)l * 16 * 512 * 1024;
      transpose_conv_tiles([wd](int k, int n) { const int e = n >> 10, c = n & 1023; return wd[((size_t)e * 512 + k) * 1024 + c]; }, (bf16_t*)(p.ws + (l ? MOEW1_D : MOEW_D)), 512, tile,
                           (tb > MOEW_TILES_GU ? tb : MOEW_TILES_GU) - MOEW_TILES_GU, te - MOEW_TILES_GU, rank, nranks); }
}
__device__ __forceinline__ void ph_moe_weights(const Params& p, int l, unsigned char* smem) {
    float* tile = (float*)smem;
    { const float* wg = p.moe_wg + (size_t)l * 16 * 1024 * 512; const float* wu = p.moe_wu + (size_t)l * 16 * 1024 * 512;
      const ptrdiff_t du = wu - wg;
      transpose_conv([wg, du](int k, int n) { const int e = n >> 10, c = n & 1023; return wg[(ptrdiff_t)(c & 1) * du + ((size_t)e * 1024 + k) * 512 + (c >> 1)]; },
                     (bf16_t*)(p.ws + MOEW_GU), 1024, 16 * 1024, tile); }
    { const float* wd = p.moe_wd + (size_t)l * 16 * 512 * 1024;
      transpose_conv([wd](int k, int n) { const int e = n >> 10, c = n & 1023; return wd[((size_t)e * 512 + k) * 1024 + c]; }, (bf16_t*)(p.ws + MOEW_D), 512, 16 * 1024, tile); }
}
__device__ __forceinline__ void ph_prep1(const Params& p, unsigned char* smem) {
    float* tile = (float*)smem;
    { const float* wkv = p.nsa_w_kv; const float* win = p.nsa_w_in;
      transpose_conv([wkv, win](int k, int n) { const int sec = n >> 8; const bool rot = (sec == 0 || sec == 2 || sec == 4 || (sec >= 6 && sec < 10));
                         const int c = rot ? (n & ~63) + ((n & 1) << 5) + ((n & 63) >> 1) : n;
                         return c < 1536 ? wkv[(size_t)k * 1536 + c] : (c < 2608 ? win[(size_t)k * 1072 + (c - 1536)] : 0.f); },
                     (bf16_t*)(p.ws + WT_KVQ), 1024, KVQ_N, tile); }
    { const float* wk = p.ck_w2; const ptrdiff_t dv = p.cv_w2 - p.ck_w2; transpose_conv([wk, dv](int k, int n) { return (n & 127) < 64 ? wk[(ptrdiff_t)(n >> 7) * dv + (size_t)k * 64 + (n & 127)] : 0.f; }, (bf16_t*)(p.ws + WT_CW2), 256, 256, tile); }
    {   float* nt = (float*)(p.ws + ROPE_NT);
        const float inv = (float)pow(10000.0, (double)(-(float)(2 * (gtid() & 31)) / 64.0f));
        for (int it = gtid(); it < S_ * 32; it += gthreads()) { const int t = it >> 5; const float ang = (float)t * inv; float sn, cs; sincosf(ang, &sn, &cs); *(float2*)(nt + it * 2) = make_float2(cs, sn); } }
    {
        const int lane = ptid() & 63; float* part = (float*)(p.ws + ATTN_OUT);
        for (int it = gwave(); it < 256; it += gwaves()) {
            const int kv = it >> 7, jg = (it >> 5) & 3, ks = it & 31; const float* w1 = (kv ? p.cv_w1 : p.ck_w1) + (size_t)ks * 64 * 256 + jg * 64 + lane; const float* pe = (kv ? p.pe_v : p.pe_k) + ks * 64;
            float a = 0.f;
#pragma unroll
            for (int kb = 0; kb < 64; kb += 16) {
                float wv[16], pv[16];
#pragma unroll
                for (int k = 0; k < 16; ++k) { wv[k] = w1[(size_t)(kb + k) * 256]; pv[k] = pe[kb + k]; }
#pragma unroll
                for (int k = 0; k < 16; ++k) a += pv[k] * wv[k];
            }
            part[ks * 512 + kv * 256 + jg * 64 + lane] = a;
        } }
    { const float* w = p.nsa_w_out; transpose_conv([w](int k, int n) { return w[(size_t)k * 1024 + n]; }, (bf16_t*)(p.ws + WT_NSAOUT), 1024, 1024, tile); }
    { const float* wk = p.ck_w1; const ptrdiff_t dv = p.cv_w1 - p.ck_w1; transpose_conv([wk, dv](int k, int n) { return wk[(ptrdiff_t)(n >> 8) * dv + (size_t)k * 256 + (n & 255)]; }, (bf16_t*)(p.ws + WT_CW1), 2048, 512, tile); }
}

struct EpiRetIn : EpiBase { const Params* p; int m0, n0; float lg; int head, sec; float kd[4]; int wm_, fr_;
    __device__ __forceinline__ void start(int wm, int wn, int fr, int) {
        wm_ = wm; fr_ = fr; sec = n0 >> 10; head = ((n0 + wn * 64) >> 8) & 3;
        lg = log2f(1.f - exp2f(-5.f - (float)head));
#pragma unroll
        for (int i = 0; i < 4; ++i) { const int t = (m0 + wm * 64 + i * 16 + fr) & (S_ - 1); kd[i] = sec == 1 ? 0.0625f * exp2f((float)(127 - (t & 127)) * lg) : 1.f; }
    }
    __device__ __forceinline__ void operator()(int m, int n, f32x4 v) const {
        const size_t tok = (size_t)(m0 + m); const int c = n0 + n;
        if (n0 < 2048) {
            const int d = (c & 255) >> 1, t = (int)tok & (S_ - 1), i = (m - wm_ * 64 - fr_) >> 4;
            const f32x4 cs = *(const f32x4*)((const float*)(p->ws + ROPE_RT) + ((size_t)t * 128 + d) * 2);
            const float sc = i == 0 ? kd[0] : (i == 1 ? kd[1] : (i == 2 ? kd[2] : kd[3]));
            const float a0 = (v[0] * cs[0] - v[1] * cs[1]) * sc, b0 = (v[1] * cs[0] + v[0] * cs[1]) * sc, a1 = (v[2] * cs[2] - v[3] * cs[3]) * sc, b1 = (v[3] * cs[2] + v[2] * cs[3]) * sc;
            bf16_t* dst = (bf16_t*)(p->ws + (sec ? KB : QB)) + tok * 1024 + head * 256 + d;
            *(unsigned*)dst = pack2(a0, a1); *(unsigned*)(dst + 128) = pack2(b0, b1);
        } else {
            bf16_t* dst = (n0 < 4096 ? (bf16_t*)(p->ws + VB) + (c - 2048) : (bf16_t*)(p->ws + GB) + (c - 4096)) + tok * 2048;
            *(u32x2*)dst = (u32x2){pack2(v[0], v[1]), pack2(v[2], v[3])};
        }
    }
};
__device__ __forceinline__ void ph_gemm_retin(const Params& p, unsigned char* smem) {
    const bf16_t* A = (const bf16_t*)(p.ws + XB); const bf16_t* Bt = (const bf16_t*)(p.ws + WT_IN);
    for (int t = blockIdx.x; t < 64 * 48; t += gridDim.x) {
        const int mt = t / 48, nt = t % 48, n0 = nt * 128;
        EpiRetIn e{}; e.p = &p; e.m0 = mt * 256; e.n0 = n0;
        gemm_tile(A + (size_t)mt * 256 * 1024, 1024, Bt + (size_t)n0 * 1024, 1024, 1024, e, smem);
    }
}
__device__ __forceinline__ void ph_gemm_f32(const bf16_t* A, const bf16_t* Bt, float* C, int Mt, int Nt, int K, int N, unsigned char* smem) {
    for (int t = blockIdx.x; t < Mt * Nt; t += gridDim.x) {
        const int mt = t / Nt, nt = t % Nt;
        gemm_tile(A + (size_t)mt * 256 * K, K, Bt + (size_t)nt * 128 * K, K, K, EpiF32{{}, C + (size_t)mt * 256 * N + nt * 128, N}, smem);
    }
}
__device__ __forceinline__ void ph_gemm_bf16(const bf16_t* A, const bf16_t* Bt, bf16_t* C, int Mt, int Nt, int K, int N, unsigned char* smem) {
    for (int t = blockIdx.x; t < Mt * Nt; t += gridDim.x) {
        const int mt = t / Nt, nt = t % Nt;
        gemm_tile(A + (size_t)mt * 256 * K, K, Bt + (size_t)nt * 128 * K, K, K, EpiBf16{{}, C + (size_t)mt * 256 * N + nt * 128, N}, smem);
    }
}

typedef short s16x4 __attribute__((ext_vector_type(4)));
#define LDSP(T, ptr) ((__attribute__((address_space(3))) T*)(ptr))
__device__ __forceinline__ bf16x8 tr_frag(const bf16_t* tile, int ld, int row0, int col0, int lane) {
    const int g = lane >> 4, q = (lane & 15) >> 2, pp = lane & 3;
    const bf16_t* a = tile + (row0 + 8 * g + q) * ld + col0 + 4 * pp;
    const s16x4 lo = __builtin_amdgcn_ds_read_tr16_b64_v4i16(LDSP(s16x4, a));
    const s16x4 hi = __builtin_amdgcn_ds_read_tr16_b64_v4i16(LDSP(s16x4, a + 4 * ld));
    return (bf16x8){lo[0], lo[1], lo[2], lo[3], hi[0], hi[1], hi[2], hi[3]};
}
__device__ __forceinline__ bf16x8 pack_frag(f32x4 a, f32x4 b) {
    u32x4 u = {pack2(a[0], a[1]), pack2(a[2], a[3]), pack2(b[0], b[1]), pack2(b[2], b[3])};
    return __builtin_bit_cast(bf16x8, u);
}
constexpr int RQ_LD = 264, RK_LD = 136;
template <int NCH> __device__ __forceinline__ void stage_tile(const bf16_t* g, int gld, bf16_t* l, int lld) {
    const int tix = ptid(), row = tix / NCH, ch = tix % NCH, goff = row * gld + ch * 8, loff = row * lld + ch * 8;
#pragma unroll
    for (int i = 0; i < (128 * NCH) / NT; ++i) { *(u32x4*)(l + loff + i * (NT / NCH) * lld) = *(const u32x4*)(g + (size_t)i * (NT / NCH) * gld + goff); if ((i & 3) == 3) asm volatile("" ::: "memory"); }
}
__device__ __forceinline__ void ph_ret_state(const Params& p, unsigned char* smem) {
    const bf16_t* K = (const bf16_t*)(p.ws + KB); const bf16_t* V = (const bf16_t*)(p.ws + VB); float* L = (float*)(p.ws + RET_L);
    bf16_t* Ks = (bf16_t*)smem; bf16_t* Vs = Ks + 128 * RQ_LD;
    const int tix = ptid(), lane = tix & 63, w = __builtin_amdgcn_readfirstlane(tix >> 6), g = lane >> 4, i16 = lane & 15;
    for (int unit = blockIdx.x; unit < 224; unit += gridDim.x) {
        const int slice = unit & 3, seg = (unit >> 2) % 7, bh = unit / 28, b = bh >> 2, h = bh & 3;
        const float lg = log2f(1.f - exp2f(-5.f - (float)h)), g128 = exp2f(128.f * lg);
        f32x4 S[16];
#pragma unroll
        for (int dt = 0; dt < 16; ++dt) S[dt] = (f32x4){0.f, 0.f, 0.f, 0.f};
        u32x4 pk[8], pv[4];
        const int kg = (tix >> 5) * 1024 + (tix & 31) * 8, kl = (tix >> 5) * RQ_LD + (tix & 31) * 8, vg = (tix >> 4) * 2048 + (tix & 15) * 8, vl = (tix >> 4) * RK_LD + (tix & 15) * 8;
        {   const size_t t0 = (size_t)b * S_ + seg * 1024;
#pragma unroll
            for (int i = 0; i < 8; ++i) pk[i] = *(const u32x4*)(K + t0 * 1024 + h * 256 + (size_t)i * 16 * 1024 + kg);
#pragma unroll
            for (int i = 0; i < 4; ++i) pv[i] = *(const u32x4*)(V + t0 * 2048 + h * 512 + slice * 128 + (size_t)i * 32 * 2048 + vg); }
        for (int ch = 0; ch < 8; ++ch) {
            __syncthreads();
#pragma unroll
            for (int i = 0; i < 8; ++i) *(u32x4*)(Ks + kl + i * 16 * RQ_LD) = pk[i];
#pragma unroll
            for (int i = 0; i < 4; ++i) *(u32x4*)(Vs + vl + i * 32 * RK_LD) = pv[i];
            __syncthreads();
            {   const size_t t1 = (size_t)b * S_ + seg * 1024 + (ch < 7 ? ch + 1 : ch) * 128;
#pragma unroll
                for (int i = 0; i < 8; ++i) pk[i] = *(const u32x4*)(K + t1 * 1024 + h * 256 + (size_t)i * 16 * 1024 + kg);
#pragma unroll
                for (int i = 0; i < 4; ++i) pv[i] = *(const u32x4*)(V + t1 * 2048 + h * 512 + slice * 128 + (size_t)i * 32 * 2048 + vg); }
            bf16x8 Vf[4];
#pragma unroll
            for (int ks = 0; ks < 4; ++ks) Vf[ks] = tr_frag(Vs, RK_LD, 32 * ks, 16 * w, lane);
#pragma unroll
            for (int dt = 0; dt < 16; ++dt) {
                S[dt] = S[dt] * g128;
#pragma unroll
                for (int ks = 0; ks < 4; ++ks) S[dt] = __builtin_amdgcn_mfma_f32_16x16x32_bf16(tr_frag(Ks, RQ_LD, 32 * ks, 16 * dt, lane), Vf[ks], S[dt], 0, 0, 0);
            }
        }
        bf16_t* Lu = (bf16_t*)L + (size_t)((bh * 8 + seg) * 4 + slice) * (256 * 128) + tix * 64;
#pragma unroll
        for (int dt = 0; dt < 16; dt += 2) *(u32x4*)(Lu + dt * 4) = (u32x4){pack2(S[dt][0], S[dt][1]), pack2(S[dt][2], S[dt][3]), pack2(S[dt + 1][0], S[dt + 1][1]), pack2(S[dt + 1][2], S[dt + 1][3])};
    }
}
__device__ __forceinline__ void ph_ret_scan(const Params& p, unsigned char* smem) {
    const bf16_t* Q = (const bf16_t*)(p.ws + QB); const bf16_t* K = (const bf16_t*)(p.ws + KB); const bf16_t* V = (const bf16_t*)(p.ws + VB);
    const float* L = (const float*)(p.ws + RET_L); bf16_t* O = (bf16_t*)p.out;
    bf16_t* Qs = (bf16_t*)smem; bf16_t* Ks = Qs + 128 * RK_LD; bf16_t* Vs = Ks + 128 * RK_LD; bf16_t* Ps = Vs + 128 * RK_LD;
    for (int unit = blockIdx.x; unit < 256; unit += gridDim.x) {
        const int tix = ptid(), lane = tix & 63, w = __builtin_amdgcn_readfirstlane(tix >> 6), g = lane >> 4, i16 = lane & 15;
        const int slice = unit & 3, seg = (unit >> 2) & 7, bh = unit >> 5, b = bh >> 2, h = bh & 3;
        const float lg = log2f(1.f - exp2f(-5.f - (float)h)), g128 = exp2f(128.f * lg), g1024 = exp2f(1024.f * lg), gm128 = exp2f(-128.f * lg);
        f32x4 S[16];
#pragma unroll
        for (int dt = 0; dt < 16; ++dt) S[dt] = (f32x4){0.f, 0.f, 0.f, 0.f};
        for (int j = 0; j < seg; ++j) {
            const bf16_t* Lu = (const bf16_t*)L + (size_t)((bh * 8 + j) * 4 + slice) * (256 * 128) + tix * 64;
            u32x4 lv[8];
#pragma unroll
            for (int dt = 0; dt < 8; ++dt) lv[dt] = *(const u32x4*)(Lu + dt * 8);
#pragma unroll
            for (int dt = 0; dt < 8; ++dt) {
                S[2 * dt] = S[2 * dt] * g1024 + (f32x4){lo2f(lv[dt][0]), hi2f(lv[dt][0]), lo2f(lv[dt][1]), hi2f(lv[dt][1])};
                S[2 * dt + 1] = S[2 * dt + 1] * g1024 + (f32x4){lo2f(lv[dt][2]), hi2f(lv[dt][2]), lo2f(lv[dt][3]), hi2f(lv[dt][3])}; }
        }
        u32x4 pfq[4], pfk[4], pfv[4]; const int pfg = (tix >> 4) * 1024 + (tix & 15) * 8, pfl = (tix >> 4) * RK_LD + (tix & 15) * 8, pvg = (tix >> 4) * 2048 + (tix & 15) * 8;
        {   const bf16_t* q0 = Q + ((size_t)b * S_ + seg * 1024) * 1024 + h * 256; const bf16_t* k0_ = K + ((size_t)b * S_ + seg * 1024) * 1024 + h * 256;
#pragma unroll
            for (int i = 0; i < 4; ++i) { pfq[i] = *(const u32x4*)(q0 + (size_t)i * 32 * 1024 + pfg); pfk[i] = *(const u32x4*)(k0_ + (size_t)i * 32 * 1024 + pfg);
                pfv[i] = *(const u32x4*)(V + ((size_t)b * S_ + seg * 1024 + (size_t)i * 32) * 2048 + h * 512 + slice * 128 + pvg); } }
        for (int ch = 0; ch < 8; ++ch) {
            const size_t tok0 = (size_t)b * S_ + seg * 1024 + ch * 128;
            f32x4 Oa[8], P[8];
#pragma unroll
            for (int i = 0; i < 8; ++i) { Oa[i] = (f32x4){0.f, 0.f, 0.f, 0.f}; P[i] = (f32x4){0.f, 0.f, 0.f, 0.f}; }
#pragma unroll
            for (int hf = 0; hf < 2; ++hf) {
                __syncthreads();
#pragma unroll
                for (int i = 0; i < 4; ++i) { *(u32x4*)(Qs + pfl + i * 32 * RK_LD) = pfq[i]; *(u32x4*)(Ks + pfl + i * 32 * RK_LD) = pfk[i]; }
                if (hf == 0) {
#pragma unroll
                    for (int i = 0; i < 4; ++i) *(u32x4*)(Vs + pfl + i * 32 * RK_LD) = pfv[i]; }
                __syncthreads();
                {
                    const int nch = hf == 0 ? ch : (ch < 7 ? ch + 1 : ch), nhf = hf == 0 ? 1 : (ch < 7 ? 0 : 1);
                    const bf16_t* qn_ = Q + ((size_t)b * S_ + seg * 1024 + nch * 128) * 1024 + h * 256 + nhf * 128; const bf16_t* kn_ = K + ((size_t)b * S_ + seg * 1024 + nch * 128) * 1024 + h * 256 + nhf * 128;
#pragma unroll
                    for (int i = 0; i < 4; ++i) { pfq[i] = *(const u32x4*)(qn_ + (size_t)i * 32 * 1024 + pfg); pfk[i] = *(const u32x4*)(kn_ + (size_t)i * 32 * 1024 + pfg); }
                }
                {
                    bf16x8 Sf[4];
#pragma unroll
                    for (int ks = 0; ks < 4; ++ks) Sf[ks] = pack_frag(S[8 * hf + 2 * ks], S[8 * hf + 2 * ks + 1]);
#pragma unroll
                    for (int ct = 0; ct < 8; ++ct) {
#pragma unroll
                        for (int ks = 0; ks < 4; ++ks) {
                            const bf16_t* qa = Qs + (16 * ct + i16) * RK_LD + 32 * ks + 4 * g;
                            const u32x2 lo = *(const u32x2*)qa, hi = *(const u32x2*)(qa + 16);
                            const u32x4 qq = {lo[0], lo[1], hi[0], hi[1]};
                            Oa[ct] = __builtin_amdgcn_mfma_f32_16x16x32_bf16(Sf[ks], __builtin_bit_cast(bf16x8, qq), Oa[ct], 0, 0, 0);
                        }
                        if (ct & 1) __builtin_amdgcn_sched_barrier(0);
                    }
                }
#pragma unroll
                for (int ks = 0; ks < 4; ++ks) {
                    const bf16x8 Qf = *(const bf16x8*)(Qs + (16 * w + i16) * RK_LD + 32 * ks + 8 * g);
#pragma unroll
                    for (int mt = 0; mt < 8; ++mt) if (mt <= w) P[mt] = __builtin_amdgcn_mfma_f32_16x16x32_bf16(*(const bf16x8*)(Ks + (16 * mt + i16) * RK_LD + 32 * ks + 8 * g), Qf, P[mt], 0, 0, 0);
                }
                __builtin_amdgcn_sched_barrier(0);
                if (hf == 1) {
                    const int c = 16 * w + i16;
#pragma unroll
                    for (int mt = 0; mt < 8; ++mt) {
                        float v[4];
#pragma unroll
                        for (int r = 0; r < 4; ++r) { const int m = 16 * mt + 4 * g + r; v[r] = (mt <= w && m <= c) ? P[mt][r] * gm128 : 0.f; }
                        *(u32x2*)(Ps + c * RK_LD + 16 * mt + 4 * g) = (u32x2){pack2(v[0], v[1]), pack2(v[2], v[3])};
                    }
                    {   const int nch = ch < 7 ? ch + 1 : ch;
#pragma unroll
                        for (int i = 0; i < 4; ++i) pfv[i] = *(const u32x4*)(V + ((size_t)b * S_ + seg * 1024 + nch * 128 + (size_t)i * 32) * 2048 + h * 512 + slice * 128 + pvg); }
                }
                {
                    bf16x8 Vf[4];
#pragma unroll
                    for (int ks = 0; ks < 4; ++ks) Vf[ks] = tr_frag(Vs, RK_LD, 32 * ks, 16 * w, lane);
#pragma unroll
                    for (int dt = 0; dt < 8; ++dt) {
                        S[8 * hf + dt] = S[8 * hf + dt] * g128;
#pragma unroll
                        for (int ks = 0; ks < 4; ++ks) S[8 * hf + dt] = __builtin_amdgcn_mfma_f32_16x16x32_bf16(tr_frag(Ks, RK_LD, 32 * ks, 16 * dt, lane), Vf[ks], S[8 * hf + dt], 0, 0, 0);
                        if (dt & 1) __builtin_amdgcn_sched_barrier(0);
                    }
                }
            }
            __syncthreads();
            {
                bf16x8 Vf[4];
#pragma unroll
                for (int ks = 0; ks < 4; ++ks) Vf[ks] = tr_frag(Vs, RK_LD, 32 * ks, 16 * w, lane);
#pragma unroll
                for (int ct = 0; ct < 8; ++ct)
#pragma unroll
                    for (int ks = 0; ks < 4; ++ks) if (ks <= ct / 2) Oa[ct] = __builtin_amdgcn_mfma_f32_16x16x32_bf16(Vf[ks], *(const bf16x8*)(Ps + (16 * ct + i16) * RK_LD + 32 * ks + 8 * g), Oa[ct], 0, 0, 0);
            }
            {
                bf16_t* ob = O + tok0 * 2048 + h * 512 + slice * 128 + 16 * w; const int ooff = i16 * 2048 + 4 * g;
#pragma unroll
                for (int ct = 0; ct < 8; ++ct) { const float sc = exp2f((float)(16 * ct + i16 + 1) * lg); *(u32x2*)(ob + (size_t)ct * 16 * 2048 + ooff) = (u32x2){pack2(Oa[ct][0] * sc, Oa[ct][1] * sc), pack2(Oa[ct][2] * sc, Oa[ct][3] * sc)}; }
            }
        }
    }
}
__device__ __forceinline__ void ph_gnorm_gate(const Params& p) {
    bf16_t* O = (bf16_t*)p.out; const bf16_t* G = (const bf16_t*)(p.ws + GB);
    const int lane = ptid() & 63, gw = gwaves();
    for (int it0 = gwave(); it0 < T_ * 4; it0 += 4 * gw) {
        u32x4 xr[4], gr[4];
#pragma unroll
        for (int u = 0; u < 4; ++u) { const int it = it0 + u * gw < T_ * 4 ? it0 + u * gw : it0; const size_t off = (size_t)it * 512 + lane * 8; xr[u] = *(const u32x4*)(O + off); gr[u] = *(const u32x4*)(G + off); }
#pragma unroll
        for (int u = 0; u < 4; ++u) {
            const int it = it0 + u * gw; if (it >= T_ * 4) break;
            const size_t off = (size_t)it * 512 + lane * 8;
            float x[8], g[8]; unpack8(xr[u], x); unpack8(gr[u], g);
            float s = 0.f;
#pragma unroll
            for (int j = 0; j < 8; ++j) s += x[j];
            const float mean = wave_sum(s) * (1.f / 512.f);
            float q = 0.f;
#pragma unroll
            for (int j = 0; j < 8; ++j) { x[j] -= mean; q += x[j] * x[j]; }
            const float rstd = rsqrtf(wave_sum(q) * (1.f / 512.f) + 1e-5f);
            float r[8];
#pragma unroll
            for (int j = 0; j < 8; ++j) r[j] = x[j] * rstd * (g[j] / (1.f + __expf(-g[j])));
            *(u32x4*)(O + off) = (u32x4){pack2(r[0], r[1]), pack2(r[2], r[3]), pack2(r[4], r[5]), pack2(r[6], r[7])};
        }
    }
}

template <bool BASEBF> __device__ __forceinline__ void ph_ln_router(const Params& p, const float* base, const bf16_t* mix, bf16_t* hb, const float* lng, const float* lnb, int layer, unsigned char* smem) {
    const int tix = ptid(), lane = tix & 63, w = __builtin_amdgcn_readfirstlane(tix >> 6);
    int* misc = (int*)(p.ws + MISC);
    constexpr int HT_LD = 1028;
    float* WB = (float*)smem;
    float* HT = (float*)(smem + 65536);
    int* lcnt = (int*)(smem + 65536 + 16 * HT_LD * 4);
    int* lbase = lcnt + 16; int* llist = lcnt + 32; int nloc = 0;
    float* PART = (float*)(smem + 135168);
    float* LOGT = (float*)(smem + 143360);
    static_assert(143360 + 1024 <= LDS_BYTES - 16 && 65536 + 16 * HT_LD * 4 + 128 + 8 * 16 * 5 * 4 <= 135168, "router LDS");
    struct In { f32x4 a[4]; u32x2 mb[4], ab[4]; };
    auto load = [&](int tok, In& in) {
#pragma unroll
        for (int i = 0; i < 4; ++i) {
            if (BASEBF) in.ab[i] = *(const u32x2*)((const bf16_t*)base + (size_t)tok * 1024 + i * 256 + lane * 4); else in.a[i] = *(const f32x4*)(base + (size_t)tok * 1024 + i * 256 + lane * 4);
            in.mb[i] = *(const u32x2*)(mix + (size_t)tok * 1024 + i * 256 + lane * 4);
        } };
    In iA, iB, iC, iD;
    { const int q0 = (int)blockIdx.x; if (q0 < T_ / 16) { load(16 * q0 + 2 * w, iA); load(16 * q0 + 2 * w + 1, iB); } }
    for (int i0 = 0; i0 < 1024 * 16; i0 += 8 * NT) {
        float rv[8];
#pragma unroll
        for (int j = 0; j < 8; ++j) rv[j] = p.router_w[i0 + j * NT + tix];
#pragma unroll
        for (int j = 0; j < 8; ++j) { const int idx = i0 + j * NT + tix, d = idx >> 4, e = idx & 15; WB[((((d >> 4) * 4 + ((d >> 2) & 3)) * 16 + e) << 2) + (d & 3)] = rv[j]; }
    }
    if (tix < 16) lcnt[tix] = 0;
    __syncthreads();
    const float rbL = p.router_b[lane >> 2];
    auto norm = [&](int tok, int j, const In& in) {
        float v[16];
#pragma unroll
        for (int i = 0; i < 4; ++i) {
            const f32x4 m = {lo2f(in.mb[i][0]), hi2f(in.mb[i][0]), lo2f(in.mb[i][1]), hi2f(in.mb[i][1])};
            const f32x4 av = BASEBF ? (f32x4){lo2f(in.ab[i][0]), hi2f(in.ab[i][0]), lo2f(in.ab[i][1]), hi2f(in.ab[i][1])} : in.a[i];
            v[i * 4 + 0] = 1.41421356237f * av[0] + m[0]; v[i * 4 + 1] = 1.41421356237f * av[1] + m[1]; v[i * 4 + 2] = 1.41421356237f * av[2] + m[2]; v[i * 4 + 3] = 1.41421356237f * av[3] + m[3];
        }
        float s = 0.f;
#pragma unroll
        for (int i = 0; i < 16; ++i) s += v[i];
        const float mean = wave_sum(s) * (1.f / 1024.f);
        float q = 0.f;
#pragma unroll
        for (int i = 0; i < 16; ++i) { v[i] -= mean; q += v[i] * v[i]; }
        const float rstd = rsqrtf(wave_sum(q) * (1.f / 1024.f) + 1e-5f);
#pragma unroll
        for (int i = 0; i < 4; ++i) {
            const float4 g = *(const float4*)(lng + i * 256 + lane * 4), bb = *(const float4*)(lnb + i * 256 + lane * 4);
            v[i * 4 + 0] = v[i * 4 + 0] * rstd * g.x + bb.x; v[i * 4 + 1] = v[i * 4 + 1] * rstd * g.y + bb.y; v[i * 4 + 2] = v[i * 4 + 2] * rstd * g.z + bb.z; v[i * 4 + 3] = v[i * 4 + 3] * rstd * g.w + bb.w;
            *(uint2*)(hb + (size_t)tok * 1024 + i * 256 + lane * 4) = make_uint2(pack2(v[i * 4 + 0], v[i * 4 + 1]), pack2(v[i * 4 + 2], v[i * 4 + 3]));
            *(f32x4*)(HT + j * HT_LD + i * 256 + lane * 4) = (f32x4){v[i * 4 + 0], v[i * 4 + 1], v[i * 4 + 2], v[i * 4 + 3]};
        } };
    auto route = [&](int tok, float r1) {
        const float affL = 1.f / (1.f + expf(-r1)), selL = affL + rbL;
        const float xb_ = __int_as_float(__builtin_amdgcn_update_dpp(0, __float_as_int(selL), 0x124, 0xF, 0xF, false)), xc_ = __int_as_float(__builtin_amdgcn_update_dpp(0, __float_as_int(selL), 0x128, 0xF, 0xF, false)),
                    xd_ = __int_as_float(__builtin_amdgcn_update_dpp(0, __float_as_int(selL), 0x12C, 0xF, 0xF, false));
        const float mxg = fmaxf(fmaxf(selL, xb_), fmaxf(xc_, xd_));
        const float m2g = fmaxf(fmaxf(fminf(selL, xb_), fminf(xc_, xd_)), fminf(fmaxf(selL, xb_), fmaxf(xc_, xd_)));
        const float gsl = mxg + m2g;
        float best = -3.0e38f; int bg = 0;
#pragma unroll
        for (int g = 0; g < 4; ++g) { const float gs = __shfl(gsl, 16 * g); if (gs > best) { best = gs; bg = g; } }
        const float b0 = __shfl(selL, 16 * bg), b1 = __shfl(selL, 16 * bg + 4), b2 = __shfl(selL, 16 * bg + 8), b3 = __shfl(selL, 16 * bg + 12);
        const float a0 = __shfl(affL, 16 * bg), a1 = __shfl(affL, 16 * bg + 4), a2 = __shfl(affL, 16 * bg + 8), a3 = __shfl(affL, 16 * bg + 12);
        int i1 = 0; float m = b0, wa = a0;
        if (b1 > m) { m = b1; i1 = 1; wa = a1; } if (b2 > m) { m = b2; i1 = 2; wa = a2; } if (b3 > m) { m = b3; i1 = 3; wa = a3; }
        int i2 = -1; float m2 = -3.0e38f, wb = 0.f;
        if (i1 != 0 && b0 > m2) { m2 = b0; i2 = 0; wb = a0; } if (i1 != 1 && b1 > m2) { m2 = b1; i2 = 1; wb = a1; }
        if (i1 != 2 && b2 > m2) { m2 = b2; i2 = 2; wb = a2; } if (i1 != 3 && b3 > m2) { m2 = b3; i2 = 3; wb = a3; }
        const float nrm = wa + wb;
        if (lane == 0) {
            const int e1 = bg * 4 + i1, e2 = bg * 4 + i2;
            misc[MI_TE + tok * 2] = e1; misc[MI_TE + tok * 2 + 1] = e2;
            misc[MI_TW + tok * 2] = __float_as_int(wa / nrm); misc[MI_TW + tok * 2 + 1] = __float_as_int(wb / nrm);
            const int li1 = atomicAdd(&lcnt[e1], 1), li2 = atomicAdd(&lcnt[e2], 1);
            int* ent = llist + ((tix >> 6) * 16 + nloc) * 5; ent[0] = tok; ent[1] = e1; ent[2] = e2; ent[3] = li1; ent[4] = li2;
        }
        ++nloc;
    };
    auto round = [&](int q, const In& x0, const In& x1) {
        norm(16 * q + 2 * w, 2 * w, x0); norm(16 * q + 2 * w + 1, 2 * w + 1, x1);
        __syncthreads();
        f32x4 acc = {0.f, 0.f, 0.f, 0.f};
#pragma unroll
        for (int st = 0; st < 8; ++st) {
            const int sp = 8 * w + st;
            const f32x4 av = *(const f32x4*)(HT + (lane & 15) * HT_LD + 16 * sp + 4 * (lane >> 4)), bv = *(const f32x4*)(WB + (((sp * 4 + (lane >> 4)) * 16 + (lane & 15)) << 2));
#pragma unroll
            for (int i = 0; i < 4; ++i) acc = __builtin_amdgcn_mfma_f32_16x16x4f32(av[i], bv[i], acc, 0, 0, 0);
        }
        *(f32x4*)(PART + ((w * 64 + lane) << 2)) = acc;
        __syncthreads();
#pragma unroll
        for (int t = 0; t < 2; ++t) {
            const int j = 2 * w + t; float sum = 0.f;
#pragma unroll
            for (int w2 = 0; w2 < 8; ++w2) sum += PART[w2 * 256 + (((j >> 2) * 16 + (lane >> 2)) << 2) + (j & 3)];
            route(16 * q + j, sum);
        }
    };
    {
        const int G = (int)gridDim.x, nr = T_ / 16;
        int q = (int)blockIdx.x;
        while (q < nr) {
            const int qn = q + G, qa = qn < nr ? qn : q;
            load(16 * qa + 2 * w, iC); load(16 * qa + 2 * w + 1, iD);
            round(q, iA, iB);
            if (qn >= nr) break;
            const int qm = qn + G, qb = qm < nr ? qm : qn;
            load(16 * qb + 2 * w, iA); load(16 * qb + 2 * w + 1, iB);
            round(qn, iC, iD);
            q = qm;
        }
    }
    {
        __syncthreads();
        int* cnt = (int*)(p.ws + CNT_OFF) + layer * 1024;
        if (tix < 16) lbase[tix] = lcnt[tix] ? atomicAdd(&cnt[tix * 64], lcnt[tix]) : 0;
        __syncthreads();
        int* inv = (int*)(p.ws + MOE_INV);
        const int wv = tix >> 6, k = tix & 63;
        if (k < nloc) { const int* ent = llist + (wv * 16 + k) * 5; const int tok = ent[0], e1 = ent[1], e2 = ent[2], i1x = lbase[e1] + ent[3], i2x = lbase[e2] + ent[4];
            misc[MI_TI + tok * 2] = i1x; misc[MI_TI + tok * 2 + 1] = i2x; inv[e1 * 16384 + i1x] = tok; inv[e2 * 16384 + i2x] = tok; }
    }

}

template <bool COMBINE, bool ROUTER, bool FINAL, bool BASEBF> __forceinline__
__device__ __forceinline__ void ph_ln(const Params& p, const float* base, const float* mix, float* hout, bf16_t* hb, const float* lng, const float* lnb, int layer, unsigned char* smem) {
    const int tix = ptid(), lane = tix & 63;
    int* misc = (int*)(p.ws + MISC);
    const bf16_t* yexp = (const bf16_t*)(p.ws + YEXP);
    float* rwl = (float*)smem;
    int* eoffs = (int*)(smem + 65536);
    int* lcnt = (int*)(smem + 65536 + 256);
    int* lbase = lcnt + 16; int* llist = lcnt + 32; int nloc = 0;
    if (ROUTER) {
        for (int i0 = 0; i0 < 1024 * 16; i0 += 8 * NT) {
            float rv[8];
#pragma unroll
            for (int j = 0; j < 8; ++j) rv[j] = p.router_w[i0 + j * NT + tix];
#pragma unroll
            for (int j = 0; j < 8; ++j) { const int idx = i0 + j * NT + tix, d = idx >> 4, e = idx & 15; rwl[(((((d >> 8) * 4 + (d & 3)) * 4 + (e >> 2)) * 64 + ((d & 255) >> 2)) << 2) + (e & 3)] = rv[j]; }
        }
        if (tix < 16) lcnt[tix] = 0;
        __syncthreads();
    }
    if (COMBINE) {
        if (tix == 0) { const int* cnt = (const int*)(p.ws + CNT_OFF) + layer * 1024; int o = 0; for (int e = 0; e < 16; ++e) { eoffs[e] = o; o += (cnt[e * 64] + 255) & ~255; } }
        __syncthreads();
    }
    struct LnIn { f32x4 a[4], m[4]; u32x2 ab[4], y0[4], y1[4]; float w0, w1; };
    int pr0 = 0, pr1 = 0; float pw0 = 0.f, pw1 = 0.f;
    auto ln_load = [&](int tok, int ix, LnIn& in) {
        int r0 = 0, r1 = 0;
        if (COMBINE) { in.w0 = __shfl(pw0, ix); in.w1 = __shfl(pw1, ix); r0 = __shfl(pr0, ix); r1 = __shfl(pr1, ix); }
#pragma unroll
        for (int i = 0; i < 4; ++i) {
            if (BASEBF) in.ab[i] = *(const u32x2*)((const bf16_t*)base + (size_t)tok * 1024 + i * 256 + lane * 4); else in.a[i] = *(const f32x4*)(base + (size_t)tok * 1024 + i * 256 + lane * 4);
            if (COMBINE) { in.y0[i] = *(const u32x2*)(yexp + (size_t)r0 * 1024 + i * 256 + lane * 4); in.y1[i] = *(const u32x2*)(yexp + (size_t)r1 * 1024 + i * 256 + lane * 4); }
            else in.m[i] = *(const f32x4*)(mix + (size_t)tok * 1024 + i * 256 + lane * 4);
        }
    };
    auto ln_token = [&](int tok, const LnIn& in) {
        float v[16];
#pragma unroll
        for (int i = 0; i < 4; ++i) {
            f32x4 m;
            if (COMBINE) { m[0] = in.w0 * lo2f(in.y0[i][0]) + in.w1 * lo2f(in.y1[i][0]); m[1] = in.w0 * hi2f(in.y0[i][0]) + in.w1 * hi2f(in.y1[i][0]); m[2] = in.w0 * lo2f(in.y0[i][1]) + in.w1 * lo2f(in.y1[i][1]); m[3] = in.w0 * hi2f(in.y0[i][1]) + in.w1 * hi2f(in.y1[i][1]); }
            else m = in.m[i];
            const f32x4 av = BASEBF ? (f32x4){lo2f(in.ab[i][0]), hi2f(in.ab[i][0]), lo2f(in.ab[i][1]), hi2f(in.ab[i][1])} : in.a[i];
            v[i * 4 + 0] = 1.41421356237f * av[0] + m[0]; v[i * 4 + 1] = 1.41421356237f * av[1] + m[1]; v[i * 4 + 2] = 1.41421356237f * av[2] + m[2]; v[i * 4 + 3] = 1.41421356237f * av[3] + m[3];
        }
        float s = 0.f;
#pragma unroll
        for (int i = 0; i < 16; ++i) s += v[i];
        const float mean = wave_sum(s) * (1.f / 1024.f);
        float q = 0.f;
#pragma unroll
        for (int i = 0; i < 16; ++i) { v[i] -= mean; q += v[i] * v[i]; }
        const float rstd = rsqrtf(wave_sum(q) * (1.f / 1024.f) + 1e-5f);
#pragma unroll
        for (int i = 0; i < 4; ++i) {
            const float4 g = *(const float4*)(lng + i * 256 + lane * 4), bb = *(const float4*)(lnb + i * 256 + lane * 4);
            v[i * 4 + 0] = v[i * 4 + 0] * rstd * g.x + bb.x; v[i * 4 + 1] = v[i * 4 + 1] * rstd * g.y + bb.y; v[i * 4 + 2] = v[i * 4 + 2] * rstd * g.z + bb.z; v[i * 4 + 3] = v[i * 4 + 3] * rstd * g.w + bb.w;
            if (FINAL) *(float4*)(hout + (size_t)tok * 1024 + i * 256 + lane * 4) = make_float4(v[i * 4 + 0], v[i * 4 + 1], v[i * 4 + 2], v[i * 4 + 3]);
            if (!FINAL) *(uint2*)(hb + (size_t)tok * 1024 + i * 256 + lane * 4) = make_uint2(pack2(v[i * 4 + 0], v[i * 4 + 1]), pack2(v[i * 4 + 2], v[i * 4 + 3]));
        }
        if (ROUTER) {
            __builtin_amdgcn_sched_barrier(0);
            float lg[16];
#pragma unroll
            for (int e = 0; e < 16; ++e) lg[e] = 0.f;
#pragma unroll
            for (int i = 0; i < 4; ++i)
#pragma unroll
                for (int j = 0; j < 4; ++j) {
                    const float hv = v[i * 4 + j];
#pragma unroll
                    for (int e4 = 0; e4 < 4; ++e4) { const f32x4 r = *(const f32x4*)(rwl + ((((i * 4 + j) * 4 + e4) * 64 + lane) << 2)); lg[e4 * 4 + 0] += hv * r[0]; lg[e4 * 4 + 1] += hv * r[1]; lg[e4 * 4 + 2] += hv * r[2]; lg[e4 * 4 + 3] += hv * r[3]; }
                    if (j & 1) asm volatile("" ::: "memory");
                }
            __builtin_amdgcn_sched_barrier(0);
            float r8[8], r4[4], r2[2], r1;
#pragma unroll
            for (int e = 0; e < 8; ++e) { const bool hi = lane & 32; const float keep = hi ? lg[e + 8] : lg[e], send = hi ? lg[e] : lg[e + 8]; r8[e] = keep + __shfl_xor(send, 32); }
#pragma unroll
            for (int e = 0; e < 4; ++e) { const bool hi = lane & 16; const float keep = hi ? r8[e + 4] : r8[e], send = hi ? r8[e] : r8[e + 4]; r4[e] = keep + __shfl_xor(send, 16); }
#pragma unroll
            for (int e = 0; e < 2; ++e) { const bool hi = lane & 8; const float keep = hi ? r4[e + 2] : r4[e], send = hi ? r4[e] : r4[e + 2]; r2[e] = keep + __shfl_xor(send, 8); }
            { const bool hi = lane & 4; const float keep = hi ? r2[1] : r2[0], send = hi ? r2[0] : r2[1]; r1 = keep + __shfl_xor(send, 4); }
            r1 += __shfl_xor(r1, 1); r1 += __shfl_xor(r1, 2);
            float aff[16], sel[16];
#pragma unroll
            for (int e = 0; e < 16; ++e) { const int src = ((e >> 3) & 1) * 32 + ((e >> 2) & 1) * 16 + ((e >> 1) & 1) * 8 + (e & 1) * 4; const float l = __shfl(r1, src); aff[e] = 1.f / (1.f + expf(-l)); sel[e] = aff[e] + p.router_b[e]; }
            float best = -3.0e38f; int bg = 0; float b0 = 0, b1 = 0, b2 = 0, b3 = 0, a0 = 0, a1 = 0, a2 = 0, a3 = 0;
#pragma unroll
            for (int g = 0; g < 4; ++g) {
                const float x0 = sel[4 * g], x1 = sel[4 * g + 1], x2 = sel[4 * g + 2], x3 = sel[4 * g + 3];
                const float mx = fmaxf(fmaxf(x0, x1), fmaxf(x2, x3));
                const float m2 = fmaxf(fmaxf(fminf(x0, x1), fminf(x2, x3)), fminf(fmaxf(x0, x1), fmaxf(x2, x3)));
                const float gs = mx + m2;
                if (gs > best) { best = gs; bg = g; b0 = x0; b1 = x1; b2 = x2; b3 = x3; a0 = aff[4 * g]; a1 = aff[4 * g + 1]; a2 = aff[4 * g + 2]; a3 = aff[4 * g + 3]; }
            }
            int i1 = 0; float m = b0, wa = a0;
            if (b1 > m) { m = b1; i1 = 1; wa = a1; } if (b2 > m) { m = b2; i1 = 2; wa = a2; } if (b3 > m) { m = b3; i1 = 3; wa = a3; }
            int i2 = -1; float m2 = -3.0e38f, wb = 0.f;
            if (i1 != 0 && b0 > m2) { m2 = b0; i2 = 0; wb = a0; } if (i1 != 1 && b1 > m2) { m2 = b1; i2 = 1; wb = a1; }
            if (i1 != 2 && b2 > m2) { m2 = b2; i2 = 2; wb = a2; } if (i1 != 3 && b3 > m2) { m2 = b3; i2 = 3; wb = a3; }
            const float nrm = wa + wb;
            if (lane == 0) {
                const int e1 = bg * 4 + i1, e2 = bg * 4 + i2;
                misc[MI_TE + tok * 2] = e1; misc[MI_TE + tok * 2 + 1] = e2;
                misc[MI_TW + tok * 2] = __float_as_int(wa / nrm); misc[MI_TW + tok * 2 + 1] = __float_as_int(wb / nrm);
                const int li1 = atomicAdd(&lcnt[e1], 1), li2 = atomicAdd(&lcnt[e2], 1);
                int* ent = llist + ((tix >> 6) * 16 + nloc) * 5; ent[0] = tok; ent[1] = e1; ent[2] = e2; ent[3] = li1; ent[4] = li2;
            }
            ++nloc;
        }
    };
    {
        const int t00 = gwave(), step = gwaves(), ntk_all = (T_ - t00 + step - 1) / step;
        for (int c0 = 0; c0 < ntk_all; c0 += 64) {
            const int t0 = t00 + c0 * step, ntk = ntk_all - c0 < 64 ? ntk_all - c0 : 64;
            if (COMBINE) { const int tl = t0 + (lane < ntk ? lane : 0) * step;
                pw0 = __int_as_float(misc[MI_TW + tl * 2]); pw1 = __int_as_float(misc[MI_TW + tl * 2 + 1]); pr0 = eoffs[misc[MI_TE + tl * 2]] + misc[MI_TI + tl * 2]; pr1 = eoffs[misc[MI_TE + tl * 2 + 1]] + misc[MI_TI + tl * 2 + 1]; }
            LnIn inA, inB;
            ln_load(t0, 0, inA);
            for (int it = 0; it < ntk; it += 2) {
                const int tk = t0 + it * step, tk1 = tk + step, tk2 = tk + 2 * step;
                ln_load(it + 1 < ntk ? tk1 : tk, it + 1 < ntk ? it + 1 : it, inB);
                ln_token(tk, inA);
                if (it + 1 >= ntk) break;
                ln_load(it + 2 < ntk ? tk2 : tk1, it + 2 < ntk ? it + 2 : it + 1, inA);
                ln_token(tk1, inB);
            }
        }
    }
    if (ROUTER) {
        __syncthreads();
        int* cnt = (int*)(p.ws + CNT_OFF) + layer * 1024;
        if (tix < 16) lbase[tix] = lcnt[tix] ? atomicAdd(&cnt[tix * 64], lcnt[tix]) : 0;
        __syncthreads();
        int* inv = (int*)(p.ws + MOE_INV);
        const int wv = tix >> 6, k = tix & 63;
        if (k < nloc) { const int* ent = llist + (wv * 16 + k) * 5; const int tok = ent[0], e1 = ent[1], e2 = ent[2], i1x = lbase[e1] + ent[3], i2x = lbase[e2] + ent[4];
            misc[MI_TI + tok * 2] = i1x; misc[MI_TI + tok * 2 + 1] = i2x; inv[e1 * 16384 + i1x] = tok; inv[e2 * 16384 + i2x] = tok; }
    }
}

template <int WHICH> __device__ __forceinline__ void ph_moe_gemm(const Params& p, int layer, unsigned char* smem) {
    const int* cnt = (const int*)(p.ws + CNT_OFF) + layer * 1024;
    __shared__ int eoff[17]; const int tix = ptid();
    if (tix == 0) { int o = 0; for (int e = 0; e < 16; ++e) { eoff[e] = o; o += (cnt[e * 64] + 255) & ~255; } eoff[16] = o; }
    __syncthreads();
    const int Mt = eoff[16] >> 8;
    for (int t = blockIdx.x; t < Mt * 8; t += gridDim.x) {
        const int mt = t >> 3, nt = t & 7, row0 = mt << 8;
        int e = 0;
        while (e < 15 && row0 >= eoff[e + 1]) ++e;
        if (WHICH == 0) {
            const int* inv = (const int*)(p.ws + MOE_INV) + e * 16384; const int ne = cnt[e * 64], i0 = row0 - eoff[e] + (tix >> 3);
            const bf16_t* ap[4];
#pragma unroll
            for (int i = 0; i < 4; ++i) { const int ix = i0 + 64 * i; ap[i] = (const bf16_t*)(p.ws + H_BF) + (size_t)inv[ix < ne ? ix : 0] * 1024 + (tix & 7) * 8; }
            const bf16_t* Bt = (const bf16_t*)(p.ws + MOEW_GU) + ((size_t)e * 1024 + nt * 128) * 1024;
            gemm_tile_rows(ap, Bt, 1024, 1024, EpiSwiglu{{}, (bf16_t*)p.out + (size_t)row0 * 512 + nt * 64, 512}, smem);
        } else {
            const bf16_t* A = (const bf16_t*)p.out + (size_t)row0 * 512;
            const bf16_t* Bt = (const bf16_t*)(p.ws + MOEW_D) + ((size_t)e * 1024 + nt * 128) * 512;
            gemm_tile(A, 512, Bt, 512, 512, EpiBf16{{}, (bf16_t*)(p.ws + YEXP) + (size_t)row0 * 1024 + nt * 128, 1024}, smem);
        }
    }
}

struct EpiKvq : EpiBase { const Params* p; int m0, n0; int wm_, fr_, hbase; bool isk; float nrm, mx;
    __device__ __forceinline__ void start(int wm, int wn, int fr, int) { wm_ = wm; fr_ = fr; hbase = n0 + wn * 64; const int sec = n0 >> 8; isk = sec == 0 || sec == 2 || sec == 4; nrm = 0.f; mx = 0.f; }
    __device__ __forceinline__ void operator()(int m, int n, f32x4 v) {
        const size_t tok = (size_t)(m0 + m); const int c = n0 + n, sec = n0 >> 8;
        bf16_t* row = (bf16_t*)(p->ws + KVQ) + tok * KVQ_LD;
        if (sec == 1 || sec == 3 || sec == 5) { *(u32x2*)(row + c) = (u32x2){pack2(v[0], v[1]), pack2(v[2], v[3])}; }
        else if (sec < 10) {
            const int d = (c & 63) >> 1, t = (int)tok & (S_ - 1);
            const f32x4 cs = *(const f32x4*)((const float*)(p->ws + ROPE_NT) + ((size_t)t * 32 + d) * 2);
            const float sc = sec >= 6 ? 0.125f : 1.f;
            const float a0 = (v[0] * cs[0] - v[1] * cs[1]) * sc, b0 = (v[1] * cs[0] + v[0] * cs[1]) * sc, a1 = (v[2] * cs[2] - v[3] * cs[3]) * sc, b1 = (v[3] * cs[2] + v[2] * cs[3]) * sc;
            bf16_t* dst = row + (c & ~63) + d;
            *(unsigned*)dst = pack2(a0, a1); *(unsigned*)(dst + 32) = pack2(b0, b1);
            nrm += a0 * a0 + b0 * b0 + a1 * a1 + b1 * b1;
        } else if (c < 2608) {
            float* gt = (float*)(p->ws + GATES) + tok * 48 + (c - 2560);
            *(f32x4*)gt = (f32x4){1.f / (1.f + __expf(-v[0])), 1.f / (1.f + __expf(-v[1])), 1.f / (1.f + __expf(-v[2])), 1.f / (1.f + __expf(-v[3]))};
        }
    }
    __device__ __forceinline__ void row_done(int) { float r = nrm; r += __shfl_xor(r, 16); r += __shfl_xor(r, 32); mx = fmaxf(mx, r); nrm = 0.f; }
    __device__ __forceinline__ void finish() {
        if (isk) { const float m = wave_max(mx); if ((ptid() & 63) == 0) atomicMax((int*)(p->ws + MISC) + MI_KMAX + ((n0 >> 9) * 2 + (m0 >> 13)) * 4 + ((hbase & 255) >> 6), __float_as_int(sqrtf(m) * 1.01f + 1e-6f)); }
    }
};
__device__ __forceinline__ void ph_gemm_kvq(const Params& p, unsigned char* smem) {
    const bf16_t* A = (const bf16_t*)(p.ws + H_BF); const bf16_t* Bt = (const bf16_t*)(p.ws + WT_KVQ);
    for (int t = blockIdx.x; t < 64 * (KVQ_LD / 128); t += gridDim.x) {
        const int mt = t / (KVQ_LD / 128), nt = t % (KVQ_LD / 128);
        EpiKvq e{}; e.p = &p; e.m0 = mt * 256; e.n0 = nt * 128;
        gemm_tile(A + (size_t)mt * 256 * 1024, 1024, Bt + (size_t)nt * 128 * 1024, 1024, 1024, e, smem);
    }
}

#define PG8_LDS(ptr) ((PG8_LAS unsigned char*)(ptr))
__device__ __forceinline__ void ph_gemm_retin8(const Params& p, unsigned char* smem) {
    const pg8::Gemm g{(const bf16_t*)(p.ws + XB), (const bf16_t*)(p.ws + WT_IN), T_, 6144, 1024}; pg8::StaticOrder S; S.init(T_, 6144, (int)gridDim.x, (int)blockIdx.x);
    const pg8::EpiRetInP E{&p};
    pg8::gemm_phase<pg8::EpiRetInP, pg8::StaticOrder, true, true>(PG8_LDS(smem), g, S, E);
}
__device__ __forceinline__ void ph_gemm_bf16_8(const bf16_t* A, const bf16_t* Bt, bf16_t* C, int N, int K, unsigned char* smem) {
    const pg8::Gemm g{A, Bt, T_, N, K}; pg8::StaticOrder S; S.init(T_, N, (int)gridDim.x, (int)blockIdx.x);
    const pg8::EpiBf16P E{C, N, 0xffff};
    pg8::gemm_phase<pg8::EpiBf16P, pg8::StaticOrder, true, true>(PG8_LDS(smem), g, S, E);
}
__device__ __forceinline__ void ph_gemm_f32_8(const bf16_t* A, const bf16_t* Bt, float* C, int N, int K, unsigned char* smem) {
    const pg8::Gemm g{A, Bt, T_, N, K}; pg8::StaticOrder S; S.init(T_, N, (int)gridDim.x, (int)blockIdx.x);
    const pg8::EpiF32P E{C, N};
    pg8::gemm_phase<pg8::EpiF32P, pg8::StaticOrder, true, true>(PG8_LDS(smem), g, S, E);
}
__device__ __forceinline__ void ph_gemm_kvq8(const Params& p, unsigned char* smem) {
    const pg8::Gemm g{(const bf16_t*)(p.ws + H_BF), (const bf16_t*)(p.ws + WT_KVQ), T_, KVQ_N, 1024}; pg8::StaticOrder S; S.init(T_, KVQ_N, (int)gridDim.x, (int)blockIdx.x);
    const pg8::EpiKvqP E{&p};
    pg8::gemm_phase<pg8::EpiKvqP, pg8::StaticOrder, true, true>(PG8_LDS(smem), g, S, E);
}
__device__ __forceinline__ void ph_moe_up8(const Params& p, int layer, unsigned char* smem) {
    const int* cnt = (const int*)(p.ws + CNT_OFF) + layer * 1024;
    int* eoff = (int*)(smem + 131072 + 1024);
    if (ptid() == 0) { int o = 0; for (int e = 0; e < 16; ++e) { eoff[e] = o; o += (cnt[e * 64] + 255) & ~255; } eoff[16] = o; }
    __syncthreads();
    const pg8::Gemm g{(const bf16_t*)(p.ws + H_BF), (const bf16_t*)(p.ws + (layer ? MOEW1_GU : MOEW_GU)), eoff[16], 16 * 1024, 1024};
    const pg8::GroupedGatherOrder S{eoff, cnt, (const int*)(p.ws + MOE_INV), (eoff[16] >> 8) * 4, (int)gridDim.x, (int)blockIdx.x};
    const pg8::EpiSwigluP E{(bf16_t*)p.out};
    pg8::gemm_phase<pg8::EpiSwigluP, pg8::GroupedGatherOrder, true, true, true>(PG8_LDS(smem), g, S, E);
}
__device__ __forceinline__ void ph_moe_down8(const Params& p, int layer, unsigned char* smem) {
    int* eoff = (int*)(smem + 131072 + 1024);
    const pg8::Gemm g{(const bf16_t*)p.out, (const bf16_t*)(p.ws + (layer ? MOEW1_D : MOEW_D)), eoff[16], 16 * 1024, 512};
    const pg8::GroupedOrder S{eoff, (eoff[16] >> 8) * 4, (int)gridDim.x, (int)blockIdx.x};
    const pg8::EpiBf16P E{(bf16_t*)(p.ws + YEXP), 1024, 3};
    pg8::gemm_phase<pg8::EpiBf16P, pg8::GroupedOrder, true, true>(PG8_LDS(smem), g, S, E);
}
__device__ __forceinline__ void moe_tail_convert(const Params& p, int layer, unsigned char* smem, int tb, int te) {
    const int MT = ((const int*)(smem + 131072 + 1024))[16] >> 8;
    const int G = (int)gridDim.x, c = (int)blockIdx.x;
    if (G != 256) { moe_weights_range(p, 1, smem, tb, te, c, G); return; }
    const int x = c & 7, pw = c >> 3;
    int before = 0, total = 0, mine = -1;
    for (int xx = 0; xx < 8; ++xx) { const int Ux = 4 * ((MT - xx + 7) >> 3), hv = Ux > 64 ? (Ux - 64 < 32 ? Ux - 64 : 32) : 0;
        if (xx == x) mine = pw >= hv ? total + (pw - hv) : -1; total += 32 - hv; (void)before; }
    if (total == 0) { moe_weights_range(p, 1, smem, tb, te, c, G); return; }
    if (mine >= 0) moe_weights_range(p, 1, smem, tb, te, mine, total);
}
__device__ __forceinline__ void ph_vt(const Params& p) {
    const bf16_t* kvq = (const bf16_t*)(p.ws + KVQ);
    const int tix = ptid(), lane = tix & 63;
    const bool split = gridDim.x > 192; if (split && blockIdx.x < 128) return;
    const int nbl = split ? (int)gridDim.x - 128 : (int)gridDim.x, bl = split ? (int)blockIdx.x - 128 : (int)blockIdx.x;
    for (int it = (tix >> 6) * nbl + bl; it < 2048; it += nbl * (NT / 64)) {
        const int part = it >> 10, bg = (it >> 7) & 7, blk = it & 127, b = bg >> 2, g = bg & 3;
        const int key = (lane & ~31) + 16 * ((lane >> 2) & 1) + 4 * ((lane >> 3) & 3) + (lane & 3);
        const bf16_t* src = kvq + ((size_t)b * S_ + blk * 64 + key) * KVQ_LD + (part ? 1280 : 768) + g * 64;
        bf16_t* dst = (bf16_t*)(p.ws + (part ? VWT : VST)) + (size_t)(bg * 128 + blk) * 4096 + lane;
        u32x4 v[8];
#pragma unroll
        for (int c = 0; c < 8; ++c) v[c] = *(const u32x4*)(src + c * 8);
#pragma unroll
        for (int c = 0; c < 8; ++c)
#pragma unroll
            for (int e = 0; e < 4; ++e) { dst[(c * 8 + e * 2) * 64] = (bf16_t)(v[c][e] & 0xffffu); dst[(c * 8 + e * 2 + 1) * 64] = (bf16_t)(v[c][e] >> 16); }
    }
}
struct EpiCmp2 : EpiBase { const Params* p; int kv, bg, mt; unsigned char* lds; int wn_; float nrm, mx;
    __device__ __forceinline__ void start(int, int wn, int, int) { wn_ = wn; nrm = 0.f; mx = 0.f; }
    __device__ __forceinline__ void operator()(int m, int n, f32x4 v) {
        if (wn_ != 0) return;
        const int row = mt * 256 + m;
        if (row == 511) v = (f32x4){0.f, 0.f, 0.f, 0.f};
        if (kv == 0) { *(u32x2*)((bf16_t*)(p->ws + KCMPB) + (size_t)(bg * 512 + row) * 64 + n) = (u32x2){pack2(v[0], v[1]), pack2(v[2], v[3])}; nrm += v[0] * v[0] + v[1] * v[1] + v[2] * v[2] + v[3] * v[3]; }
        else { const int rp = (row & ~31) + 8 * ((row & 15) >> 2) + 4 * ((row & 31) >> 4) + (row & 3);
            bf16_t* vt = (bf16_t*)lds + n * 264 + (rp & 255);
            vt[0] = f2bf(v[0]); vt[264] = f2bf(v[1]); vt[528] = f2bf(v[2]); vt[792] = f2bf(v[3]); }
    }
    __device__ __forceinline__ void row_done(int) { float r = nrm; r += __shfl_xor(r, 16); r += __shfl_xor(r, 32); mx = fmaxf(mx, r); nrm = 0.f; }
    __device__ __forceinline__ void finish() {
        if (kv != 0) {
            __syncthreads();
            const int tix = ptid();
#pragma unroll
            for (int c = tix; c < 2048; c += NT) { const int n = c >> 5, off = (c & 31) * 8;
                *(u32x4*)((bf16_t*)(p->ws + VCMPT) + (size_t)(bg * 64 + n) * 512 + mt * 256 + off) = *(const u32x4*)((const bf16_t*)lds + n * 264 + off); }
        }
        if (kv == 0 && wn_ == 0) { const float m = wave_max(mx); if ((ptid() & 63) == 0) atomicMax((int*)(p->ws + MISC) + MI_KMAXC + bg, __float_as_int(sqrtf(m) * 1.01f + 1e-6f)); } }
};
__device__ __forceinline__ void ph_cmp2(const Params& p, unsigned char* smem) {
    for (int t = blockIdx.x; t < 32; t += gridDim.x) {
        const int mt = t & 1, bg = (t >> 1) & 7, kv = t >> 4;
        EpiCmp2 e{}; e.p = &p; e.kv = kv; e.bg = bg; e.mt = mt; e.lds = smem;
        gemm_tile((const bf16_t*)(p.ws + HC) + (size_t)((kv * 8 + bg) * 512 + mt * 256) * 256, 256, (const bf16_t*)(p.ws + WT_CW2) + (size_t)kv * 128 * 256, 256, 256, e, smem);
    }
}
__device__ __forceinline__ float quad_xor1(float v) { return __int_as_float(__builtin_amdgcn_mov_dpp(__float_as_int(v), 0xB1, 0xF, 0xF, true)); }
__device__ __forceinline__ float quad_xor2(float v) { return __int_as_float(__builtin_amdgcn_mov_dpp(__float_as_int(v), 0x4E, 0xF, 0xF, true)); }
__device__ __forceinline__ void lds_barrier() { asm volatile("s_waitcnt lgkmcnt(0)" ::: "memory"); __builtin_amdgcn_s_barrier(); asm volatile("" ::: "memory"); }
constexpr int KT_LD = 80;
constexpr int A2_BUF = 0, A2_BUFSZ = 2 * 64 * KT_LD * 2, A2_IMP = 4 * A2_BUFSZ, A2_TM = A2_IMP + 32768, A2_OR = A2_TM + 1024, A2_GT = A2_OR + 16, A2_END = A2_GT + 6 * NT * 4;
static_assert(A2_END <= LDS_BYTES - 16, "attention LDS");
constexpr float LOG2E = 1.4426950408889634f;
struct BlkSrc { const bf16_t* K; int ldk; const bf16_t* VT; int ldv; };
__device__ __forceinline__ int next_bit128(const unsigned (&m)[4], int j) {
    for (int k = j + 1; k < 128; ++k) if ((m[k >> 5] >> (k & 31)) & 1u) return k;
    return 128;
}
template <int BR> __device__ __forceinline__ void attn_branch(const Params& p, unsigned char* smem, const unsigned (&orm)[4], int bg, int cur, const float (&mrow)[2],
                                                               const float (&invl)[2], f32x4 (&Lacc)[2], f32x4 (&Oacc)[2][4], const bf16x8 (&Qs)[2][2]) {
    const int tid = ptid(), lane = tid & 63, w = __builtin_amdgcn_readfirstlane(tid >> 6), g = lane >> 4, i16 = lane & 15;
    const int b = bg >> 2, g4 = bg & 3;
    const bf16_t* kvq = (const bf16_t*)(p.ws + KVQ);
    float* imp = (float*)(smem + A2_IMP);
    const unsigned onew = i16 == 0 ? 0x3f803f80u : 0u; const bf16x8 onesf = __builtin_bit_cast(bf16x8, (u32x4){onew, onew, onew, onew});
    const int srow = tid >> 3, sch = tid & 7;
    auto src = [&](int j) -> BlkSrc {
        if (BR <= 1) return BlkSrc{(const bf16_t*)(p.ws + KCMPB) + (size_t)(bg * 512 + j * 64) * 64, 64, (const bf16_t*)(p.ws + VCMPT) + (size_t)bg * 64 * 512 + j * 64, 512};
        if (BR == 2) return BlkSrc{kvq + ((size_t)b * S_ + j * 64) * KVQ_LD + 512 + g4 * 64, KVQ_LD, (const bf16_t*)(p.ws + VST) + (size_t)(bg * 128 + j) * 4096, 64};
        return BlkSrc{kvq + ((size_t)b * S_ + j * 64) * KVQ_LD + 1024 + g4 * 64, KVQ_LD, (const bf16_t*)(p.ws + VWT) + (size_t)(bg * 128 + j) * 4096, 64};
    };
    u32x4 rk[2], rv[2];
    auto ld = [&](u32x4& rk, u32x4& rv, int j) { const BlkSrc s = src(j); rk = *(const u32x4*)(s.K + (size_t)srow * s.ldk + sch * 8); if (BR != 1) rv = *(const u32x4*)(s.VT + (size_t)srow * s.ldv + sch * 8); };
    auto st = [&](const u32x4& rk, const u32x4& rv, int bi) {
        bf16_t* buf = (bf16_t*)(smem + A2_BUF + bi * A2_BUFSZ);
        *(u32x4*)(buf + srow * KT_LD + sch * 8) = rk;
        if (BR != 1) *(u32x4*)(buf + 64 * KT_LD + srow * KT_LD + sch * 8) = rv;
    };
    auto process = [&](int j, int bi) {
        const bf16_t* Kt = (const bf16_t*)(smem + A2_BUF + bi * A2_BUFSZ); const bf16_t* Vt = Kt + 64 * KT_LD;
        bool need[2]; unsigned selb[2];
#pragma unroll
        for (int bt = 0; bt < 2; ++bt) { selb[bt] = BR == 2 ? ((((const unsigned*)(smem + A2_TM))[(8 * w + 4 * bt + (i16 >> 2)) * 4 + (j >> 5)] >> (j & 31)) & 1u) : 1u; need[bt] = BR == 2 ? (__ballot(selb[bt] != 0u) != 0ull) : true; }
        if (need[0] || need[1]) {
            bf16x8 Kf[4][2];
#pragma unroll
            for (int mt = 0; mt < 4; ++mt) { Kf[mt][0] = *(const bf16x8*)(Kt + (16 * mt + i16) * KT_LD + 8 * g); Kf[mt][1] = *(const bf16x8*)(Kt + (16 * mt + i16) * KT_LD + 32 + 8 * g); }
#pragma unroll
            for (int bt = 0; bt < 2; ++bt) {
                if (!need[bt]) continue;
                const int tq = 8 * w + 4 * bt + (i16 >> 2);
                const bf16x8 Qf0 = Qs[bt][0], Qf1 = Qs[bt][1];
                const float msel = selb[bt] != 0u ? mrow[bt] : __builtin_inff();
                f32x4 St[4];
                const bool edge = BR <= 1 ? (64 * j + 63 > ((64 * cur + 8 * w - 31) >> 4)) : (j == cur || (BR == 3 && j == cur - 8));
                if (!edge) {
                    const f32x4 sinit = {-msel, -msel, -msel, -msel};
#pragma unroll
                    for (int mt = 0; mt < 4; ++mt) St[mt] = __builtin_amdgcn_mfma_f32_16x16x32_bf16(Kf[mt][0], Qf0, sinit, 0, 0, 0);
#pragma unroll
                    for (int mt = 0; mt < 4; ++mt) St[mt] = __builtin_amdgcn_mfma_f32_16x16x32_bf16(Kf[mt][1], Qf1, St[mt], 0, 0, 0);
                } else {
                    int lo = 0, hi = 63;
                    if (BR <= 1) hi = ((64 * cur + tq - 31) >> 4) - 64 * j;
                    if (BR >= 2 && j == cur) hi = tq;
                    if (BR == 3 && j == cur - 8) lo = tq + 1;
                    const int k0 = 4 * g - lo, k1 = hi - 4 * g;
#pragma unroll
                    for (int mt = 0; mt < 4; ++mt)
#pragma unroll
                        for (int r = 0; r < 4; ++r) St[mt][r] = (16 * mt + r + k0 >= 0 && 16 * mt + r <= k1) ? -msel : -__builtin_inff();
#pragma unroll
                    for (int mt = 0; mt < 4; ++mt) St[mt] = __builtin_amdgcn_mfma_f32_16x16x32_bf16(Kf[mt][0], Qf0, St[mt], 0, 0, 0);
#pragma unroll
                    for (int mt = 0; mt < 4; ++mt) St[mt] = __builtin_amdgcn_mfma_f32_16x16x32_bf16(Kf[mt][1], Qf1, St[mt], 0, 0, 0);
                }
#pragma unroll
                for (int mt = 0; mt < 4; ++mt)
#pragma unroll
                    for (int r = 0; r < 4; ++r) St[mt][r] = __builtin_amdgcn_exp2f(St[mt][r]);
                if (BR == 1) {
#pragma unroll
                    for (int mt = 0; mt < 4; ++mt) {
                        float s4 = (St[mt][0] + St[mt][1] + St[mt][2] + St[mt][3]) * invl[bt], p3 = St[mt][3] * invl[bt];
                        s4 += quad_xor1(s4); s4 += quad_xor2(s4); p3 += quad_xor1(p3); p3 += quad_xor2(p3);
                        const int sb = 16 * j + 4 * mt + g;
                        if ((i16 & 3) == 0) { atomicAdd(&imp[tq * 128 + sb], s4); if (sb + 1 < 128) atomicAdd(&imp[tq * 128 + sb + 1], p3); }
                    }
                } else {
                    bf16x8 Vf[4][2];
#pragma unroll
                    for (int dt = 0; dt < 4; ++dt) { Vf[dt][0] = *(const bf16x8*)(Vt + (16 * dt + i16) * KT_LD + 8 * g); Vf[dt][1] = *(const bf16x8*)(Vt + (16 * dt + i16) * KT_LD + 32 + 8 * g); }
                    const bf16x8 Pf0 = pack_frag(St[0], St[1]), Pf1 = pack_frag(St[2], St[3]);
#pragma unroll
                    for (int dt = 0; dt < 4; ++dt) Oacc[bt][dt] = __builtin_amdgcn_mfma_f32_16x16x32_bf16(Vf[dt][0], Pf0, Oacc[bt][dt], 0, 0, 0);
#pragma unroll
                    for (int dt = 0; dt < 4; ++dt) Oacc[bt][dt] = __builtin_amdgcn_mfma_f32_16x16x32_bf16(Vf[dt][1], Pf1, Oacc[bt][dt], 0, 0, 0);
                    Lacc[bt] = __builtin_amdgcn_mfma_f32_16x16x32_bf16(onesf, Pf0, Lacc[bt], 0, 0, 0);
                    Lacc[bt] = __builtin_amdgcn_mfma_f32_16x16x32_bf16(onesf, Pf1, Lacc[bt], 0, 0, 0);
                }
            }
        }
    };
    int a0 = next_bit128(orm, -1);
    if (a0 >= 128) return;
    const int jsafe = a0;
    int b0 = next_bit128(orm, a0), a1 = b0 < 128 ? next_bit128(orm, b0) : 128, b1 = a1 < 128 ? next_bit128(orm, a1) : 128;
    ld(rk[0], rv[0], a0); ld(rk[1], rv[1], b0 < 128 ? b0 : jsafe);
    lds_barrier();
    st(rk[0], rv[0], 0); st(rk[1], rv[1], 1);
    ld(rk[0], rv[0], a1 < 128 ? a1 : jsafe); ld(rk[1], rv[1], b1 < 128 ? b1 : jsafe);
    lds_barrier();
    int sg = 0;
    for (;;) {
        const int a2 = b1 < 128 ? next_bit128(orm, b1) : 128, b2 = a2 < 128 ? next_bit128(orm, a2) : 128;
        process(a0, 2 * sg);
        st(rk[0], rv[0], 2 * (sg ^ 1)); st(rk[1], rv[1], 2 * (sg ^ 1) + 1);
        ld(rk[0], rv[0], a2 < 128 ? a2 : jsafe); ld(rk[1], rv[1], b2 < 128 ? b2 : jsafe);
        if (b0 < 128) process(b0, 2 * sg + 1);
        lds_barrier();
        if (a1 >= 128) break;
        a0 = a1; b0 = b1; a1 = a2; b1 = b2; sg ^= 1;
    }
}
__device__ __forceinline__ void ph_attn(const Params& p, unsigned char* smem) {
    const bf16_t* kvq = (const bf16_t*)(p.ws + KVQ); const float* gates = (const float*)(p.ws + GATES); const int* misc = (const int*)(p.ws + MISC);
    bf16_t* ao = (bf16_t*)(p.ws + ATTN_OUT);
    float* imp = (float*)(smem + A2_IMP); unsigned* tmask = (unsigned*)(smem + A2_TM); unsigned* tor = (unsigned*)(smem + A2_OR);
    const int tid = ptid(), lane = tid & 63, w = __builtin_amdgcn_readfirstlane(tid >> 6), g = lane >> 4, i16 = lane & 15;
    if (w >= 4) __builtin_amdgcn_s_setprio(1);
    for (int u = blockIdx.x; u < 1024; u += gridDim.x) {
        const int bg = u & 7, c5 = (u >> 3) & 31, kq = u >> 8;
        const int cur = kq == 0 ? c5 : (kq == 1 ? 63 - c5 : (kq == 2 ? 64 + c5 : 127 - c5));
        const int b = bg >> 2, g4 = bg & 3; const size_t tok0 = (size_t)b * S_ + cur * 64;
        bf16x8 Qf[2][2]; float qn[2];
        const int head = g4 * 4 + (i16 & 3);
        float gt6[6];
#pragma unroll
        for (int bt = 0; bt < 2; ++bt)
#pragma unroll
            for (int c = 0; c < 3; ++c) gt6[bt * 3 + c] = gates[(tok0 + 8 * w + 4 * bt + (i16 >> 2)) * 48 + head * 3 + c];
#pragma unroll
        for (int bt = 0; bt < 2; ++bt) {
            const size_t tok = tok0 + 8 * w + 4 * bt + (i16 >> 2);
            const bf16_t* qp = kvq + tok * KVQ_LD + 1536 + head * 64 + 8 * g;
            Qf[bt][0] = *(const bf16x8*)qp; Qf[bt][1] = *(const bf16x8*)(qp + 32);
            float f[16]; unpack8(__builtin_bit_cast(u32x4, Qf[bt][0]), f); unpack8(__builtin_bit_cast(u32x4, Qf[bt][1]), f + 8);
            float s = 0.f;
#pragma unroll
            for (int k = 0; k < 16; ++k) s += f[k] * f[k];
            s += __shfl_xor(s, 16); s += __shfl_xor(s, 32);
            qn[bt] = sqrtf(s) * 1.01f + 1e-6f;
        }
        __syncthreads();
#pragma unroll
        for (int k = 0; k < 6; ++k) ((float*)(smem + A2_GT))[k * NT + tid] = gt6[k];
#pragma unroll
        for (int bt = 0; bt < 2; ++bt) {
            float f[16]; unpack8(__builtin_bit_cast(u32x4, Qf[bt][0]), f); unpack8(__builtin_bit_cast(u32x4, Qf[bt][1]), f + 8);
            u32x4 q0, q1;
#pragma unroll
            for (int k = 0; k < 4; ++k) { q0[k] = pack2(f[2 * k] * LOG2E, f[2 * k + 1] * LOG2E); q1[k] = pack2(f[8 + 2 * k] * LOG2E, f[9 + 2 * k] * LOG2E); }
            Qf[bt][0] = __builtin_bit_cast(bf16x8, q0); Qf[bt][1] = __builtin_bit_cast(bf16x8, q1); }
        for (int k = lane; k < 8 * 128; k += 64) imp[w * 8 * 128 + k] = 0.f;
        if (tid < 4) tor[tid] = 0u;
        f32x4 Oacc[2][4], Lacc[2] = {(f32x4){0.f, 0.f, 0.f, 0.f}, (f32x4){0.f, 0.f, 0.f, 0.f}}; float mrow[2], invl[2] = {0.f, 0.f};
#pragma unroll
        for (int bt = 0; bt < 2; ++bt) {
#pragma unroll
            for (int dt = 0; dt < 4; ++dt) Oacc[bt][dt] = (f32x4){0.f, 0.f, 0.f, 0.f};
        }
        auto norml = [&]() {
#pragma unroll
            for (int bt = 0; bt < 2; ++bt) { const float l = __shfl(Lacc[bt][0], i16); invl[bt] = l > 0.f ? 1.f / l : 0.f; Lacc[bt] = (f32x4){0.f, 0.f, 0.f, 0.f}; }
        };
        auto finish = [&](int c) {
#pragma unroll
            for (int bt = 0; bt < 2; ++bt) {
                const size_t tokc = tok0 + 8 * w + 4 * bt + (i16 >> 2);
                const float sc = ((const float*)(smem + A2_GT))[(bt * 3 + c) * NT + tid] * invl[bt];
                u32x2* slot = (u32x2*)(smem + A2_IMP) + ((w * 2 + bt) * 4) * 64 + lane;
#pragma unroll
                for (int dt = 0; dt < 4; ++dt) { f32x4 o = Oacc[bt][dt] * sc;
                    if (c > 0) { const u32x2 q = slot[dt * 64]; o[0] += __uint_as_float(q[0] << 16); o[1] += __uint_as_float(q[0] & 0xffff0000u); o[2] += __uint_as_float(q[1] << 16); o[3] += __uint_as_float(q[1] & 0xffff0000u); }
                    const u32x2 r = {pack2(o[0], o[1]), pack2(o[2], o[3])};
                    if (c < 2) slot[dt * 64] = r; else *(u32x2*)(ao + tokc * 1024 + head * 64 + 4 * g + 16 * dt) = r;
                    Oacc[bt][dt] = (f32x4){0.f, 0.f, 0.f, 0.f}; }
            }
        };
        {
            const int nblk = min(8, (4 * cur + 2) / 64 + 1);
            unsigned orm[4] = {(1u << nblk) - 1u, 0u, 0u, 0u};
            const float kmx = __int_as_float(misc[MI_KMAXC + bg]);
            mrow[0] = qn[0] * kmx * LOG2E; mrow[1] = qn[1] * kmx * LOG2E;
            attn_branch<0>(p, smem, orm, bg, cur, mrow, invl, Lacc, Oacc, Qf);
            norml();
            attn_branch<1>(p, smem, orm, bg, cur, mrow, invl, Lacc, Oacc, Qf);
        }
        for (int k = 0; k < 8; k += 2) {
            unsigned ka[2][2]; unsigned T[2] = {0u, 0u};
#pragma unroll
            for (int u = 0; u < 2; ++u) {
                const int tl = w * 8 + k + u;
                { const int s = lane; const bool valid = s <= cur, forced = (s == 0) || (s == cur) || (s == cur - 1); ka[u][0] = valid ? __float_as_uint(imp[tl * 128 + s] + (forced ? 1000.f : 0.f)) + 1u : 0u; }
                { const int s = lane + 64; const bool valid = s <= cur, forced = (s == 0) || (s == cur) || (s == cur - 1); ka[u][1] = valid ? __float_as_uint(imp[tl * 128 + s] + (forced ? 1000.f : 0.f)) + 1u : 0u; }
            }
            bool ex[2] = {false, false};
#pragma unroll 1
            for (int bit = 30; bit >= 0; --bit) {
#pragma unroll
                for (int u = 0; u < 2; ++u) {
                    const unsigned cand = T[u] | (1u << bit);
                    const int cnt = __builtin_popcountll(__ballot(ka[u][0] >= cand)) + __builtin_popcountll(__ballot(ka[u][1] >= cand));
                    T[u] = cnt >= 16 ? cand : T[u]; ex[u] = ex[u] || cnt == 16;
                }
                if (ex[0] && ex[1]) break;
            }
#pragma unroll
            for (int u = 0; u < 2; ++u) {
                const int tl = w * 8 + k + u;
                unsigned long long s0 = __ballot(ka[u][0] > T[u]), s1 = __ballot(ka[u][1] > T[u]), e0 = __ballot(ka[u][0] == T[u]), e1 = __ballot(ka[u][1] == T[u]);
                int need = 16 - __builtin_popcountll(s0) - __builtin_popcountll(s1);
                while (need > 0 && e0) { const unsigned long long low = e0 & (~e0 + 1ull); s0 |= low; e0 ^= low; --need; }
                while (need > 0 && e1) { const unsigned long long low = e1 & (~e1 + 1ull); s1 |= low; e1 ^= low; --need; }
                const unsigned long long v0 = cur >= 63 ? ~0ull : ((1ull << (cur + 1)) - 1ull), v1 = cur >= 127 ? ~0ull : (cur >= 64 ? ((1ull << (cur - 63)) - 1ull) : 0ull);
                s0 &= v0; s1 &= v1;
                const unsigned m0 = (unsigned)s0, m1 = (unsigned)(s0 >> 32), m2 = (unsigned)s1, m3 = (unsigned)(s1 >> 32);
                if (lane == 0) { tmask[tl * 4] = m0; tmask[tl * 4 + 1] = m1; tmask[tl * 4 + 2] = m2; tmask[tl * 4 + 3] = m3; atomicOr(&tor[0], m0); atomicOr(&tor[1], m1); atomicOr(&tor[2], m2); atomicOr(&tor[3], m3); }
            }
        }
        __syncthreads();
        finish(0);
        {
            unsigned orm[4];
#pragma unroll
            for (int k = 0; k < 4; ++k) orm[k] = __builtin_amdgcn_readfirstlane(tor[k]);
            const float kmx = sqrtf(__int_as_float(misc[MI_KMAX + ((1 * 2 + b) * 4 + g4) * 2]) + __int_as_float(misc[MI_KMAX + ((1 * 2 + b) * 4 + g4) * 2 + 1])) * 1.01f + 1e-6f;
            mrow[0] = qn[0] * kmx * LOG2E; mrow[1] = qn[1] * kmx * LOG2E;
            attn_branch<2>(p, smem, orm, bg, cur, mrow, invl, Lacc, Oacc, Qf);
            norml(); finish(1);
        }
        {
            unsigned orm[4] = {0u, 0u, 0u, 0u};
            for (int jj = max(0, cur - 8); jj <= cur; ++jj) orm[jj >> 5] |= 1u << (jj & 31);
            const float kmx = sqrtf(__int_as_float(misc[MI_KMAX + ((2 * 2 + b) * 4 + g4) * 2]) + __int_as_float(misc[MI_KMAX + ((2 * 2 + b) * 4 + g4) * 2 + 1])) * 1.01f + 1e-6f;
            mrow[0] = qn[0] * kmx * LOG2E; mrow[1] = qn[1] * kmx * LOG2E;
            attn_branch<3>(p, smem, orm, bg, cur, mrow, invl, Lacc, Oacc, Qf);
            norml(); finish(2);
        }
    }
    __builtin_amdgcn_s_setprio(0);
}

struct EpiGeluBias : EpiBase { bf16_t* C; int ldc; const float* bias; f32x4 bv[4];
    __device__ __forceinline__ void start(int, int wn, int, int fq) {
#pragma unroll
        for (int j = 0; j < 4; ++j) bv[j] = *(const f32x4*)(bias + wn * 64 + j * 16 + fq * 4); }
    __device__ __forceinline__ void operator()(int m, int n, f32x4 v) const {
        const int j = (n >> 4) & 3; const f32x4 bb = j == 0 ? bv[0] : (j == 1 ? bv[1] : (j == 2 ? bv[2] : bv[3]));
        float y[4];
#pragma unroll
        for (int i = 0; i < 4; ++i) { const float x = v[i] + bb[i]; const float u2 = 1.5957691216057308f * (x + 0.044715f * x * x * x); y[i] = x / (1.f + __expf(-u2)); }
        *(u32x2*)(C + (size_t)m * ldc + n) = (u32x2){pack2(y[0], y[1]), pack2(y[2], y[3])}; } };
__device__ __forceinline__ void ph_cmp_gemm(const Params& p, unsigned char* smem) {
    const bf16_t* kvq = (const bf16_t*)(p.ws + KVQ); const float* pew = (const float*)(p.ws + MISC) + MI_PEW;
    for (int t = blockIdx.x; t < 128; t += gridDim.x) {
        const int nt = t & 3, mt = (t >> 2) & 1, bg = (t >> 3) & 7, kv = t >> 6, b = bg >> 2, g = bg & 3;
        const bf16_t* A = kvq + ((size_t)b * S_ + 16 * (mt * 256)) * KVQ_LD + kv * 256 + g * 64;
        const bf16_t* Bt = (const bf16_t*)(p.ws + WT_CW1) + (size_t)(kv * 256 + nt * 64) * 2048;
        bf16_t* C = (bf16_t*)(p.ws + HC) + (size_t)((kv * 8 + bg) * 512 + mt * 256) * 256 + nt * 64;
        gemm_tile<EpiGeluBias, true>(A, 16 * KVQ_LD, Bt, 2048, 2048, EpiGeluBias{{}, C, 256, pew + kv * 256 + nt * 64, {}}, smem, KVQ_LD);
    }
}

#define XB_TMO      128
#define XB_XCNT(j)  (256  + 64 * (j))
#define XB_XSUB(j)  (1280 + 64 * (j))
#define XB_XGEN(j)  (2304 + 64 * (j))
#define XB_TOP      3328
#define XB_TOPGEN   3392
#define XCD_BAR_WORDS 3456
#define XB_SPIN_CAP (1u << 20)
#define LAS __attribute__((address_space(3)))
__device__ __forceinline__ unsigned xb_ld(unsigned* p) { return __hip_atomic_load(p, __ATOMIC_RELAXED, __HIP_MEMORY_SCOPE_AGENT); }
__device__ __forceinline__ unsigned xb_add(unsigned* p, unsigned v) { return __hip_atomic_fetch_add(p, v, __ATOMIC_RELAXED, __HIP_MEMORY_SCOPE_AGENT); }
__device__ __forceinline__ unsigned xb_xcc_id() { return (unsigned)__builtin_amdgcn_s_getreg((3 << 11) | 20) & 0xFu; }
#define XB_SPIN(cond, bar) do { unsigned _sp = 0; while (cond) { __builtin_amdgcn_s_sleep(1); \
    if ((++_sp & 255u) == 0u) { if (xb_ld(&(bar)[XB_TMO])) break; if (_sp > XB_SPIN_CAP) { atomicAdd(&(bar)[XB_TMO], 1u); break; } } } } while (0)
struct XcdBarrier { unsigned* bar; unsigned x; volatile LAS unsigned* st; };
__device__ __forceinline__ XcdBarrier xcd_barrier_post(unsigned* bar, volatile LAS unsigned* st) {
    XcdBarrier b; b.bar = bar; b.x = xb_xcc_id(); b.st = st;
    if (threadIdx.x == 0) (void)xb_add(&bar[XB_XCNT(b.x)], 1u);
    return b;
}
__device__ __forceinline__ void xcd_barrier_complete(unsigned* bar, unsigned x, unsigned& nloc, unsigned& nx) {
    const unsigned G = gridDim.x * gridDim.y * gridDim.z;
    unsigned sum, cnt, mine, sp = 0u;
    for (;;) {
        sum = 0u; cnt = 0u; mine = 0u;
#pragma unroll
        for (unsigned j = 0; j < 16; ++j) { const unsigned c = xb_ld(&bar[XB_XCNT(j)]); sum += c; cnt += (c > 0u) ? 1u : 0u; mine = (j == x) ? c : mine; }
        if (sum == G) break;
        __builtin_amdgcn_s_sleep(1);
        if ((++sp & 255u) == 0u) { if (xb_ld(&bar[XB_TMO])) break; if (sp > XB_SPIN_CAP) { atomicAdd(&bar[XB_TMO], 1u); break; } }
    }
    nloc = mine > 0u ? mine : 1u; nx = cnt > 0u ? cnt : 1u;
}
__device__ __forceinline__ void xcd_barrier(const XcdBarrier& b) {
    asm volatile("s_waitcnt vmcnt(0)" ::: "memory");
    __syncthreads();
    if (threadIdx.x == 0) {
        unsigned* bar = b.bar;
        __builtin_amdgcn_s_waitcnt(0);
        unsigned nloc = b.st[0], nx = b.st[1];
        if (nloc == 0u) { xcd_barrier_complete(bar, b.x, nloc, nx); b.st[0] = nloc; b.st[1] = nx; }
        const unsigned old = xb_add(&bar[XB_XSUB(b.x)], 1u);
        const unsigned gen = old / nloc;
        if (old + 1u == (gen + 1u) * nloc) {
            __builtin_amdgcn_fence(__ATOMIC_RELEASE, "agent");
            asm volatile("s_waitcnt vmcnt(0)" ::: "memory");
            const unsigned og = xb_add(&bar[XB_TOP], 1u);
            const unsigned tg = og / nx;
            if (og + 1u == (tg + 1u) * nx) xb_add(&bar[XB_TOPGEN], 1u);
            else XB_SPIN(xb_ld(&bar[XB_TOPGEN]) == tg, bar);
            __builtin_amdgcn_fence(__ATOMIC_ACQUIRE, "agent");
            xb_add(&bar[XB_XGEN(b.x)], 1u);
            asm volatile("s_waitcnt vmcnt(0)" ::: "memory");
        } else {
            XB_SPIN(xb_ld(&bar[XB_XGEN(b.x)]) == gen, bar);
            __builtin_amdgcn_fence(__ATOMIC_ACQUIRE, "agent");
            asm volatile("s_waitcnt vmcnt(0)" ::: "memory");
        }
    }
    __syncthreads();
}
__global__ void __launch_bounds__(NT) fwd_kernel(Params p) {
    cg::grid_group grid = cg::this_grid();
    extern __shared__ __attribute__((aligned(16))) unsigned char smem[];
    float* hf = (float*)(p.ws + H_F32); bf16_t* hb = (bf16_t*)(p.ws + H_BF);
    volatile LAS unsigned* xst = (volatile LAS unsigned*)(smem + LDS_BYTES - 16);
    if (threadIdx.x == 0) { xst[0] = 0u; xst[1] = 0u; }
    __syncthreads();
    const XcdBarrier xb = xcd_barrier_post((unsigned*)(p.ws + BAR_OFF), xst);
    ph_prep0(p, smem); ph_moe_weights(p, 0, smem);
    if (p.out == nullptr) grid.sync();
    xcd_barrier(xb);
    PHASE(1, ph_gemm_retin8(p, smem));
    PHASE(2, ph_ret_state(p, smem));
    PHASE(3, ph_ret_scan(p, smem));
    PHASE(4, ph_gnorm_gate(p));
    PHASE(5, ph_gemm_bf16_8((const bf16_t*)p.out, (const bf16_t*)(p.ws + WT_OUT), (bf16_t*)hf, 1024, 2048, smem));
    PHASE(6, (ph_ln_router<false>(p, p.x, (const bf16_t*)hf, hb, p.ln_mix_g, p.ln_mix_b, 0, smem)));
    constexpr int MW_T1 = 3100, MW_T2 = 5200;
    PHASE(7, (ph_moe_up8(p, 0, smem), moe_tail_convert(p, 0, smem, 0, MW_T1)));
    PHASE(8, (ph_moe_down8(p, 0, smem), moe_tail_convert(p, 0, smem, MW_T1, MW_T2)));
    PHASE(9, (ph_ln<true, false, false, true>(p, (const float*)hb, nullptr, hf, hb, p.ln_ffn_g, p.ln_ffn_b, 0, smem), ph_prep1(p, smem)));
    const int G_ = (int)gridDim.x, c_ = (int)blockIdx.x;
    PHASE(10, (ph_gemm_kvq8(p, smem), [&] { if (c_ == G_ - 1) { const int o = ptid(); const float* part = (const float*)(p.ws + ATTN_OUT); float a = 0.f; for (int ks = 0; ks < 32; ++ks) a += part[ks * 512 + o]; ((float*)(p.ws + MISC))[MI_PEW + o] = a; } }(), [&] { const int rem = ((T_ / 256) * (KVQ_N / 256)) % G_; if (rem == 0) moe_weights_range(p, 1, smem, MW_T2, MOEW_TILES, c_, G_); else if (c_ >= rem) moe_weights_range(p, 1, smem, MW_T2, MOEW_TILES, c_ - rem, G_ - rem); }()));
    PHASE(11, (ph_vt(p), ph_cmp_gemm(p, smem)));
    PHASE(12, ph_cmp2(p, smem));
    PHASE(13, ph_attn(p, smem));
    PHASE(14, ph_gemm_bf16_8((const bf16_t*)(p.ws + ATTN_OUT), (const bf16_t*)(p.ws + WT_NSAOUT), (bf16_t*)(p.ws + MIX2), 1024, 1024, smem));
    PHASE(15, (ph_ln_router<true>(p, (const float*)hb, (const bf16_t*)(p.ws + MIX2), hb, p.ln_mix_g + 1024, p.ln_mix_b + 1024, 1, smem)));
    PHASE(16, ph_moe_up8(p, 1, smem));
    PHASE(17, ph_moe_down8(p, 1, smem));
    ph_ln<true, false, true, true>(p, (const float*)hb, nullptr, p.out, nullptr, p.ln_ffn_g + 1024, p.ln_ffn_b + 1024, 1, smem);
}

extern "C" void kernel_launch(void* const* d_in, const int* in_sizes, int n_in, void* d_out, int out_size, void* d_ws, size_t ws_size, hipStream_t stream) {
    (void)in_sizes; (void)n_in; (void)out_size;
    if (ws_size < WS_NEEDED) { fprintf(stderr, "workspace too small: %zu < %zu\n", ws_size, (size_t)WS_NEEDED); return; }
    static int grid_blocks = 0;
    if (!grid_blocks) {
        int dev = 0, cus = 0, per_cu = 0;
        (void)hipGetDevice(&dev);
        (void)hipDeviceGetAttribute(&cus, hipDeviceAttributeMultiprocessorCount, dev);
        (void)hipFuncSetAttribute((const void*)fwd_kernel, hipFuncAttributeMaxDynamicSharedMemorySize, LDS_BYTES);
        (void)hipOccupancyMaxActiveBlocksPerMultiprocessor(&per_cu, fwd_kernel, NT, LDS_BYTES);
        if (per_cu > 1) per_cu = 1;
        grid_blocks = cus * per_cu;
    }
    Params p{};
    const float** pp = (const float**)&p;
    for (int i = 0; i < 21; ++i) pp[i] = (const float*)d_in[i];
    p.out = (float*)d_out; p.ws = (unsigned char*)d_ws;
    (void)hipMemsetAsync((unsigned char*)d_ws + BAR_OFF, 0, CTL_ZERO_BYTES, stream);
    void* args[] = {&p};
    hipError_t e = hipLaunchCooperativeKernel((void*)fwd_kernel, dim3(grid_blocks), dim3(NT), args, LDS_BYTES, stream);
    if (e != hipSuccess) fprintf(stderr, "cooperative launch failed: %s (grid %d)\n", hipGetErrorString(e), grid_blocks);
}
```
